# Optimizing an MI355X kernel written in HIP

```python
import math
import jax, jax.numpy as jnp
from jax import lax
import numpy as np

D_MODEL = 1024
BATCH = 4
SEQ = 8192
DEPTH = 1
DEC_BATCH = 32
DEC_SEQ = 64
PAST_LEN = 1024

CHUNK = 64
WINDOW = 128
WIN_CHUNKS = WINDOW // CHUNK
HEAD_DIM = 64
N_Q_HEADS = 8
N_KV_HEADS = 2
Q_GROUP = N_Q_HEADS // N_KV_HEADS
ATTN_WIDTH = N_Q_HEADS * HEAD_DIM
KV_WIDTH = N_KV_HEADS * HEAD_DIM
HGRN_HEADS = 8
HGRN_DK = 128
HGRN_DV = 128
HGRN_WIDTH = HGRN_HEADS * HGRN_DK
HGRN_BLOCK = 16
N_BRANCH = 2
D_FF = -(-8 * D_MODEL // (3 * 256)) * 256
IN_WIDTH = ATTN_WIDTH + 2 * KV_WIDTH + 4 * HGRN_WIDTH + N_BRANCH * D_MODEL
ALPHA = (2 * DEPTH) ** 0.25
BETA = (8 * DEPTH) ** -0.25
LN_EPS = 1e-5
RMS_EPS = 1e-6

kernel_name = "swa_sink_hgrn2_griffin_merge_deepnorm_adaln"


def split_points():
    sizes = (ATTN_WIDTH, KV_WIDTH, KV_WIDTH, HGRN_WIDTH, HGRN_WIDTH, HGRN_WIDTH, HGRN_WIDTH)
    return [int(v) for v in np.cumsum(sizes)]


def layer_norm(x, gain=None, bias=None):
    xf = x.astype(jnp.float32)
    mu = jnp.mean(xf, axis=-1, keepdims=True)
    var = jnp.mean(jnp.square(xf - mu), axis=-1, keepdims=True)
    y = (xf - mu) * lax.rsqrt(var + LN_EPS)
    if gain is not None:
        y = y * gain.astype(jnp.float32) + bias.astype(jnp.float32)
    return y.astype(x.dtype)


def rms_norm(x):
    xf = x.astype(jnp.float32)
    return xf * lax.rsqrt(jnp.mean(jnp.square(xf), axis=-1, keepdims=True) + RMS_EPS)


def alibi_slopes():
    return jnp.exp2(-8.0 * jnp.arange(1, N_Q_HEADS + 1, dtype=jnp.float32) / N_Q_HEADS)


def banded_attention(q, k, v, qpos, kpos, valid, sinks):
    B, N, Tq = q.shape[:3]
    qg = q.reshape(B, N, Tq, N_KV_HEADS, Q_GROUP, HEAD_DIM)
    s = jnp.einsum('bnqhgd,bnkhd->bnhgqk', qg, k, preferred_element_type=jnp.float32) * (HEAD_DIM ** -0.5)
    dist = jnp.abs(qpos[:, :, None] - kpos[:, None, :]).astype(jnp.float32)
    s = s - alibi_slopes().reshape(N_KV_HEADS, Q_GROUP, 1, 1) * dist[None, :, None, None]
    s = jnp.where(valid[None, :, None, None], s, -jnp.inf)
    sink = jnp.broadcast_to(sinks.astype(jnp.float32).reshape(N_KV_HEADS, Q_GROUP, 1, 1), s.shape[:-1] + (1,))
    p = jax.nn.softmax(jnp.concatenate([s, sink], axis=-1), axis=-1)[..., :-1]
    o = jnp.einsum('bnhgqk,bnkhd->bnqhgd', p.astype(v.dtype), v)
    return o.reshape(B, N, Tq, ATTN_WIDTH)


def swa_prompt(q, k, v, sinks):
    B, T = q.shape[:2]
    N = T // CHUNK
    qc = q.reshape(B, N, CHUNK, N_Q_HEADS, HEAD_DIM)
    pad = ((0, 0), (WINDOW, 0), (0, 0), (0, 0))
    kp = jnp.pad(k, pad).reshape(B, N + WIN_CHUNKS, CHUNK, N_KV_HEADS, HEAD_DIM)
    vp = jnp.pad(v, pad).reshape(B, N + WIN_CHUNKS, CHUNK, N_KV_HEADS, HEAD_DIM)
    kb = jnp.concatenate([kp[:, j:j + N] for j in range(WIN_CHUNKS + 1)], axis=2)
    vb = jnp.concatenate([vp[:, j:j + N] for j in range(WIN_CHUNKS + 1)], axis=2)
    qpos = jnp.arange(T).reshape(N, CHUNK)
    kpos = (jnp.arange(N)[:, None] - WIN_CHUNKS) * CHUNK + jnp.arange((WIN_CHUNKS + 1) * CHUNK)[None, :]
    valid = (kpos >= 0)[:, None, :]
    o = banded_attention(qc, kb, vb, qpos, kpos, valid, sinks).reshape(B, T, ATTN_WIDTH)
    return o, k[:, T - WINDOW:], v[:, T - WINDOW:]


def swa_sample(q, k, v, k_cache, v_cache, sinks):
    T = q.shape[1]
    kb = jnp.concatenate([k_cache.astype(k.dtype), k], axis=1)
    vb = jnp.concatenate([v_cache.astype(v.dtype), v], axis=1)
    qpos = (PAST_LEN + jnp.arange(T))[None, :]
    kpos = (PAST_LEN - WINDOW + jnp.arange(WINDOW + T))[None, :]
    valid = jnp.ones((1, 1, WINDOW + T), dtype=bool)
    o = banded_attention(q[:, None], kb[:, None], vb[:, None], qpos, kpos, valid, sinks)[:, 0]
    return o, kb[:, T:], vb[:, T:]


def hgrn2_recurrence(q, log_f, k, v, s0):
    B, T = q.shape[:2]
    L = HGRN_BLOCK
    Tp = -(-T // L) * L
    pad = ((0, 0), (0, Tp - T), (0, 0), (0, 0))
    nb = Tp // L

    def blocks(a):
        return jnp.pad(a, pad).reshape(B, nb, L, HGRN_HEADS, a.shape[-1]).astype(jnp.float32)

    q, log_f, k, v = blocks(q), blocks(log_f), blocks(k), blocks(v)
    b = jnp.cumsum(log_f, axis=2)
    b_last = b[:, :, -1:]
    qe = q * jnp.exp(b)
    ke = k * jnp.exp(-b)
    kd = k * jnp.exp(b_last - b)
    causal = jnp.tril(jnp.ones((L, L), dtype=bool))
    a = jnp.where(causal, jnp.einsum('bnlhd,bnmhd->bnhlm', qe, ke), 0.0)
    o_intra = jnp.einsum('bnhlm,bnmhe->bnlhe', a, v)

    def step(s, inp):
        qe_n, kd_n, v_n, dec_n = inp
        o = jnp.einsum('blhd,bhde->blhe', qe_n, s)
        s = dec_n[..., None] * s + jnp.einsum('blhd,blhe->bhde', kd_n, v_n)
        return s, o

    xs = (jnp.moveaxis(qe, 1, 0), jnp.moveaxis(kd, 1, 0), jnp.moveaxis(v, 1, 0),
          jnp.moveaxis(jnp.exp(b_last[:, :, 0]), 1, 0))
    s_final, o_inter = lax.scan(step, s0.astype(jnp.float32), xs)
    o = o_intra + jnp.moveaxis(o_inter, 0, 1)
    return o.reshape(B, Tp, HGRN_HEADS, HGRN_DV)[:, :T], s_final.astype(s0.dtype)


def hgrn2_branch(hq, hf, hi, hg, lb, norm_w, s0):
    B, T = hq.shape[:2]
    shp = (B, T, HGRN_HEADS, HGRN_DK)
    z = hf.astype(jnp.float32).reshape(shp)
    lbh = lb.reshape(HGRN_HEADS, HGRN_DK)
    log_f = jnp.log(lbh + (1.0 - lbh) * jax.nn.sigmoid(z))
    k_in = (1.0 - lbh) * jax.nn.sigmoid(-z)
    q_r = jax.nn.silu(hq).reshape(shp)
    v_r = hi.reshape(B, T, HGRN_HEADS, HGRN_DV)
    o, s_new = hgrn2_recurrence(q_r, log_f, k_in, v_r, s0)
    o = rms_norm(o) * norm_w.astype(jnp.float32).reshape(HGRN_HEADS, HGRN_DV)
    y = o.reshape(B, T, HGRN_WIDTH).astype(hg.dtype) * jax.nn.silu(hg)
    return y, s_new


def layer_forward(x, c, k_cache, v_cache, s0, w_ada, b_ada, w_in, sinks, lb, hgrn_norm_w,
                  w_branch_attn, w_branch_hgrn, w_out, ln_mix_g, ln_mix_b,
                  w_up, w_down, ln_ffn_g, ln_ffn_b):
    B, T = x.shape[:2]
    mod = jnp.einsum('bd,de->be', jax.nn.silu(c), w_ada) + b_ada
    sh1, sc1, g1, sh2, sc2, g2 = jnp.split(mod[:, None, :], 6, axis=-1)
    h = layer_norm(x) * (1 + sc1) + sh1
    proj = jnp.einsum('btd,de->bte', h, w_in)
    q, k, v, hq, hf, hi, hg, gates = jnp.split(proj, split_points(), axis=-1)
    q = q.reshape(B, T, N_Q_HEADS, HEAD_DIM)
    k = k.reshape(B, T, N_KV_HEADS, HEAD_DIM)
    v = v.reshape(B, T, N_KV_HEADS, HEAD_DIM)
    if k_cache is None:
        ya, k_win, v_win = swa_prompt(q, k, v, sinks)
        s0 = jnp.zeros((B, HGRN_HEADS, HGRN_DK, HGRN_DV), dtype=x.dtype)
    else:
        ya, k_win, v_win = swa_sample(q, k, v, k_cache, v_cache, sinks)
    yh, s_new = hgrn2_branch(hq, hf, hi, hg, lb, hgrn_norm_w, s0)
    ga, gh = jnp.split(gates, 2, axis=-1)
    merged = jax.nn.sigmoid(ga) * (ya @ w_branch_attn) + jax.nn.sigmoid(gh) * (yh @ w_branch_hgrn)
    x = layer_norm(ALPHA * x + g1 * (merged @ w_out), ln_mix_g, ln_mix_b)
    h = layer_norm(x) * (1 + sc2) + sh2
    u, gt = jnp.split(h @ w_up, 2, axis=-1)
    x = layer_norm(ALPHA * x + g2 * ((jax.nn.silu(gt) * u) @ w_down), ln_ffn_g, ln_ffn_b)
    return x, k_win, v_win, s_new


def setup_inputs(seed: int = 0) -> dict:
    key = jax.random.key(seed)
    ks = jax.random.split(key, 24)
    L = DEPTH

    def nrm(k, shape, scale):
        return jax.random.normal(k, shape, jnp.float32) * scale

    return {
        'x_prompt': nrm(ks[0], (BATCH, SEQ, D_MODEL), 1.0),
        'x_sample': nrm(ks[1], (DEC_BATCH, DEC_SEQ, D_MODEL), 1.0),
        'cache_attn_k': nrm(ks[2], (L, DEC_BATCH, WINDOW, N_KV_HEADS, HEAD_DIM), 1.0),
        'cache_attn_v': nrm(ks[3], (L, DEC_BATCH, WINDOW, N_KV_HEADS, HEAD_DIM), 1.0),
        'state_hgrn': nrm(ks[4], (L, DEC_BATCH, HGRN_HEADS, HGRN_DK, HGRN_DV), 0.5),
        'c_prompt': nrm(ks[5], (BATCH, D_MODEL), 1.0),
        'c_sample': nrm(ks[6], (DEC_BATCH, D_MODEL), 1.0),
        'w_ada': nrm(ks[7], (L, D_MODEL, 6 * D_MODEL), 0.5 * D_MODEL ** -0.5),
        'b_ada': nrm(ks[8], (L, 6 * D_MODEL), 0.02),
        'w_in': nrm(ks[9], (L, D_MODEL, IN_WIDTH), D_MODEL ** -0.5),
        'attn_sinks': nrm(ks[10], (L, N_Q_HEADS), 1.0),
        'hgrn_lb_logits': nrm(ks[11], (L + 1, HGRN_WIDTH), 0.5),
        'hgrn_norm_w': 1.0 + nrm(ks[12], (L, HGRN_WIDTH), 0.02),
        'w_branch_attn': nrm(ks[13], (L, ATTN_WIDTH, D_MODEL), BETA * ATTN_WIDTH ** -0.5),
        'w_branch_hgrn': nrm(ks[14], (L, HGRN_WIDTH, D_MODEL), BETA * HGRN_WIDTH ** -0.5),
        'w_out': nrm(ks[15], (L, D_MODEL, D_MODEL), BETA * D_MODEL ** -0.5),
        'ln_mix_g': 1.0 + nrm(ks[16], (L, D_MODEL), 0.02),
        'ln_mix_b': nrm(ks[17], (L, D_MODEL), 0.02),
        'w_up': nrm(ks[18], (L, D_MODEL, 2 * D_FF), D_MODEL ** -0.5),
        'w_down': nrm(ks[19], (L, D_FF, D_MODEL), BETA * D_FF ** -0.5),
        'ln_ffn_g': 1.0 + nrm(ks[20], (L, D_MODEL), 0.02),
        'ln_ffn_b': nrm(ks[21], (L, D_MODEL), 0.02),
    }


def reference(x_prompt, x_sample, cache_attn_k, cache_attn_v, state_hgrn, c_prompt, c_sample,
              w_ada, b_ada, w_in, attn_sinks, hgrn_lb_logits, hgrn_norm_w,
              w_branch_attn, w_branch_hgrn, w_out, ln_mix_g, ln_mix_b,
              w_up, w_down, ln_ffn_g, ln_ffn_b):
    lb_all = jnp.cumsum(jax.nn.softmax(hgrn_lb_logits.astype(jnp.float32), axis=0), axis=0)
    xp, xs = x_prompt, x_sample
    kp_l, vp_l, sp_l, ks_l, vs_l, ss_l = [], [], [], [], [], []
    for l in range(DEPTH):
        w = (w_ada[l], b_ada[l], w_in[l], attn_sinks[l], lb_all[l], hgrn_norm_w[l],
             w_branch_attn[l], w_branch_hgrn[l], w_out[l], ln_mix_g[l], ln_mix_b[l],
             w_up[l], w_down[l], ln_ffn_g[l], ln_ffn_b[l])
        xp, kp, vp, sp = layer_forward(xp, c_prompt, None, None, None, *w)
        xs, kn, vn, sn = layer_forward(xs, c_sample, cache_attn_k[l], cache_attn_v[l], state_hgrn[l], *w)
        kp_l.append(kp); vp_l.append(vp); sp_l.append(sp)
        ks_l.append(kn); vs_l.append(vn); ss_l.append(sn)
    new_k_prompt = jnp.stack(kp_l)
    new_v_prompt = jnp.stack(vp_l)
    new_state_prompt = jnp.stack(sp_l)
    new_k_sample = jnp.stack(ks_l)
    new_v_sample = jnp.stack(vs_l)
    new_state_sample = jnp.stack(ss_l)
    return (xp, xs, new_k_prompt, new_v_prompt, new_state_prompt, new_k_sample, new_v_sample, new_state_sample)
```

```cpp
#define MK_N_LAUNCHES 0
#include <hip/hip_runtime.h>
#include <hip/hip_cooperative_groups.h>
#include <cstdio>
#include <cstdint>
namespace pg8 {
#define PG8_LAS __attribute__((address_space(3)))
typedef unsigned short bf16_t;
typedef short bf16x8 __attribute__((ext_vector_type(8)));
typedef float f32x4 __attribute__((ext_vector_type(4)));
typedef unsigned u32x4 __attribute__((ext_vector_type(4)));
constexpr int BM = 256, BK = 64, HALF = 128, HTB = HALF * BK * 2  , STAGE_BYTES = 8 * HTB, NXCD = 8, WGM = 8;

__host__ __device__ __forceinline__ int lds_byte(int r, int c) { const int st = (r >> 4) * 2 + (c >> 5), rr = r & 15, cc = c & 31, ob = rr * 64 + cc * 2; return st * 1024 + (ob ^ (((ob >> 9) & 1) << 5)); }
__host__ __device__ __forceinline__ void stage_rc(int b, int& R, int& C) { const int st = b / 1024, sb = b % 1024, swz = sb ^ (((sb >> 9) & 1) << 5); R = (st >> 1) * 16 + swz / 64; C = (st & 1) * 32 + (swz % 64) / 2; }
__host__ __device__ __forceinline__ int perm32(int rho) { const int n = rho >> 4, i = rho & 15; return 8 * (i >> 2) + 4 * n + (i & 3); }

struct Unit { int pm, pn; };
struct Gemm { const bf16_t* A; const bf16_t* Bt; int M, N, K; };

struct StaticOrder {
    int nM, nN, nwg, G, c;
    __host__ __device__ void init(int M, int N, int G_, int c_) { nM = M / BM; nN = N / BM; nwg = nM * nN; G = G_; c = c_; }
    __host__ __device__ bool next(int i, Unit& u) const {
        const long L = (long)i * G + c; if (L >= nwg) return false;
        int wgid = (int)L; { const int q = nwg / NXCD, r = nwg % NXCD, xcd = wgid % NXCD, off = wgid / NXCD; wgid = (xcd < r ? xcd * (q + 1) : r * (q + 1) + (xcd - r) * q) + off; }
        const int nig = WGM * nN, gid = wgid / nig, fm = gid * WGM, gsz = (nM - fm) < WGM ? (nM - fm) : WGM;
        u.pm = fm + ((wgid % nig) % gsz); u.pn = (wgid % nig) / gsz; return true;
    }
    __device__ __forceinline__ void a_ready(const Unit&) const {}
    __device__ __forceinline__ void done(const Unit&) const {}
};

__device__ __forceinline__ unsigned cvt_pk_bf16(float lo, float hi) { unsigned r; asm volatile("v_cvt_pk_bf16_f32 %0, %1, %2" : "=v"(r) : "v"(lo), "v"(hi)); return r; }
typedef float f32x2 __attribute__((ext_vector_type(2)));
__device__ __forceinline__ float bf2f(unsigned short b) { return __uint_as_float(((unsigned)b) << 16); }
__device__ __forceinline__ float fsigmoid(float x) { return __builtin_amdgcn_rcpf(1.0f + __expf(-x)); }
__device__ __forceinline__ float fsilu(float x) { return x * fsigmoid(x); }
__device__ __forceinline__ int mod_row(int row) { return row < 32768 ? (row >> 13) : 4 + ((row - 32768) >> 6); }
constexpr int OFF_NKP = 35651584, OFF_NVP = 35717120, OFF_NSP = 35782656, OFF_NKS = 36306944, OFF_NVS = 36831232, OFF_NSS = 37355520;

struct EpiProj {
    static constexpr bool PERM = true, AFTER_DRAIN = false;
    bf16_t *QB, *KB, *VB, *HQ, *HZ, *HV, *HG, *GT; float* dout;
    __device__ __forceinline__ void operator()(const f32x4 (&acc)[2][2][4][2], const Unit& u, int wr, int wc, int fr, int fq) const {
        const int pn = u.pn, row0 = u.pm * BM + wr * 64 + fr, cl = wc * 32 + 8 * fq;
        if (pn == 2) {
#pragma unroll
            for (int ai = 0; ai < 2; ++ai)
#pragma unroll
                for (int m = 0; m < 4; ++m) { const int row = row0 + ai * HALF + m * 16;
                    float* wdst = nullptr;
                    if (row < 32768) { const int t = row & 8191; if (t >= 8064) wdst = dout + OFF_NKP + (size_t)(((row >> 13) * 128 + (t - 8064)) * 128 + cl); }
                    else { const int r2 = row - 32768; wdst = dout + OFF_NKS + (size_t)(((r2 >> 6) * 128 + 64 + (r2 & 63)) * 128 + cl); }
#pragma unroll
                    for (int bj = 0; bj < 2; ++bj) { const f32x4 v0 = acc[ai][bj][m][0], v1 = acc[ai][bj][m][1];
                        u32x4 w; w.x = cvt_pk_bf16(v0[0], v0[1]); w.y = cvt_pk_bf16(v0[2], v0[3]); w.z = cvt_pk_bf16(v1[0], v1[1]); w.w = cvt_pk_bf16(v1[2], v1[3]);
                        *(u32x4*)((bj == 0 ? KB : VB) + (size_t)row * 128 + cl) = w;
                        if (wdst) { float* d = wdst + (bj == 0 ? 0 : (row < 32768 ? (OFF_NVP - OFF_NKP) : (OFF_NVS - OFF_NKS))); *(f32x4*)d = v0; *(f32x4*)(d + 4) = v1; } } }
            return;
        }
        int mode; bf16_t* base; int ldc, cb;
        if (pn < 2)       { mode = 0; base = QB; ldc = 512;  cb = pn * 256; }
        else if (pn < 7)  { mode = 1; base = HQ; ldc = 1024; cb = (pn - 3) * 256; }
        else if (pn < 11) { mode = 3; base = HZ; ldc = 1024; cb = (pn - 7) * 256; }
        else if (pn < 15) { mode = 3; base = HV; ldc = 1024; cb = (pn - 11) * 256; }
        else if (pn < 19) { mode = 1; base = HG; ldc = 1024; cb = (pn - 15) * 256; }
        else              { mode = 2; base = GT; ldc = 2048; cb = (pn - 19) * 256; }
#pragma unroll
        for (int ai = 0; ai < 2; ++ai)
#pragma unroll
            for (int m = 0; m < 4; ++m) { bf16_t* rowp = base + (size_t)(row0 + ai * HALF + m * 16) * ldc + cb + cl;
#pragma unroll
                for (int bj = 0; bj < 2; ++bj) { f32x4 v0 = acc[ai][bj][m][0], v1 = acc[ai][bj][m][1];
                    if (mode == 0) { v0 = v0 * 0.125f; v1 = v1 * 0.125f; }
                    else if (mode == 1) {
#pragma unroll
                        for (int i = 0; i < 4; ++i) { v0[i] = fsilu(v0[i]); v1[i] = fsilu(v1[i]); } }
                    else if (mode == 2) {
#pragma unroll
                        for (int i = 0; i < 4; ++i) { v0[i] = fsigmoid(v0[i]); v1[i] = fsigmoid(v1[i]); } }
                    u32x4 w; w.x = cvt_pk_bf16(v0[0], v0[1]); w.y = cvt_pk_bf16(v0[2], v0[3]); w.z = cvt_pk_bf16(v1[0], v1[1]); w.w = cvt_pk_bf16(v1[2], v1[3]);
                    *(u32x4*)(rowp + bj * HALF) = w; } }
    }
};
struct EpiSwiGLU {
    static constexpr bool PERM = true, AFTER_DRAIN = false;
    bf16_t* O;
    __device__ __forceinline__ void operator()(const f32x4 (&acc)[2][2][4][2], const Unit& u, int wr, int wc, int fr, int fq) const {
        const int row0 = u.pm * BM + wr * 64 + fr, col = u.pn * 128 + wc * 32 + 8 * fq;
#pragma unroll
        for (int ai = 0; ai < 2; ++ai)
#pragma unroll
            for (int m = 0; m < 4; ++m) { f32x4 v0, v1;
#pragma unroll
                for (int i = 0; i < 4; ++i) { v0[i] = fsilu(acc[ai][1][m][0][i]) * acc[ai][0][m][0][i]; v1[i] = fsilu(acc[ai][1][m][1][i]) * acc[ai][0][m][1][i]; }
                u32x4 w; w.x = cvt_pk_bf16(v0[0], v0[1]); w.y = cvt_pk_bf16(v0[2], v0[3]); w.z = cvt_pk_bf16(v1[0], v1[1]); w.w = cvt_pk_bf16(v1[2], v1[3]);
                *(u32x4*)(O + (size_t)(row0 + ai * HALF + m * 16) * 2816 + col) = w; }
    }
};
template <bool FIRST> struct EpiMerge {
    static constexpr bool PERM = true, AFTER_DRAIN = false;
    const bf16_t* GT; const bf16_t* T1in; bf16_t* O;
    __device__ __forceinline__ void operator()(const f32x4 (&acc)[2][2][4][2], const Unit& u, int wr, int wc, int fr, int fq) const {
        const int row0 = u.pm * BM + wr * 64 + fr, col0 = u.pn * BM + wc * 32 + 8 * fq;
#pragma unroll
        for (int ai = 0; ai < 2; ++ai)
#pragma unroll
            for (int m = 0; m < 4; ++m) { const size_t row = (size_t)(row0 + ai * HALF + m * 16);
#pragma unroll
                for (int bj = 0; bj < 2; ++bj) { const int col = col0 + bj * HALF;
                    const u32x4 g = *(const u32x4*)(GT + row * 2048 + (FIRST ? 0 : 1024) + col);
                    f32x4 v0 = acc[ai][bj][m][0], v1 = acc[ai][bj][m][1];
                    v0[0] *= __uint_as_float(g.x << 16); v0[1] *= __uint_as_float(g.x & 0xffff0000u); v0[2] *= __uint_as_float(g.y << 16); v0[3] *= __uint_as_float(g.y & 0xffff0000u);
                    v1[0] *= __uint_as_float(g.z << 16); v1[1] *= __uint_as_float(g.z & 0xffff0000u); v1[2] *= __uint_as_float(g.w << 16); v1[3] *= __uint_as_float(g.w & 0xffff0000u);
                    if (!FIRST) { const u32x4 t = *(const u32x4*)(T1in + row * 1024 + col);
                        v0[0] += __uint_as_float(t.x << 16); v0[1] += __uint_as_float(t.x & 0xffff0000u); v0[2] += __uint_as_float(t.y << 16); v0[3] += __uint_as_float(t.y & 0xffff0000u);
                        v1[0] += __uint_as_float(t.z << 16); v1[1] += __uint_as_float(t.z & 0xffff0000u); v1[2] += __uint_as_float(t.w << 16); v1[3] += __uint_as_float(t.w & 0xffff0000u); }
                    u32x4 w; w.x = cvt_pk_bf16(v0[0], v0[1]); w.y = cvt_pk_bf16(v0[2], v0[3]); w.z = cvt_pk_bf16(v1[0], v1[1]); w.w = cvt_pk_bf16(v1[2], v1[3]);
                    *(u32x4*)(O + row * 1024 + col) = w; } }
    }
};
struct EpiResid {
    static constexpr bool PERM = false, AFTER_DRAIN = false;
    const float* xa; const float* xb; const float* gate;
    float* out; float alpha;
    __device__ __forceinline__ void operator()(const f32x4 (&acc)[2][2][4][2], const Unit& u, int wr, int wc, int fr, int fq) const {
        const int row0 = u.pm * BM + wr * 64 + fr, col0 = u.pn * BM + wc * 32 + 4 * fq;
#pragma unroll
        for (int ai = 0; ai < 2; ++ai)
#pragma unroll
            for (int m = 0; m < 4; ++m) { const int row = row0 + ai * HALF + m * 16;
                const float* xr = row < 32768 ? xa + (size_t)row * 1024 : xb + (size_t)(row - 32768) * 1024;
                const float* gr = gate + (size_t)mod_row(row) * 6144; float* orow = out + (size_t)row * 1024;
#pragma unroll
                for (int bj = 0; bj < 2; ++bj)
#pragma unroll
                    for (int n = 0; n < 2; ++n) { const int c = col0 + bj * HALF + n * 16;
                        const f32x4 xv = *(const f32x4*)(xr + c), gv = *(const f32x4*)(gr + c);
                        *(f32x4*)(orow + c) = xv * alpha + gv * acc[ai][bj][m][n]; } }
    }
};
template <class Epi, class Sched, bool ALIGN_EPI = false, bool SP2 = false>
__device__ __forceinline__ void gemm_phase(PG8_LAS unsigned char* lds, const Gemm g, const Sched& S, const Epi& E) {
    const int tid = threadIdx.x, wid = __builtin_amdgcn_readfirstlane(tid >> 6), lane = tid & 63, wr = wid >> 2, wc = wid & 3, fr = lane & 15, fq = lane >> 4;
    const int K = g.K, nt = K / BK;
    unsigned voffA[2], voffB[2];
#pragma unroll
    for (int i = 0; i < 2; ++i) { int R, C; stage_rc(tid * 16 + i * 8192, R, C); const int Rb = Epi::PERM ? ((R & ~31) + perm32(R & 31)) : R;
        voffA[i] = (unsigned)(R * K + C) * 2u; voffB[i] = (unsigned)(Rb * K + C) * 2u; }
    const size_t kstep = (size_t)(BK * 2);
    const size_t hstep = (size_t)HALF * K * 2;
    const size_t tstep = 2 * hstep;
    const unsigned ldsw = (unsigned)wid * 1024u;
    const int aoff = lds_byte(wr * 64 + fr, fq * 8), boff = lds_byte(wc * 32 + fr, fq * 8);
#define PG8_SA(b, h) (((b) * 2 + (h)) * HTB)
#define PG8_SB(b, h) ((4 + (b) * 2 + (h)) * HTB)
#define PG8_STAGE(bufoff, gbase, voff) do { _Pragma("unroll") for (int _i = 0; _i < 2; ++_i) \
        __builtin_amdgcn_global_load_lds((const unsigned*)((const char*)(gbase) + (voff)[_i]), (PG8_LAS unsigned*)(lds + (bufoff) + ldsw + _i * 8192), 16, 0, 0); } while (0)
#define PG8_LDA(dst, b, h) do { _Pragma("unroll") for (int m = 0; m < 4; ++m) _Pragma("unroll") for (int k = 0; k < 2; ++k) dst[m][k] = *(const PG8_LAS bf16x8*)(lds + PG8_SA(b, h) + aoff + m * 2048 + k * 1024); } while (0)
#define PG8_LDB(dst, b, h) do { _Pragma("unroll") for (int n = 0; n < 2; ++n) _Pragma("unroll") for (int k = 0; k < 2; ++k) dst[n][k] = *(const PG8_LAS bf16x8*)(lds + PG8_SB(b, h) + boff + n * 2048 + k * 1024); } while (0)
#define PG8_MMA(ai, bj, At, Bt) do { __builtin_amdgcn_s_setprio(1); _Pragma("unroll") for (int m = 0; m < 4; ++m) _Pragma("unroll") for (int n = 0; n < 2; ++n) _Pragma("unroll") for (int k = 0; k < 2; ++k) \
        acc[ai][bj][m][n] = __builtin_amdgcn_mfma_f32_16x16x32_bf16(Bt[n][k], At[m][k], acc[ai][bj][m][n], 0, 0, 0); __builtin_amdgcn_s_setprio(0); } while (0)
#define PG8_WAIT_V(n) asm volatile("s_waitcnt vmcnt(" #n ")" ::: "memory")
#define PG8_WAIT_L(n) asm volatile("s_waitcnt lgkmcnt(" #n ")" ::: "memory")
#define PG8_BAR __builtin_amdgcn_s_barrier()
#define PG8_SCHED __builtin_amdgcn_sched_barrier(0)
    Unit cur, nxt; int ui = 0;
    if (!S.next(0, cur)) return;
    f32x4 acc[2][2][4][2];
#pragma unroll
    for (int a = 0; a < 2; ++a)
#pragma unroll
        for (int b = 0; b < 2; ++b)
#pragma unroll
            for (int m = 0; m < 4; ++m)
#pragma unroll
                for (int n = 0; n < 2; ++n) acc[a][b][m][n] = (f32x4){0.f, 0.f, 0.f, 0.f};
    bf16x8 At[4][2], B0[2][2], B1[2][2];
    const char* cA = (const char*)g.A + (size_t)cur.pm * tstep; const char* cB = (const char*)g.Bt + (size_t)cur.pn * tstep;
    S.a_ready(cur);
    if constexpr (SP2) {
        PG8_STAGE(PG8_SB(0, 0), cB, voffB); PG8_STAGE(PG8_SB(0, 1), cB + hstep, voffB); PG8_STAGE(PG8_SA(0, 0), cA, voffA); PG8_STAGE(PG8_SA(0, 1), cA + hstep, voffA);
        if (wr == 1) PG8_BAR;
        PG8_WAIT_V(2); PG8_BAR;
        PG8_STAGE(PG8_SB(1, 0), cB + kstep, voffB); PG8_STAGE(PG8_SA(1, 0), cA + kstep, voffA); PG8_STAGE(PG8_SB(1, 1), cB + hstep + kstep, voffB);
        PG8_WAIT_V(6); PG8_BAR;
    } else {
        PG8_STAGE(PG8_SB(0, 0), cB, voffB); PG8_STAGE(PG8_SA(0, 0), cA, voffA); PG8_STAGE(PG8_SB(0, 1), cB + hstep, voffB); PG8_STAGE(PG8_SA(0, 1), cA + hstep, voffA);
        if (wr == 1) PG8_BAR;
        PG8_WAIT_V(4); PG8_BAR;
        PG8_STAGE(PG8_SB(1, 0), cB + kstep, voffB); PG8_STAGE(PG8_SA(1, 0), cA + kstep, voffA); PG8_STAGE(PG8_SB(1, 1), cB + hstep + kstep, voffB);
        PG8_WAIT_V(6); PG8_BAR;
    }
    for (;;) {
        const bool has_next = S.next(ui + 1, nxt);
        const char* nA = has_next ? (const char*)g.A + (size_t)nxt.pm * tstep : cA; const char* nB = has_next ? (const char*)g.Bt + (size_t)nxt.pn * tstep : cB;
        for (int t = 0; t < nt; t += 2) {
            const bool last = (t == nt - 2);
            const char* a1 = cA + (size_t)(t + 1) * kstep;
            const char* a2 = last ? nA : cA + (size_t)(t + 2) * kstep; const char* b2 = last ? nB : cB + (size_t)(t + 2) * kstep;
            const char* a3 = a2 + kstep; const char* b3 = b2 + kstep;
            if (last && has_next) S.a_ready(nxt);
            if constexpr (SP2) {
            PG8_LDB(B0, 0, 0); PG8_LDB(B1, 0, 1); PG8_SCHED; PG8_LDA(At, 0, 0); PG8_STAGE(PG8_SA(1, 1), a1 + hstep, voffA);
            PG8_WAIT_V(8); PG8_WAIT_L(0); PG8_BAR; PG8_MMA(0, 0, At, B0); PG8_MMA(0, 1, At, B1); PG8_BAR; PG8_SCHED;
            PG8_LDA(At, 0, 1); PG8_STAGE(PG8_SB(0, 0), b2, voffB); PG8_STAGE(PG8_SB(0, 1), b2 + hstep, voffB); PG8_STAGE(PG8_SA(0, 0), a2, voffA);
            PG8_WAIT_V(8); PG8_WAIT_L(0); PG8_BAR; PG8_MMA(1, 0, At, B0); PG8_MMA(1, 1, At, B1); PG8_BAR; PG8_SCHED;
            PG8_LDB(B0, 1, 0); PG8_LDB(B1, 1, 1); PG8_SCHED; PG8_LDA(At, 1, 0); PG8_STAGE(PG8_SA(0, 1), a2 + hstep, voffA);
            PG8_WAIT_V(8); PG8_WAIT_L(0); PG8_BAR; PG8_MMA(0, 0, At, B0); PG8_MMA(0, 1, At, B1); PG8_BAR; PG8_SCHED;
            PG8_LDA(At, 1, 1); PG8_STAGE(PG8_SB(1, 0), b3, voffB); PG8_STAGE(PG8_SB(1, 1), b3 + hstep, voffB); PG8_STAGE(PG8_SA(1, 0), a3, voffA);
            PG8_WAIT_V(8); PG8_WAIT_L(0); PG8_BAR; PG8_MMA(1, 0, At, B0); PG8_MMA(1, 1, At, B1); PG8_BAR; PG8_SCHED;
            } else {
            PG8_LDB(B0, 0, 0); PG8_SCHED; PG8_LDA(At, 0, 0); PG8_STAGE(PG8_SA(1, 1), a1 + hstep, voffA);
            PG8_WAIT_L(8); PG8_BAR; PG8_WAIT_L(0); PG8_MMA(0, 0, At, B0); PG8_BAR; PG8_SCHED;
            PG8_LDB(B1, 0, 1); PG8_STAGE(PG8_SB(0, 0), b2, voffB);
            PG8_BAR; PG8_WAIT_L(0); PG8_MMA(0, 1, At, B1); PG8_BAR;
            PG8_LDA(At, 0, 1); PG8_STAGE(PG8_SA(0, 0), a2, voffA);
            PG8_BAR; PG8_WAIT_L(0); PG8_MMA(1, 0, At, B0); PG8_BAR; PG8_SCHED;
            PG8_STAGE(PG8_SB(0, 1), b2 + hstep, voffB);
            PG8_WAIT_V(6); PG8_BAR; PG8_MMA(1, 1, At, B1); PG8_BAR;
            PG8_LDB(B0, 1, 0); PG8_SCHED; PG8_LDA(At, 1, 0); PG8_STAGE(PG8_SA(0, 1), a2 + hstep, voffA);
            PG8_WAIT_L(8); PG8_BAR; PG8_WAIT_L(0); PG8_MMA(0, 0, At, B0); PG8_BAR; PG8_SCHED;
            PG8_LDB(B1, 1, 1); PG8_STAGE(PG8_SB(1, 0), b3, voffB);
            PG8_BAR; PG8_WAIT_L(0); PG8_MMA(0, 1, At, B1); PG8_BAR;
            PG8_LDA(At, 1, 1); PG8_STAGE(PG8_SA(1, 0), a3, voffA);
            PG8_BAR; PG8_WAIT_L(0); PG8_MMA(1, 0, At, B0); PG8_BAR; PG8_SCHED;
            PG8_STAGE(PG8_SB(1, 1), b3 + hstep, voffB);
            PG8_WAIT_V(6); PG8_BAR; PG8_MMA(1, 1, At, B1); PG8_BAR;
            }
        }
        if constexpr (ALIGN_EPI) { if (wr == 0) PG8_BAR; }
        if constexpr (!Epi::AFTER_DRAIN) { E(acc, cur, wr, wc, fr, fq); S.done(cur); }
        if (!has_next) break;
#pragma unroll
        for (int a = 0; a < 2; ++a)
#pragma unroll
            for (int b = 0; b < 2; ++b)
#pragma unroll
                for (int m = 0; m < 4; ++m)
#pragma unroll
                    for (int n = 0; n < 2; ++n) acc[a][b][m][n] = (f32x4){0.f, 0.f, 0.f, 0.f};
        cur = nxt; cA = nA; cB = nB; ++ui;
        if constexpr (ALIGN_EPI) { if (wr == 1) PG8_BAR; }
    }
    PG8_WAIT_V(0);
    if constexpr (!ALIGN_EPI) { if (wr == 0) PG8_BAR; }
    PG8_BAR;
    if constexpr (Epi::AFTER_DRAIN) { E.fused(acc, cur, wr, wc, fr, fq, lds, wid, lane); S.done(cur); }
#undef PG8_SA
#undef PG8_SB
#undef PG8_STAGE
#undef PG8_LDA
#undef PG8_LDB
#undef PG8_MMA
#undef PG8_WAIT_V
#undef PG8_WAIT_L
#undef PG8_BAR
#undef PG8_SCHED
}
}
#define GAS __attribute__((address_space(1)))
#define LAS __attribute__((address_space(3)))
typedef unsigned short bf16;
typedef unsigned v4u __attribute__((ext_vector_type(4)));
typedef float f32x4 __attribute__((ext_vector_type(4)));
typedef short bf16x8 __attribute__((ext_vector_type(8)));
typedef GAS unsigned gu32;
typedef GAS unsigned long long gu64;
#define RLX_AGENT __ATOMIC_RELAXED, __HIP_MEMORY_SCOPE_AGENT
#define LDS_WAIT() asm volatile("s_waitcnt lgkmcnt(0)" ::: "memory")
#define VM_WAIT() asm volatile("s_waitcnt vmcnt(0)" ::: "memory")
__device__ __forceinline__ unsigned long long rt() { return __builtin_amdgcn_s_memrealtime(); }
__device__ __forceinline__ unsigned f2bf(float f) { unsigned u = __builtin_bit_cast(unsigned, f); return (u + 0x7fffu + ((u >> 16) & 1u)) >> 16; }
__device__ __forceinline__ unsigned pk2(float lo, float hi) { return f2bf(lo) | (f2bf(hi) << 16); }
#ifndef MK_N_LAUNCHES
#define MK_N_LAUNCHES 1
#endif
#ifndef ATTN_IMPL
#define ATTN_IMPL 0
#endif
#ifndef HGRN_IMPL
#define HGRN_IMPL 0
#endif
constexpr int NWAVES = 8;
constexpr int N_PHASES = 12;

constexpr int DM = 1024, SEQ = 8192, NBP = 4, NBS = 32, DSEQ = 64, MP = NBP * SEQ, MS = NBS * DSEQ, M = MP + MS;
constexpr int INW = 6912, DFF = 2816, NMOD = NBP + NBS;
constexpr float LN_EPS = 1e-5f, RMS_EPS = 1e-6f;
constexpr float ALPHA = 1.189207115002721f;
static_assert(M % 256 == 0 && INW % 256 == 0 && (2 * DFF) % 256 == 0, "tile shapes");

constexpr size_t MiB = 1u << 20, HMiB = 1u << 19;
constexpr size_t WS_CTL = 0, WS_MOD = 1 * MiB, CTL_ZERO_BYTES = 2 * MiB;
constexpr size_t WS_WIN = 2 * MiB, WS_WBA = 31 * HMiB, WS_WBH = 33 * HMiB, WS_WOUT = 37 * HMiB, WS_WUP = 41 * HMiB, WS_WDN = 63 * HMiB;
constexpr size_t WS_H = 37 * MiB, WS_QB = 105 * MiB, WS_KB = 139 * MiB, WS_VB = 295 * HMiB, WS_HQ = 156 * MiB, WS_HZ = 224 * MiB, WS_HV = 292 * MiB, WS_HG = 360 * MiB;
constexpr size_t WS_U = 428 * MiB, WS_D = 492 * MiB, WS_END = 985 * HMiB;
constexpr size_t WS_YH = WS_H, WS_T1 = WS_HQ, WS_MERGED = WS_HZ, WS_Z1 = WS_HV, WS_X1 = WS_HQ, WS_ACT = WS_HV;
static_assert(WS_WIN + (size_t)INW * DM * 2 == WS_WBA && WS_WBA + 512 * 1024 * 2 == WS_WBH && WS_WBH + 1024 * 1024 * 2 == WS_WOUT && WS_WOUT + 1024 * 1024 * 2 == WS_WUP &&
              WS_WUP + (size_t)2 * DFF * DM * 2 == WS_WDN && WS_WDN + (size_t)DM * DFF * 2 == WS_H && WS_H + (size_t)M * DM * 2 == WS_QB && WS_QB + (size_t)M * 512 * 2 == WS_KB &&
              WS_KB + (size_t)M * 128 * 2 == WS_VB && WS_VB + (size_t)M * 128 * 2 == WS_HQ && WS_HQ + (size_t)M * DM * 2 == WS_HZ && WS_HG + (size_t)M * DM * 2 == WS_U &&
              WS_ACT + (size_t)M * DFF * 2 <= WS_D && WS_END <= 512 * MiB, "d_ws map");
constexpr int CW_BAR = 4096;

constexpr int RING_BYTES = 131072, LDSCTL_OFF = RING_BYTES, MISC_OFF = LDSCTL_OFF + 320, LDS_BYTES = 147456;

typedef unsigned short bf16_t;
typedef unsigned u32x4 __attribute__((ext_vector_type(4)));
typedef unsigned u32x2 __attribute__((ext_vector_type(2)));
using pg8::bf2f; using pg8::fsigmoid; using pg8::fsilu; using pg8::mod_row;
using pg8::OFF_NKP; using pg8::OFF_NVP; using pg8::OFF_NSP; using pg8::OFF_NKS; using pg8::OFF_NVS; using pg8::OFF_NSS;

struct Frame {
    LAS unsigned char* lds;
    int tid, lane, wave, vcu, G;
    const float* in[22]; float* out; unsigned char* ws;
};
#define IN_XP 0
#define IN_XS 1
#define IN_CK 2
#define IN_CV 3
#define IN_ST 4
#define IN_CP 5
#define IN_CS 6
#define IN_WADA 7
#define IN_BADA 8
#define IN_WIN 9
#define IN_SINK 10
#define IN_LBL 11
#define IN_NORMW 12
#define IN_WBA 13
#define IN_WBH 14
#define IN_WOUT 15
#define IN_LNMG 16
#define IN_LNMB 17
#define IN_WUP 18
#define IN_WDN 19
#define IN_LNFG 20
#define IN_LNFB 21

__device__ __forceinline__ float wave_sum(float v) {
#pragma unroll
    for (int o = 1; o < 64; o <<= 1) v += __shfl_xor(v, o);
    return v;
}
template <class RMap>
__device__ __forceinline__ void transpose_item(const float* W, int K, int N, bf16_t* WT, LAS float* scr, int item, int lane, RMap rmap) {
    const int nblk = N / 32, kb = item / nblk, nb = item % nblk, k0 = 64 * kb, n0 = 32 * nb;
#pragma unroll 8
    for (int i = 0; i < 32; ++i) { const int kk = 2 * i + (lane >> 5); scr[kk * 33 + (lane & 31)] = W[(size_t)(k0 + kk) * N + n0 + (lane & 31)]; }
    LDS_WAIT(); asm volatile("" ::: "memory");
    const int c = lane & 7; const int nd0 = rmap(n0);
#pragma unroll
    for (int j = 0; j < 4; ++j) { const int n = (lane >> 3) + 8 * j; const LAS float* s = scr + (8 * c) * 33 + n;
        v4u o; o.x = pk2(s[0 * 33], s[1 * 33]); o.y = pk2(s[2 * 33], s[3 * 33]); o.z = pk2(s[4 * 33], s[5 * 33]); o.w = pk2(s[6 * 33], s[7 * 33]);
        *(GAS v4u*)(WT + (size_t)(nd0 + n) * K + k0 + 8 * c) = o; }
    LDS_WAIT(); asm volatile("" ::: "memory");
}
struct RMapId { __device__ __forceinline__ int operator()(int n0) const { return n0; } };
struct RMapUp { __device__ __forceinline__ int operator()(int n0) const { return n0 < DFF ? 256 * (n0 >> 7) + (n0 & 127) : 256 * ((n0 - DFF) >> 7) + 128 + ((n0 - DFF) & 127); } };

__device__ __forceinline__ void p0_prologue(Frame& F) {
    if (F.vcu < 192) {
        const int kc = F.vcu / 12, ec = F.vcu % 12, k0 = kc * 64, col = ec * 512 + F.tid;
        LAS float* sc = (LAS float*)F.lds;
        for (int i = F.tid; i < 64 * NMOD; i += 512) { const int kk = i / NMOD, mb = i % NMOD;
            const float cv = mb < NBP ? F.in[IN_CP][mb * DM + k0 + kk] : F.in[IN_CS][(mb - NBP) * DM + k0 + kk]; sc[kk * NMOD + mb] = fsilu(cv); }
        __syncthreads();
        float acc[NMOD];
#pragma unroll
        for (int i = 0; i < NMOD; ++i) acc[i] = 0.f;
        const float* wp = F.in[IN_WADA] + (size_t)k0 * 6144 + col;
#pragma unroll 4
        for (int kk = 0; kk < 64; ++kk) { const float w = wp[(size_t)kk * 6144];
#pragma unroll
            for (int i = 0; i < NMOD; ++i) acc[i] += sc[kk * NMOD + i] * w; }
        const float bias = kc == 0 ? F.in[IN_BADA][col] : 0.f;
        float* mod = (float*)(F.ws + WS_MOD);
#pragma unroll
        for (int i = 0; i < NMOD; ++i) atomicAdd(mod + i * 6144 + col, acc[i] + bias);
        __syncthreads();
    }
    LAS float* scr = (LAS float*)(F.lds + F.wave * 16384);
    const int gw = F.vcu * NWAVES + F.wave, NGW = F.G * NWAVES;
    constexpr int I_IN = (DM / 64) * (INW / 32), I_BA = (512 / 64) * (DM / 32), I_BH = (DM / 64) * (DM / 32), I_OUT = I_BH, I_UP = (DM / 64) * (2 * DFF / 32), I_DN = (DFF / 64) * (DM / 32);
    constexpr int NITEMS = I_IN + I_BA + I_BH + I_OUT + I_UP + I_DN;
    for (int it = gw; it < NITEMS; it += NGW) {
        int r = it;
        if (r < I_IN) { transpose_item(F.in[IN_WIN], DM, INW, (bf16_t*)(F.ws + WS_WIN), scr, r, F.lane, RMapId()); continue; } r -= I_IN;
        if (r < I_BA) { transpose_item(F.in[IN_WBA], 512, DM, (bf16_t*)(F.ws + WS_WBA), scr, r, F.lane, RMapId()); continue; } r -= I_BA;
        if (r < I_BH) { transpose_item(F.in[IN_WBH], DM, DM, (bf16_t*)(F.ws + WS_WBH), scr, r, F.lane, RMapId()); continue; } r -= I_BH;
        if (r < I_OUT) { transpose_item(F.in[IN_WOUT], DM, DM, (bf16_t*)(F.ws + WS_WOUT), scr, r, F.lane, RMapId()); continue; } r -= I_OUT;
        if (r < I_UP) { transpose_item(F.in[IN_WUP], DM, 2 * DFF, (bf16_t*)(F.ws + WS_WUP), scr, r, F.lane, RMapUp()); continue; } r -= I_UP;
        transpose_item(F.in[IN_WDN], DFF, DM, (bf16_t*)(F.ws + WS_WDN), scr, r, F.lane, RMapId());
    }
    const int gt = F.vcu * 512 + F.tid, NGT = F.G * 512;
    for (int i = gt; i < 2 * NBS * 64 * 32; i += NGT) {
        const int kv = i / (NBS * 64 * 32), r = i % (NBS * 64 * 32), b = r / (64 * 32), q = r % (64 * 32);
        const f32x4 v = *(const f32x4*)(F.in[kv ? IN_CV : IN_CK] + (size_t)b * 128 * 128 + 64 * 128 + q * 4);
        *(f32x4*)(F.out + (kv ? OFF_NVS : OFF_NKS) + (size_t)b * 128 * 128 + q * 4) = v;
    }
}

__device__ __forceinline__ void ln_norm(f32x4 (&v)[4]) {
    float s = 0.f;
#pragma unroll
    for (int j = 0; j < 4; ++j) s += (v[j][0] + v[j][1]) + (v[j][2] + v[j][3]);
    const float mean = wave_sum(s) * (1.f / DM); float s2 = 0.f;
#pragma unroll
    for (int j = 0; j < 4; ++j) { v[j] = v[j] - mean; s2 += (v[j][0] * v[j][0] + v[j][1] * v[j][1]) + (v[j][2] * v[j][2] + v[j][3] * v[j][3]); }
    const float rstd = 1.f / sqrtf(wave_sum(s2) * (1.f / DM) + LN_EPS);
#pragma unroll
    for (int j = 0; j < 4; ++j) v[j] = v[j] * rstd;
}
__device__ __forceinline__ void store_row_bf16(bf16_t* orow, int lane, const f32x4 (&v)[4]) {
#pragma unroll
    for (int j = 0; j < 4; ++j) { u32x2 w; w.x = pk2(v[j][0], v[j][1]); w.y = pk2(v[j][2], v[j][3]); *(u32x2*)(orow + 4 * lane + 256 * j) = w; }
}
__device__ __forceinline__ void p1_ln_mod(Frame& F) {
    const int gw = F.vcu * NWAVES + F.wave, NGW = F.G * NWAVES; const float* mod = (const float*)(F.ws + WS_MOD); bf16_t* H = (bf16_t*)(F.ws + WS_H);
    for (int row = gw; row < M; row += NGW) {
        const float* xr = row < MP ? F.in[IN_XP] + (size_t)row * DM : F.in[IN_XS] + (size_t)(row - MP) * DM; const float* mr = mod + (size_t)mod_row(row) * 6144;
        f32x4 v[4];
#pragma unroll
        for (int j = 0; j < 4; ++j) v[j] = *(const f32x4*)(xr + 4 * F.lane + 256 * j);
        ln_norm(v);
#pragma unroll
        for (int j = 0; j < 4; ++j) { const f32x4 sh = *(const f32x4*)(mr + 4 * F.lane + 256 * j), sc = *(const f32x4*)(mr + 1024 + 4 * F.lane + 256 * j); v[j] = v[j] * (sc + 1.0f) + sh; }
        store_row_bf16(H + (size_t)row * DM, F.lane, v);
    }
}
__device__ __forceinline__ void p8_ln_mix(Frame& F) {
    const int gw = F.vcu * NWAVES + F.wave, NGW = F.G * NWAVES; const float* mod = (const float*)(F.ws + WS_MOD); bf16_t* H = (bf16_t*)(F.ws + WS_H);
    const float* Z1 = (const float*)(F.ws + WS_Z1); float* X1 = (float*)(F.ws + WS_X1);
    f32x4 gg[4], bb[4];
#pragma unroll
    for (int j = 0; j < 4; ++j) { gg[j] = *(const f32x4*)(F.in[IN_LNMG] + 4 * F.lane + 256 * j); bb[j] = *(const f32x4*)(F.in[IN_LNMB] + 4 * F.lane + 256 * j); }
    for (int row = gw; row < M; row += NGW) {
        const float* mr = mod + (size_t)mod_row(row) * 6144;
        f32x4 v[4];
#pragma unroll
        for (int j = 0; j < 4; ++j) v[j] = *(const f32x4*)(Z1 + (size_t)row * DM + 4 * F.lane + 256 * j);
        ln_norm(v);
#pragma unroll
        for (int j = 0; j < 4; ++j) { v[j] = v[j] * gg[j] + bb[j]; *(f32x4*)(X1 + (size_t)row * DM + 4 * F.lane + 256 * j) = v[j]; }
        ln_norm(v);
#pragma unroll
        for (int j = 0; j < 4; ++j) { const f32x4 sh = *(const f32x4*)(mr + 3072 + 4 * F.lane + 256 * j), sc = *(const f32x4*)(mr + 4096 + 4 * F.lane + 256 * j); v[j] = v[j] * (sc + 1.0f) + sh; }
        store_row_bf16(H + (size_t)row * DM, F.lane, v);
    }
}
__device__ __forceinline__ void p11_ln_out(Frame& F) {
    const int gw = F.vcu * NWAVES + F.wave, NGW = F.G * NWAVES;
    f32x4 gg[4], bb[4];
#pragma unroll
    for (int j = 0; j < 4; ++j) { gg[j] = *(const f32x4*)(F.in[IN_LNFG] + 4 * F.lane + 256 * j); bb[j] = *(const f32x4*)(F.in[IN_LNFB] + 4 * F.lane + 256 * j); }
    for (int row = gw; row < M; row += NGW) {
        float* zr = F.out + (size_t)row * DM;
        f32x4 v[4];
#pragma unroll
        for (int j = 0; j < 4; ++j) v[j] = *(const f32x4*)(zr + 4 * F.lane + 256 * j);
        ln_norm(v);
#pragma unroll
        for (int j = 0; j < 4; ++j) *(f32x4*)(zr + 4 * F.lane + 256 * j) = v[j] * gg[j] + bb[j];
    }
}

__device__ __forceinline__ void attn_simple(Frame& F) {
    bf16_t* QB = (bf16_t*)(F.ws + WS_QB); const bf16_t* KB = (const bf16_t*)(F.ws + WS_KB); const bf16_t* VB = (const bf16_t*)(F.ws + WS_VB);
    LAS bf16_t* Ks = (LAS bf16_t*)F.lds; LAS bf16_t* Vs = (LAS bf16_t*)(F.lds + 192 * 64 * 2);
    for (int unit = F.vcu; unit < 544 * 2; unit += F.G) {
        const int ci = unit >> 1, j = unit & 1; const bool samp = ci >= 512;
        const int row0 = samp ? MP + (ci - 512) * DSEQ : (ci >> 7) * SEQ + (ci & 127) * 64; const int c = ci & 127;
        for (int idx = F.tid; idx < 192 * 8 * 2; idx += 512) { const int kv = idx / (192 * 8), r = idx % (192 * 8), i = r >> 3, ch = r & 7;
            u32x4 w = (u32x4){0u, 0u, 0u, 0u};
            if (samp && i < 128) { const float* src = F.in[kv ? IN_CV : IN_CK] + ((size_t)((ci - 512) * 128 + i) * 2 + j) * 64 + ch * 8;
                const f32x4 a = *(const f32x4*)src, b = *(const f32x4*)(src + 4); w.x = pk2(a[0], a[1]); w.y = pk2(a[2], a[3]); w.z = pk2(b[0], b[1]); w.w = pk2(b[2], b[3]); }
            else if (samp || c * 64 - 128 + i >= 0) { const size_t krow = (size_t)(row0 - 128 + i); w = *(const u32x4*)((kv ? VB : KB) + krow * 128 + j * 64 + ch * 8); }
            *(LAS u32x4*)((kv ? Vs : Ks) + i * 64 + ch * 8) = w; }
        __syncthreads();
        if (F.tid < 256) {
            const int g = F.tid >> 6, t = F.tid & 63, hq = 4 * j + g; bf16_t* qp = QB + (size_t)(row0 + t) * 512 + hq * 64;
            float q[64], o[64];
#pragma unroll
            for (int ch = 0; ch < 8; ++ch) { const u32x4 w = *(const u32x4*)(qp + ch * 8);
                q[ch * 8 + 0] = __uint_as_float(w.x << 16); q[ch * 8 + 1] = __uint_as_float(w.x & 0xffff0000u); q[ch * 8 + 2] = __uint_as_float(w.y << 16); q[ch * 8 + 3] = __uint_as_float(w.y & 0xffff0000u);
                q[ch * 8 + 4] = __uint_as_float(w.z << 16); q[ch * 8 + 5] = __uint_as_float(w.z & 0xffff0000u); q[ch * 8 + 6] = __uint_as_float(w.w << 16); q[ch * 8 + 7] = __uint_as_float(w.w & 0xffff0000u); }
#pragma unroll
            for (int d = 0; d < 64; ++d) o[d] = 0.f;
            const float slope = exp2f(-(float)(hq + 1)); float mx = F.in[IN_SINK][hq], l = 1.f;
            const int i0 = samp ? 0 : (128 - c * 64 > 0 ? 128 - c * 64 : 0);
            for (int i = i0; i < 192; ++i) {
                float s = 0.f;
#pragma unroll
                for (int d2 = 0; d2 < 32; ++d2) { const unsigned kw = *(LAS unsigned*)(Ks + i * 64 + 2 * d2); s += q[2 * d2] * __uint_as_float(kw << 16) + q[2 * d2 + 1] * __uint_as_float(kw & 0xffff0000u); }
                s -= slope * fabsf((float)(128 + t - i));
                const float mn = fmaxf(mx, s), sc = __expf(mx - mn), p = __expf(s - mn); l = l * sc + p; mx = mn;
#pragma unroll
                for (int d2 = 0; d2 < 32; ++d2) { const unsigned vw = *(LAS unsigned*)(Vs + i * 64 + 2 * d2);
                    o[2 * d2] = o[2 * d2] * sc + p * __uint_as_float(vw << 16); o[2 * d2 + 1] = o[2 * d2 + 1] * sc + p * __uint_as_float(vw & 0xffff0000u); }
            }
            const float rl = 1.f / l;
#pragma unroll
            for (int ch = 0; ch < 8; ++ch) { u32x4 w; w.x = pk2(o[ch * 8] * rl, o[ch * 8 + 1] * rl); w.y = pk2(o[ch * 8 + 2] * rl, o[ch * 8 + 3] * rl); w.z = pk2(o[ch * 8 + 4] * rl, o[ch * 8 + 5] * rl); w.w = pk2(o[ch * 8 + 6] * rl, o[ch * 8 + 7] * rl);
                *(u32x4*)(qp + ch * 8) = w; }
        }
        __syncthreads();
    }
}

__device__ __forceinline__ void hgrn_simple(Frame& F) {
    const bf16_t* HQ = (const bf16_t*)(F.ws + WS_HQ); const bf16_t* HZ = (const bf16_t*)(F.ws + WS_HZ); const bf16_t* HV = (const bf16_t*)(F.ws + WS_HV); const bf16_t* HG = (const bf16_t*)(F.ws + WS_HG);
    bf16_t* YH = (bf16_t*)(F.ws + WS_YH);
    LAS float* fs = (LAS float*)F.lds; LAS float* ks = fs + 128; LAS float* qs = fs + 256; LAS float* vs = fs + 384; LAS float* op = fs + 512; LAS float* red = fs + 1024;
    const int e = F.tid & 127, dq = F.tid >> 7;
    for (int unit = F.vcu; unit < NMOD * 8; unit += F.G) {
        const int sidx = unit < 32 ? unit >> 3 : 4 + ((unit - 32) >> 3), h = unit & 7;
        const int T = sidx < NBP ? SEQ : DSEQ, rbase = sidx < NBP ? sidx * SEQ : MP + (sidx - NBP) * DSEQ, col = h * 128;
        float S[32];
#pragma unroll
        for (int i = 0; i < 32; ++i) S[i] = sidx < NBP ? 0.f : F.in[IN_ST][((size_t)((sidx - NBP) * 8 + h) * 128 + 32 * dq + i) * 128 + e];
        float lb = 0.f, nw = 0.f;
        if (F.tid < 128) { const float l0 = F.in[IN_LBL][col + F.tid], l1 = F.in[IN_LBL][1024 + col + F.tid]; lb = 1.f / (1.f + __expf(l1 - l0)); nw = F.in[IN_NORMW][col + F.tid]; }
        for (int t = 0; t < T; ++t) {
            const size_t ro = (size_t)(rbase + t) * DM + col;
            if (F.tid < 128) { const float z = bf2f(HZ[ro + F.tid]), sg = 1.f / (1.f + __expf(-z)); fs[F.tid] = lb + (1.f - lb) * sg; ks[F.tid] = (1.f - lb) * (1.f - sg); qs[F.tid] = bf2f(HQ[ro + F.tid]); }
            else if (F.tid < 256) vs[F.tid - 128] = bf2f(HV[ro + F.tid - 128]);
            __syncthreads();
            const float v = vs[e]; float part = 0.f;
#pragma unroll
            for (int i = 0; i < 32; ++i) { const int d = 32 * dq + i; S[i] = fs[d] * S[i] + ks[d] * v; part += S[i] * qs[d]; }
            op[dq * 128 + e] = part;
            __syncthreads();
            float o = 0.f;
            if (F.tid < 128) { o = (op[e] + op[128 + e]) + (op[256 + e] + op[384 + e]); const float ss = wave_sum(o * o); if (F.lane == 0) red[F.wave] = ss; }
            __syncthreads();
            if (F.tid < 128) { const float r = 1.f / sqrtf((red[0] + red[1]) * (1.f / 128.f) + RMS_EPS); YH[ro + e] = (bf16_t)f2bf(o * r * nw * bf2f(HG[ro + e])); }
        }
        float* so = F.out + (sidx < NBP ? OFF_NSP + (size_t)(sidx * 8 + h) * 16384 : OFF_NSS + (size_t)((sidx - NBP) * 8 + h) * 16384);
#pragma unroll
        for (int i = 0; i < 32; ++i) so[(size_t)(32 * dq + i) * 128 + e] = S[i];
        __syncthreads();
    }
}
struct Args { const float* in[22]; float* out; unsigned char* ws; int ph_lo, ph_hi; };
__global__ void __launch_bounds__(NWAVES * 64, 2) fwd(Args args) {
    extern __shared__ __attribute__((aligned(16))) unsigned char lds[];
    Frame F;
    F.lds = (LAS unsigned char*)lds;
    F.tid = threadIdx.x; F.lane = F.tid & 63; F.wave = __builtin_amdgcn_readfirstlane(F.tid >> 6);
    F.G = gridDim.x; { const int bx = blockIdx.x; F.vcu = (F.G % 8 == 0) ? (bx % 8) * (F.G / 8) + bx / 8 : bx; }
#pragma unroll
    for (int i = 0; i < 22; ++i) F.in[i] = args.in[i];
    F.out = args.out; F.ws = args.ws;
    cooperative_groups::grid_group grid = cooperative_groups::this_grid();
    const int lo = args.ph_lo, hi = args.ph_hi;
#define IN(k) (lo <= (k) && (k) < hi)
#define SEAM(k) do { if (IN(k) && IN((k) + 1)) { grid.sync(); } } while (0)
    unsigned char* ws = args.ws;
    bf16_t* H = (bf16_t*)(ws + WS_H);

    if (IN(0)) { p0_prologue(F); }
    SEAM(0);
    if (IN(1)) { p1_ln_mod(F); }
    SEAM(1);
    if (IN(2)) {
        pg8::Gemm g{H, (const bf16_t*)(ws + WS_WIN), M, INW, DM}; pg8::StaticOrder S; S.init(M, INW, F.G, (int)blockIdx.x);
        pg8::EpiProj E{(bf16_t*)(ws + WS_QB), (bf16_t*)(ws + WS_KB), (bf16_t*)(ws + WS_VB), (bf16_t*)(ws + WS_HQ), (bf16_t*)(ws + WS_HZ), (bf16_t*)(ws + WS_HV), (bf16_t*)(ws + WS_HG), (bf16_t*)F.out, F.out};
        pg8::gemm_phase<pg8::EpiProj, pg8::StaticOrder, true, true>(F.lds, g, S, E);
    }
    SEAM(2);
    if (IN(3)) {
        attn_simple(F);
        hgrn_simple(F);
    }
    SEAM(3);
    if (IN(6)) {
        { pg8::Gemm g{(const bf16_t*)(ws + WS_QB), (const bf16_t*)(ws + WS_WBA), M, DM, 512}; pg8::StaticOrder S; S.init(M, DM, F.G, (int)blockIdx.x);
          pg8::EpiMerge<true> E{(const bf16_t*)F.out, nullptr, (bf16_t*)(ws + WS_T1)};
          pg8::gemm_phase<pg8::EpiMerge<true>, pg8::StaticOrder, true, true>(F.lds, g, S, E); }
        __syncthreads();
        { pg8::Gemm g{(const bf16_t*)(ws + WS_YH), (const bf16_t*)(ws + WS_WBH), M, DM, DM}; pg8::StaticOrder S; S.init(M, DM, F.G, (int)blockIdx.x);
          pg8::EpiMerge<false> E{(const bf16_t*)F.out, (const bf16_t*)(ws + WS_T1), (bf16_t*)(ws + WS_MERGED)};
          pg8::gemm_phase<pg8::EpiMerge<false>, pg8::StaticOrder, true, true>(F.lds, g, S, E); }
    }
    SEAM(6);
    if (IN(7)) {
        pg8::Gemm g{(const bf16_t*)(ws + WS_MERGED), (const bf16_t*)(ws + WS_WOUT), M, DM, DM}; pg8::StaticOrder S; S.init(M, DM, F.G, (int)blockIdx.x);
        pg8::EpiResid E{F.in[IN_XP], F.in[IN_XS], (const float*)(ws + WS_MOD) + 2048, (float*)(ws + WS_Z1), ALPHA};
        pg8::gemm_phase<pg8::EpiResid, pg8::StaticOrder, true, true>(F.lds, g, S, E);
    }
    SEAM(7);
    if (IN(8)) { p8_ln_mix(F); }
    SEAM(8);
    if (IN(9)) {
        pg8::Gemm g{H, (const bf16_t*)(ws + WS_WUP), M, 2 * DFF, DM}; pg8::StaticOrder S; S.init(M, 2 * DFF, F.G, (int)blockIdx.x);
        pg8::EpiSwiGLU E{(bf16_t*)(ws + WS_ACT)};
        pg8::gemm_phase<pg8::EpiSwiGLU, pg8::StaticOrder, true, true>(F.lds, g, S, E);
    }
    SEAM(9);
    if (IN(10)) {
        pg8::Gemm g{(const bf16_t*)(ws + WS_ACT), (const bf16_t*)(ws + WS_WDN), M, DM, DFF}; pg8::StaticOrder S; S.init(M, DM, F.G, (int)blockIdx.x);
        const float* X1 = (const float*)(ws + WS_X1);
        pg8::EpiResid E{X1, X1 + (size_t)MP * DM, (const float*)(ws + WS_MOD) + 5120, F.out, ALPHA};
        pg8::gemm_phase<pg8::EpiResid, pg8::StaticOrder, true, true>(F.lds, g, S, E);
    }
    SEAM(10);
    if (IN(11)) { p11_ln_out(F); }
#undef IN
#undef SEAM
}

extern "C" void kernel_launch(void* const* d_in, const int* in_sizes, int n_in, void* d_out, int out_size, void* d_ws, size_t ws_size, hipStream_t stream) {
    static int grid = 0;
    if (grid == 0) {
        if (n_in != 22 || out_size != 41549824 || ws_size < WS_END) { fprintf(stderr, "kernel_launch: unexpected problem (n_in %d, out %d, ws %zu)\n", n_in, out_size, ws_size); grid = -1; return; }
        int dev = 0, cus = 0, per_cu = 0;
        if (hipGetDevice(&dev) != hipSuccess || hipDeviceGetAttribute(&cus, hipDeviceAttributeMultiprocessorCount, dev) != hipSuccess) { grid = -1; return; }
        if (hipFuncSetAttribute((const void*)fwd, hipFuncAttributeMaxDynamicSharedMemorySize, LDS_BYTES) != hipSuccess) { fprintf(stderr, "kernel_launch: hipFuncSetAttribute failed\n"); grid = -1; return; }
        if (hipOccupancyMaxActiveBlocksPerMultiprocessor(&per_cu, (const void*)fwd, NWAVES * 64, LDS_BYTES) != hipSuccess || per_cu < 1) { fprintf(stderr, "kernel_launch: occupancy query says %d\n", per_cu); (void)hipGetLastError(); grid = -1; return; }
        grid = cus;
    }
    if (grid < 0) return;
    (void)hipMemsetAsync((char*)d_ws + WS_CTL, 0, CTL_ZERO_BYTES, stream);
    Args a{};
    for (int i = 0; i < 22; ++i) a.in[i] = (const float*)d_in[i];
    a.out = (float*)d_out; a.ws = (unsigned char*)d_ws;
#if MK_N_LAUNCHES == 1
    a.ph_lo = 0; a.ph_hi = N_PHASES;
    void* kargs[] = {&a};
    hipError_t e = hipLaunchCooperativeKernel((const void*)fwd, dim3(grid), dim3(NWAVES * 64), kargs, LDS_BYTES, stream);
    if (e != hipSuccess) fprintf(stderr, "kernel_launch: cooperative launch failed: %s\n", hipGetErrorString(e));
#else
    for (int p = 0; p < N_PHASES; ++p) {
        if (p == 4 || p == 5) { if (!HGRN_IMPL) continue; }
        a.ph_lo = p; a.ph_hi = p + 1;
        hipLaunchKernelGGL(fwd, dim3(grid), dim3(NWAVES * 64), LDS_BYTES, stream, a);
    }
#endif
}
```

```cpp
#define MK_N_LAUNCHES 1
#include <hip/hip_runtime.h>
#include <hip/hip_cooperative_groups.h>
#include <cstdio>
#include <cstdint>
namespace pg8 {
#define PG8_LAS __attribute__((address_space(3)))
typedef unsigned short bf16_t;
typedef short bf16x8 __attribute__((ext_vector_type(8)));
typedef float f32x4 __attribute__((ext_vector_type(4)));
typedef unsigned u32x4 __attribute__((ext_vector_type(4)));
constexpr int BM = 256, BK = 64, HALF = 128, HTB = HALF * BK * 2  , STAGE_BYTES = 8 * HTB, NXCD = 8, WGM = 8;

__host__ __device__ __forceinline__ int lds_byte(int r, int c) { const int st = (r >> 4) * 2 + (c >> 5), rr = r & 15, cc = c & 31, ob = rr * 64 + cc * 2; return st * 1024 + (ob ^ (((ob >> 9) & 1) << 5)); }
__host__ __device__ __forceinline__ void stage_rc(int b, int& R, int& C) { const int st = b / 1024, sb = b % 1024, swz = sb ^ (((sb >> 9) & 1) << 5); R = (st >> 1) * 16 + swz / 64; C = (st & 1) * 32 + (swz % 64) / 2; }
__host__ __device__ __forceinline__ int perm32(int rho) { const int n = rho >> 4, i = rho & 15; return 8 * (i >> 2) + 4 * n + (i & 3); }

struct Unit { int pm, pn; };
struct Gemm { const bf16_t* A; const bf16_t* Bt; int M, N, K; };

struct StaticOrder {
    int nM, nN, nwg, G, c;
    __host__ __device__ void init(int M, int N, int G_, int c_) { nM = M / BM; nN = N / BM; nwg = nM * nN; G = G_; c = c_; }
    __host__ __device__ bool next(int i, Unit& u) const {
        const long L = (long)i * G + c; if (L >= nwg) return false;
        int wgid = (int)L; { const int q = nwg / NXCD, r = nwg % NXCD, xcd = wgid % NXCD, off = wgid / NXCD; wgid = (xcd < r ? xcd * (q + 1) : r * (q + 1) + (xcd - r) * q) + off; }
        const int nig = WGM * nN, gid = wgid / nig, fm = gid * WGM, gsz = (nM - fm) < WGM ? (nM - fm) : WGM;
        u.pm = fm + ((wgid % nig) % gsz); u.pn = (wgid % nig) / gsz; return true;
    }
    __device__ __forceinline__ void a_ready(const Unit&) const {}
    __device__ __forceinline__ void done(const Unit&) const {}
};

__device__ __forceinline__ unsigned cvt_pk_bf16(float lo, float hi) { unsigned r; asm volatile("v_cvt_pk_bf16_f32 %0, %1, %2" : "=v"(r) : "v"(lo), "v"(hi)); return r; }
typedef float f32x2 __attribute__((ext_vector_type(2)));
__device__ __forceinline__ float bf2f(unsigned short b) { return __uint_as_float(((unsigned)b) << 16); }
__device__ __forceinline__ float fsigmoid(float x) { return __builtin_amdgcn_rcpf(1.0f + __expf(-x)); }
__device__ __forceinline__ float fsilu(float x) { return x * fsigmoid(x); }
__device__ __forceinline__ int mod_row(int row) { return row < 32768 ? (row >> 13) : 4 + ((row - 32768) >> 6); }
constexpr int OFF_NKP = 35651584, OFF_NVP = 35717120, OFF_NSP = 35782656, OFF_NKS = 36306944, OFF_NVS = 36831232, OFF_NSS = 37355520;

struct EpiProj {
    static constexpr bool PERM = true, AFTER_DRAIN = false;
    bf16_t *QB, *KB, *VB, *HQ, *HZ, *HV, *HG, *GT; float* dout;
    __device__ __forceinline__ void operator()(const f32x4 (&acc)[2][2][4][2], const Unit& u, int wr, int wc, int fr, int fq) const {
        const int pn = u.pn, row0 = u.pm * BM + wr * 64 + fr, cl = wc * 32 + 8 * fq;
        if (pn == 2) {
#pragma unroll
            for (int ai = 0; ai < 2; ++ai)
#pragma unroll
                for (int m = 0; m < 4; ++m) { const int row = row0 + ai * HALF + m * 16;
                    float* wdst = nullptr;
                    if (row < 32768) { const int t = row & 8191; if (t >= 8064) wdst = dout + OFF_NKP + (size_t)(((row >> 13) * 128 + (t - 8064)) * 128 + cl); }
                    else { const int r2 = row - 32768; wdst = dout + OFF_NKS + (size_t)(((r2 >> 6) * 128 + 64 + (r2 & 63)) * 128 + cl); }
#pragma unroll
                    for (int bj = 0; bj < 2; ++bj) { const f32x4 v0 = acc[ai][bj][m][0], v1 = acc[ai][bj][m][1];
                        u32x4 w; w.x = cvt_pk_bf16(v0[0], v0[1]); w.y = cvt_pk_bf16(v0[2], v0[3]); w.z = cvt_pk_bf16(v1[0], v1[1]); w.w = cvt_pk_bf16(v1[2], v1[3]);
                        *(u32x4*)((bj == 0 ? KB : VB) + (size_t)row * 128 + cl) = w;
                        if (wdst) { float* d = wdst + (bj == 0 ? 0 : (row < 32768 ? (OFF_NVP - OFF_NKP) : (OFF_NVS - OFF_NKS))); *(f32x4*)d = v0; *(f32x4*)(d + 4) = v1; } } }
            return;
        }
        int mode; bf16_t* base; int ldc, cb;
        if (pn < 2)       { mode = 0; base = QB; ldc = 512;  cb = pn * 256; }
        else if (pn < 7)  { mode = 1; base = HQ; ldc = 1024; cb = (pn - 3) * 256; }
        else if (pn < 11) { mode = 3; base = HZ; ldc = 1024; cb = (pn - 7) * 256; }
        else if (pn < 15) { mode = 3; base = HV; ldc = 1024; cb = (pn - 11) * 256; }
        else if (pn < 19) { mode = 1; base = HG; ldc = 1024; cb = (pn - 15) * 256; }
        else              { mode = 2; base = GT; ldc = 2048; cb = (pn - 19) * 256; }
#pragma unroll
        for (int ai = 0; ai < 2; ++ai)
#pragma unroll
            for (int m = 0; m < 4; ++m) { bf16_t* rowp = base + (size_t)(row0 + ai * HALF + m * 16) * ldc + cb + cl;
#pragma unroll
                for (int bj = 0; bj < 2; ++bj) { f32x4 v0 = acc[ai][bj][m][0], v1 = acc[ai][bj][m][1];
                    if (mode == 0) { v0 = v0 * 0.125f; v1 = v1 * 0.125f; }
                    else if (mode == 1) {
#pragma unroll
                        for (int i = 0; i < 4; ++i) { v0[i] = fsilu(v0[i]); v1[i] = fsilu(v1[i]); } }
                    else if (mode == 2) {
#pragma unroll
                        for (int i = 0; i < 4; ++i) { v0[i] = fsigmoid(v0[i]); v1[i] = fsigmoid(v1[i]); } }
                    u32x4 w; w.x = cvt_pk_bf16(v0[0], v0[1]); w.y = cvt_pk_bf16(v0[2], v0[3]); w.z = cvt_pk_bf16(v1[0], v1[1]); w.w = cvt_pk_bf16(v1[2], v1[3]);
                    *(u32x4*)(rowp + bj * HALF) = w; } }
    }
};
struct EpiSwiGLU {
    static constexpr bool PERM = true, AFTER_DRAIN = false;
    bf16_t* O;
    __device__ __forceinline__ void operator()(const f32x4 (&acc)[2][2][4][2], const Unit& u, int wr, int wc, int fr, int fq) const {
        const int row0 = u.pm * BM + wr * 64 + fr, col = u.pn * 128 + wc * 32 + 8 * fq;
#pragma unroll
        for (int ai = 0; ai < 2; ++ai)
#pragma unroll
            for (int m = 0; m < 4; ++m) { f32x4 v0, v1;
#pragma unroll
                for (int i = 0; i < 4; ++i) { v0[i] = fsilu(acc[ai][1][m][0][i]) * acc[ai][0][m][0][i]; v1[i] = fsilu(acc[ai][1][m][1][i]) * acc[ai][0][m][1][i]; }
                u32x4 w; w.x = cvt_pk_bf16(v0[0], v0[1]); w.y = cvt_pk_bf16(v0[2], v0[3]); w.z = cvt_pk_bf16(v1[0], v1[1]); w.w = cvt_pk_bf16(v1[2], v1[3]);
                *(u32x4*)(O + (size_t)(row0 + ai * HALF + m * 16) * 2816 + col) = w; }
    }
};
template <bool FIRST> struct EpiMerge {
    static constexpr bool PERM = true, AFTER_DRAIN = false;
    const bf16_t* GT; const bf16_t* T1in; bf16_t* O;
    __device__ __forceinline__ void operator()(const f32x4 (&acc)[2][2][4][2], const Unit& u, int wr, int wc, int fr, int fq) const {
        const int row0 = u.pm * BM + wr * 64 + fr, col0 = u.pn * BM + wc * 32 + 8 * fq;
#pragma unroll
        for (int ai = 0; ai < 2; ++ai)
#pragma unroll
            for (int m = 0; m < 4; ++m) { const size_t row = (size_t)(row0 + ai * HALF + m * 16);
#pragma unroll
                for (int bj = 0; bj < 2; ++bj) { const int col = col0 + bj * HALF;
                    const u32x4 g = *(const u32x4*)(GT + row * 2048 + (FIRST ? 0 : 1024) + col);
                    f32x4 v0 = acc[ai][bj][m][0], v1 = acc[ai][bj][m][1];
                    v0[0] *= __uint_as_float(g.x << 16); v0[1] *= __uint_as_float(g.x & 0xffff0000u); v0[2] *= __uint_as_float(g.y << 16); v0[3] *= __uint_as_float(g.y & 0xffff0000u);
                    v1[0] *= __uint_as_float(g.z << 16); v1[1] *= __uint_as_float(g.z & 0xffff0000u); v1[2] *= __uint_as_float(g.w << 16); v1[3] *= __uint_as_float(g.w & 0xffff0000u);
                    if (!FIRST) { const u32x4 t = *(const u32x4*)(T1in + row * 1024 + col);
                        v0[0] += __uint_as_float(t.x << 16); v0[1] += __uint_as_float(t.x & 0xffff0000u); v0[2] += __uint_as_float(t.y << 16); v0[3] += __uint_as_float(t.y & 0xffff0000u);
                        v1[0] += __uint_as_float(t.z << 16); v1[1] += __uint_as_float(t.z & 0xffff0000u); v1[2] += __uint_as_float(t.w << 16); v1[3] += __uint_as_float(t.w & 0xffff0000u); }
                    u32x4 w; w.x = cvt_pk_bf16(v0[0], v0[1]); w.y = cvt_pk_bf16(v0[2], v0[3]); w.z = cvt_pk_bf16(v1[0], v1[1]); w.w = cvt_pk_bf16(v1[2], v1[3]);
                    *(u32x4*)(O + row * 1024 + col) = w; } }
    }
};
struct EpiResid {
    static constexpr bool PERM = false, AFTER_DRAIN = false;
    const float* xa; const float* xb; const float* gate;
    float* out; float alpha;
    __device__ __forceinline__ void operator()(const f32x4 (&acc)[2][2][4][2], const Unit& u, int wr, int wc, int fr, int fq) const {
        const int row0 = u.pm * BM + wr * 64 + fr, col0 = u.pn * BM + wc * 32 + 4 * fq;
#pragma unroll
        for (int ai = 0; ai < 2; ++ai)
#pragma unroll
            for (int m = 0; m < 4; ++m) { const int row = row0 + ai * HALF + m * 16;
                const float* xr = row < 32768 ? xa + (size_t)row * 1024 : xb + (size_t)(row - 32768) * 1024;
                const float* gr = gate + (size_t)mod_row(row) * 6144; float* orow = out + (size_t)row * 1024;
#pragma unroll
                for (int bj = 0; bj < 2; ++bj)
#pragma unroll
                    for (int n = 0; n < 2; ++n) { const int c = col0 + bj * HALF + n * 16;
                        const f32x4 xv = *(const f32x4*)(xr + c), gv = *(const f32x4*)(gr + c);
                        *(f32x4*)(orow + c) = xv * alpha + gv * acc[ai][bj][m][n]; } }
    }
};
template <class Epi, class Sched, bool ALIGN_EPI = false, bool SP2 = false>
__device__ __forceinline__ void gemm_phase(PG8_LAS unsigned char* lds, const Gemm g, const Sched& S, const Epi& E) {
    const int tid = threadIdx.x, wid = __builtin_amdgcn_readfirstlane(tid >> 6), lane = tid & 63, wr = wid >> 2, wc = wid & 3, fr = lane & 15, fq = lane >> 4;
    const int K = g.K, nt = K / BK;
    unsigned voffA[2], voffB[2];
#pragma unroll
    for (int i = 0; i < 2; ++i) { int R, C; stage_rc(tid * 16 + i * 8192, R, C); const int Rb = Epi::PERM ? ((R & ~31) + perm32(R & 31)) : R;
        voffA[i] = (unsigned)(R * K + C) * 2u; voffB[i] = (unsigned)(Rb * K + C) * 2u; }
    const size_t kstep = (size_t)(BK * 2);
    const size_t hstep = (size_t)HALF * K * 2;
    const size_t tstep = 2 * hstep;
    const unsigned ldsw = (unsigned)wid * 1024u;
    const int aoff = lds_byte(wr * 64 + fr, fq * 8), boff = lds_byte(wc * 32 + fr, fq * 8);
#define PG8_SA(b, h) (((b) * 2 + (h)) * HTB)
#define PG8_SB(b, h) ((4 + (b) * 2 + (h)) * HTB)
#define PG8_STAGE(bufoff, gbase, voff) do { _Pragma("unroll") for (int _i = 0; _i < 2; ++_i) \
        __builtin_amdgcn_global_load_lds((const unsigned*)((const char*)(gbase) + (voff)[_i]), (PG8_LAS unsigned*)(lds + (bufoff) + ldsw + _i * 8192), 16, 0, 0); } while (0)
#define PG8_LDA(dst, b, h) do { _Pragma("unroll") for (int m = 0; m < 4; ++m) _Pragma("unroll") for (int k = 0; k < 2; ++k) dst[m][k] = *(const PG8_LAS bf16x8*)(lds + PG8_SA(b, h) + aoff + m * 2048 + k * 1024); } while (0)
#define PG8_LDB(dst, b, h) do { _Pragma("unroll") for (int n = 0; n < 2; ++n) _Pragma("unroll") for (int k = 0; k < 2; ++k) dst[n][k] = *(const PG8_LAS bf16x8*)(lds + PG8_SB(b, h) + boff + n * 2048 + k * 1024); } while (0)
#define PG8_MMA(ai, bj, At, Bt) do { __builtin_amdgcn_s_setprio(1); _Pragma("unroll") for (int m = 0; m < 4; ++m) _Pragma("unroll") for (int n = 0; n < 2; ++n) _Pragma("unroll") for (int k = 0; k < 2; ++k) \
        acc[ai][bj][m][n] = __builtin_amdgcn_mfma_f32_16x16x32_bf16(Bt[n][k], At[m][k], acc[ai][bj][m][n], 0, 0, 0); __builtin_amdgcn_s_setprio(0); } while (0)
#define PG8_WAIT_V(n) asm volatile("s_waitcnt vmcnt(" #n ")" ::: "memory")
#define PG8_WAIT_L(n) asm volatile("s_waitcnt lgkmcnt(" #n ")" ::: "memory")
#define PG8_BAR __builtin_amdgcn_s_barrier()
#define PG8_SCHED __builtin_amdgcn_sched_barrier(0)
    Unit cur, nxt; int ui = 0;
    if (!S.next(0, cur)) return;
    f32x4 acc[2][2][4][2];
#pragma unroll
    for (int a = 0; a < 2; ++a)
#pragma unroll
        for (int b = 0; b < 2; ++b)
#pragma unroll
            for (int m = 0; m < 4; ++m)
#pragma unroll
                for (int n = 0; n < 2; ++n) acc[a][b][m][n] = (f32x4){0.f, 0.f, 0.f, 0.f};
    bf16x8 At[4][2], B0[2][2], B1[2][2];
    const char* cA = (const char*)g.A + (size_t)cur.pm * tstep; const char* cB = (const char*)g.Bt + (size_t)cur.pn * tstep;
    S.a_ready(cur);
    if constexpr (SP2) {
        PG8_STAGE(PG8_SB(0, 0), cB, voffB); PG8_STAGE(PG8_SB(0, 1), cB + hstep, voffB); PG8_STAGE(PG8_SA(0, 0), cA, voffA); PG8_STAGE(PG8_SA(0, 1), cA + hstep, voffA);
        if (wr == 1) PG8_BAR;
        PG8_WAIT_V(2); PG8_BAR;
        PG8_STAGE(PG8_SB(1, 0), cB + kstep, voffB); PG8_STAGE(PG8_SA(1, 0), cA + kstep, voffA); PG8_STAGE(PG8_SB(1, 1), cB + hstep + kstep, voffB);
        PG8_WAIT_V(6); PG8_BAR;
    } else {
        PG8_STAGE(PG8_SB(0, 0), cB, voffB); PG8_STAGE(PG8_SA(0, 0), cA, voffA); PG8_STAGE(PG8_SB(0, 1), cB + hstep, voffB); PG8_STAGE(PG8_SA(0, 1), cA + hstep, voffA);
        if (wr == 1) PG8_BAR;
        PG8_WAIT_V(4); PG8_BAR;
        PG8_STAGE(PG8_SB(1, 0), cB + kstep, voffB); PG8_STAGE(PG8_SA(1, 0), cA + kstep, voffA); PG8_STAGE(PG8_SB(1, 1), cB + hstep + kstep, voffB);
        PG8_WAIT_V(6); PG8_BAR;
    }
    for (;;) {
        const bool has_next = S.next(ui + 1, nxt);
        const char* nA = has_next ? (const char*)g.A + (size_t)nxt.pm * tstep : cA; const char* nB = has_next ? (const char*)g.Bt + (size_t)nxt.pn * tstep : cB;
        for (int t = 0; t < nt; t += 2) {
            const bool last = (t == nt - 2);
            const char* a1 = cA + (size_t)(t + 1) * kstep;
            const char* a2 = last ? nA : cA + (size_t)(t + 2) * kstep; const char* b2 = last ? nB : cB + (size_t)(t + 2) * kstep;
            const char* a3 = a2 + kstep; const char* b3 = b2 + kstep;
            if (last && has_next) S.a_ready(nxt);
            if constexpr (SP2) {
            PG8_LDB(B0, 0, 0); PG8_LDB(B1, 0, 1); PG8_SCHED; PG8_LDA(At, 0, 0); PG8_STAGE(PG8_SA(1, 1), a1 + hstep, voffA);
            PG8_WAIT_V(8); PG8_WAIT_L(0); PG8_BAR; PG8_MMA(0, 0, At, B0); PG8_MMA(0, 1, At, B1); PG8_BAR; PG8_SCHED;
            PG8_LDA(At, 0, 1); PG8_STAGE(PG8_SB(0, 0), b2, voffB); PG8_STAGE(PG8_SB(0, 1), b2 + hstep, voffB); PG8_STAGE(PG8_SA(0, 0), a2, voffA);
            PG8_WAIT_V(8); PG8_WAIT_L(0); PG8_BAR; PG8_MMA(1, 0, At, B0); PG8_MMA(1, 1, At, B1); PG8_BAR; PG8_SCHED;
            PG8_LDB(B0, 1, 0); PG8_LDB(B1, 1, 1); PG8_SCHED; PG8_LDA(At, 1, 0); PG8_STAGE(PG8_SA(0, 1), a2 + hstep, voffA);
            PG8_WAIT_V(8); PG8_WAIT_L(0); PG8_BAR; PG8_MMA(0, 0, At, B0); PG8_MMA(0, 1, At, B1); PG8_BAR; PG8_SCHED;
            PG8_LDA(At, 1, 1); PG8_STAGE(PG8_SB(1, 0), b3, voffB); PG8_STAGE(PG8_SB(1, 1), b3 + hstep, voffB); PG8_STAGE(PG8_SA(1, 0), a3, voffA);
            PG8_WAIT_V(8); PG8_WAIT_L(0); PG8_BAR; PG8_MMA(1, 0, At, B0); PG8_MMA(1, 1, At, B1); PG8_BAR; PG8_SCHED;
            } else {
            PG8_LDB(B0, 0, 0); PG8_SCHED; PG8_LDA(At, 0, 0); PG8_STAGE(PG8_SA(1, 1), a1 + hstep, voffA);
            PG8_WAIT_L(8); PG8_BAR; PG8_WAIT_L(0); PG8_MMA(0, 0, At, B0); PG8_BAR; PG8_SCHED;
            PG8_LDB(B1, 0, 1); PG8_STAGE(PG8_SB(0, 0), b2, voffB);
            PG8_BAR; PG8_WAIT_L(0); PG8_MMA(0, 1, At, B1); PG8_BAR;
            PG8_LDA(At, 0, 1); PG8_STAGE(PG8_SA(0, 0), a2, voffA);
            PG8_BAR; PG8_WAIT_L(0); PG8_MMA(1, 0, At, B0); PG8_BAR; PG8_SCHED;
            PG8_STAGE(PG8_SB(0, 1), b2 + hstep, voffB);
            PG8_WAIT_V(6); PG8_BAR; PG8_MMA(1, 1, At, B1); PG8_BAR;
            PG8_LDB(B0, 1, 0); PG8_SCHED; PG8_LDA(At, 1, 0); PG8_STAGE(PG8_SA(0, 1), a2 + hstep, voffA);
            PG8_WAIT_L(8); PG8_BAR; PG8_WAIT_L(0); PG8_MMA(0, 0, At, B0); PG8_BAR; PG8_SCHED;
            PG8_LDB(B1, 1, 1); PG8_STAGE(PG8_SB(1, 0), b3, voffB);
            PG8_BAR; PG8_WAIT_L(0); PG8_MMA(0, 1, At, B1); PG8_BAR;
            PG8_LDA(At, 1, 1); PG8_STAGE(PG8_SA(1, 0), a3, voffA);
            PG8_BAR; PG8_WAIT_L(0); PG8_MMA(1, 0, At, B0); PG8_BAR; PG8_SCHED;
            PG8_STAGE(PG8_SB(1, 1), b3 + hstep, voffB);
            PG8_WAIT_V(6); PG8_BAR; PG8_MMA(1, 1, At, B1); PG8_BAR;
            }
        }
        if constexpr (ALIGN_EPI) { if (wr == 0) PG8_BAR; }
        if constexpr (!Epi::AFTER_DRAIN) { E(acc, cur, wr, wc, fr, fq); S.done(cur); }
        if (!has_next) break;
#pragma unroll
        for (int a = 0; a < 2; ++a)
#pragma unroll
            for (int b = 0; b < 2; ++b)
#pragma unroll
                for (int m = 0; m < 4; ++m)
#pragma unroll
                    for (int n = 0; n < 2; ++n) acc[a][b][m][n] = (f32x4){0.f, 0.f, 0.f, 0.f};
        cur = nxt; cA = nA; cB = nB; ++ui;
        if constexpr (ALIGN_EPI) { if (wr == 1) PG8_BAR; }
    }
    PG8_WAIT_V(0);
    if constexpr (!ALIGN_EPI) { if (wr == 0) PG8_BAR; }
    PG8_BAR;
    if constexpr (Epi::AFTER_DRAIN) { E.fused(acc, cur, wr, wc, fr, fq, lds, wid, lane); S.done(cur); }
#undef PG8_SA
#undef PG8_SB
#undef PG8_STAGE
#undef PG8_LDA
#undef PG8_LDB
#undef PG8_MMA
#undef PG8_WAIT_V
#undef PG8_WAIT_L
#undef PG8_BAR
#undef PG8_SCHED
}
}
#define GAS __attribute__((address_space(1)))
#define LAS __attribute__((address_space(3)))
typedef unsigned short bf16;
typedef unsigned v4u __attribute__((ext_vector_type(4)));
typedef float f32x4 __attribute__((ext_vector_type(4)));
typedef short bf16x8 __attribute__((ext_vector_type(8)));
typedef GAS unsigned gu32;
typedef GAS unsigned long long gu64;
#define RLX_AGENT __ATOMIC_RELAXED, __HIP_MEMORY_SCOPE_AGENT
#define LDS_WAIT() asm volatile("s_waitcnt lgkmcnt(0)" ::: "memory")
#define VM_WAIT() asm volatile("s_waitcnt vmcnt(0)" ::: "memory")
__device__ __forceinline__ unsigned long long rt() { return __builtin_amdgcn_s_memrealtime(); }
__device__ __forceinline__ unsigned f2bf(float f) { unsigned u = __builtin_bit_cast(unsigned, f); return (u + 0x7fffu + ((u >> 16) & 1u)) >> 16; }
__device__ __forceinline__ unsigned pk2(float lo, float hi) { return f2bf(lo) | (f2bf(hi) << 16); }
#ifndef MK_N_LAUNCHES
#define MK_N_LAUNCHES 1
#endif
#ifndef ATTN_IMPL
#define ATTN_IMPL 0
#endif
#ifndef HGRN_IMPL
#define HGRN_IMPL 0
#endif
constexpr int NWAVES = 8;
constexpr int N_PHASES = 12;

constexpr int DM = 1024, SEQ = 8192, NBP = 4, NBS = 32, DSEQ = 64, MP = NBP * SEQ, MS = NBS * DSEQ, M = MP + MS;
constexpr int INW = 6912, DFF = 2816, NMOD = NBP + NBS;
constexpr float LN_EPS = 1e-5f, RMS_EPS = 1e-6f;
constexpr float ALPHA = 1.189207115002721f;
static_assert(M % 256 == 0 && INW % 256 == 0 && (2 * DFF) % 256 == 0, "tile shapes");

constexpr size_t MiB = 1u << 20, HMiB = 1u << 19;
constexpr size_t WS_CTL = 0, WS_MOD = 1 * MiB, CTL_ZERO_BYTES = 2 * MiB;
constexpr size_t WS_WIN = 2 * MiB, WS_WBA = 31 * HMiB, WS_WBH = 33 * HMiB, WS_WOUT = 37 * HMiB, WS_WUP = 41 * HMiB, WS_WDN = 63 * HMiB;
constexpr size_t WS_H = 37 * MiB, WS_QB = 105 * MiB, WS_KB = 139 * MiB, WS_VB = 295 * HMiB, WS_HQ = 156 * MiB, WS_HZ = 224 * MiB, WS_HV = 292 * MiB, WS_HG = 360 * MiB;
constexpr size_t WS_U = 428 * MiB, WS_D = 492 * MiB, WS_END = 985 * HMiB;
constexpr size_t WS_YH = WS_H, WS_T1 = WS_HQ, WS_MERGED = WS_HZ, WS_Z1 = WS_HV, WS_X1 = WS_HQ, WS_ACT = WS_HV;
static_assert(WS_WIN + (size_t)INW * DM * 2 == WS_WBA && WS_WBA + 512 * 1024 * 2 == WS_WBH && WS_WBH + 1024 * 1024 * 2 == WS_WOUT && WS_WOUT + 1024 * 1024 * 2 == WS_WUP &&
              WS_WUP + (size_t)2 * DFF * DM * 2 == WS_WDN && WS_WDN + (size_t)DM * DFF * 2 == WS_H && WS_H + (size_t)M * DM * 2 == WS_QB && WS_QB + (size_t)M * 512 * 2 == WS_KB &&
              WS_KB + (size_t)M * 128 * 2 == WS_VB && WS_VB + (size_t)M * 128 * 2 == WS_HQ && WS_HQ + (size_t)M * DM * 2 == WS_HZ && WS_HG + (size_t)M * DM * 2 == WS_U &&
              WS_ACT + (size_t)M * DFF * 2 <= WS_D && WS_END <= 512 * MiB, "d_ws map");
constexpr int CW_BAR = 4096;

constexpr int RING_BYTES = 131072, LDSCTL_OFF = RING_BYTES, MISC_OFF = LDSCTL_OFF + 320, LDS_BYTES = 147456;

typedef unsigned short bf16_t;
typedef unsigned u32x4 __attribute__((ext_vector_type(4)));
typedef unsigned u32x2 __attribute__((ext_vector_type(2)));
using pg8::bf2f; using pg8::fsigmoid; using pg8::fsilu; using pg8::mod_row;
using pg8::OFF_NKP; using pg8::OFF_NVP; using pg8::OFF_NSP; using pg8::OFF_NKS; using pg8::OFF_NVS; using pg8::OFF_NSS;

struct Frame {
    LAS unsigned char* lds;
    int tid, lane, wave, vcu, G;
    const float* in[22]; float* out; unsigned char* ws;
};
#define IN_XP 0
#define IN_XS 1
#define IN_CK 2
#define IN_CV 3
#define IN_ST 4
#define IN_CP 5
#define IN_CS 6
#define IN_WADA 7
#define IN_BADA 8
#define IN_WIN 9
#define IN_SINK 10
#define IN_LBL 11
#define IN_NORMW 12
#define IN_WBA 13
#define IN_WBH 14
#define IN_WOUT 15
#define IN_LNMG 16
#define IN_LNMB 17
#define IN_WUP 18
#define IN_WDN 19
#define IN_LNFG 20
#define IN_LNFB 21

__device__ __forceinline__ float wave_sum(float v) {
#pragma unroll
    for (int o = 1; o < 64; o <<= 1) v += __shfl_xor(v, o);
    return v;
}
template <class RMap>
__device__ __forceinline__ void transpose_item(const float* W, int K, int N, bf16_t* WT, LAS float* scr, int item, int lane, RMap rmap) {
    const int nblk = N / 32, kb = item / nblk, nb = item % nblk, k0 = 64 * kb, n0 = 32 * nb;
#pragma unroll 8
    for (int i = 0; i < 32; ++i) { const int kk = 2 * i + (lane >> 5); scr[kk * 33 + (lane & 31)] = W[(size_t)(k0 + kk) * N + n0 + (lane & 31)]; }
    LDS_WAIT(); asm volatile("" ::: "memory");
    const int c = lane & 7; const int nd0 = rmap(n0);
#pragma unroll
    for (int j = 0; j < 4; ++j) { const int n = (lane >> 3) + 8 * j; const LAS float* s = scr + (8 * c) * 33 + n;
        v4u o; o.x = pk2(s[0 * 33], s[1 * 33]); o.y = pk2(s[2 * 33], s[3 * 33]); o.z = pk2(s[4 * 33], s[5 * 33]); o.w = pk2(s[6 * 33], s[7 * 33]);
        *(GAS v4u*)(WT + (size_t)(nd0 + n) * K + k0 + 8 * c) = o; }
    LDS_WAIT(); asm volatile("" ::: "memory");
}
struct RMapId { __device__ __forceinline__ int operator()(int n0) const { return n0; } };
struct RMapUp { __device__ __forceinline__ int operator()(int n0) const { return n0 < DFF ? 256 * (n0 >> 7) + (n0 & 127) : 256 * ((n0 - DFF) >> 7) + 128 + ((n0 - DFF) & 127); } };

__device__ __forceinline__ void p0_prologue(Frame& F) {
    if (F.vcu < 192) {
        const int kc = F.vcu / 12, ec = F.vcu % 12, k0 = kc * 64, col = ec * 512 + F.tid;
        LAS float* sc = (LAS float*)F.lds;
        for (int i = F.tid; i < 64 * NMOD; i += 512) { const int kk = i / NMOD, mb = i % NMOD;
            const float cv = mb < NBP ? F.in[IN_CP][mb * DM + k0 + kk] : F.in[IN_CS][(mb - NBP) * DM + k0 + kk]; sc[kk * NMOD + mb] = fsilu(cv); }
        __syncthreads();
        float acc[NMOD];
#pragma unroll
        for (int i = 0; i < NMOD; ++i) acc[i] = 0.f;
        const float* wp = F.in[IN_WADA] + (size_t)k0 * 6144 + col;
#pragma unroll 4
        for (int kk = 0; kk < 64; ++kk) { const float w = wp[(size_t)kk * 6144];
#pragma unroll
            for (int i = 0; i < NMOD; ++i) acc[i] += sc[kk * NMOD + i] * w; }
        const float bias = kc == 0 ? F.in[IN_BADA][col] : 0.f;
        float* mod = (float*)(F.ws + WS_MOD);
#pragma unroll
        for (int i = 0; i < NMOD; ++i) atomicAdd(mod + i * 6144 + col, acc[i] + bias);
        __syncthreads();
    }
    LAS float* scr = (LAS float*)(F.lds + F.wave * 16384);
    const int gw = F.vcu * NWAVES + F.wave, NGW = F.G * NWAVES;
    constexpr int I_IN = (DM / 64) * (INW / 32), I_BA = (512 / 64) * (DM / 32), I_BH = (DM / 64) * (DM / 32), I_OUT = I_BH, I_UP = (DM / 64) * (2 * DFF / 32), I_DN = (DFF / 64) * (DM / 32);
    constexpr int NITEMS = I_IN + I_BA + I_BH + I_OUT + I_UP + I_DN;
    for (int it = gw; it < NITEMS; it += NGW) {
        int r = it;
        if (r < I_IN) { transpose_item(F.in[IN_WIN], DM, INW, (bf16_t*)(F.ws + WS_WIN), scr, r, F.lane, RMapId()); continue; } r -= I_IN;
        if (r < I_BA) { transpose_item(F.in[IN_WBA], 512, DM, (bf16_t*)(F.ws + WS_WBA), scr, r, F.lane, RMapId()); continue; } r -= I_BA;
        if (r < I_BH) { transpose_item(F.in[IN_WBH], DM, DM, (bf16_t*)(F.ws + WS_WBH), scr, r, F.lane, RMapId()); continue; } r -= I_BH;
        if (r < I_OUT) { transpose_item(F.in[IN_WOUT], DM, DM, (bf16_t*)(F.ws + WS_WOUT), scr, r, F.lane, RMapId()); continue; } r -= I_OUT;
        if (r < I_UP) { transpose_item(F.in[IN_WUP], DM, 2 * DFF, (bf16_t*)(F.ws + WS_WUP), scr, r, F.lane, RMapUp()); continue; } r -= I_UP;
        transpose_item(F.in[IN_WDN], DFF, DM, (bf16_t*)(F.ws + WS_WDN), scr, r, F.lane, RMapId());
    }
    const int gt = F.vcu * 512 + F.tid, NGT = F.G * 512;
    for (int i = gt; i < 2 * NBS * 64 * 32; i += NGT) {
        const int kv = i / (NBS * 64 * 32), r = i % (NBS * 64 * 32), b = r / (64 * 32), q = r % (64 * 32);
        const f32x4 v = *(const f32x4*)(F.in[kv ? IN_CV : IN_CK] + (size_t)b * 128 * 128 + 64 * 128 + q * 4);
        *(f32x4*)(F.out + (kv ? OFF_NVS : OFF_NKS) + (size_t)b * 128 * 128 + q * 4) = v;
    }
}

__device__ __forceinline__ void ln_norm(f32x4 (&v)[4]) {
    float s = 0.f;
#pragma unroll
    for (int j = 0; j < 4; ++j) s += (v[j][0] + v[j][1]) + (v[j][2] + v[j][3]);
    const float mean = wave_sum(s) * (1.f / DM); float s2 = 0.f;
#pragma unroll
    for (int j = 0; j < 4; ++j) { v[j] = v[j] - mean; s2 += (v[j][0] * v[j][0] + v[j][1] * v[j][1]) + (v[j][2] * v[j][2] + v[j][3] * v[j][3]); }
    const float rstd = 1.f / sqrtf(wave_sum(s2) * (1.f / DM) + LN_EPS);
#pragma unroll
    for (int j = 0; j < 4; ++j) v[j] = v[j] * rstd;
}
__device__ __forceinline__ void store_row_bf16(bf16_t* orow, int lane, const f32x4 (&v)[4]) {
#pragma unroll
    for (int j = 0; j < 4; ++j) { u32x2 w; w.x = pk2(v[j][0], v[j][1]); w.y = pk2(v[j][2], v[j][3]); *(u32x2*)(orow + 4 * lane + 256 * j) = w; }
}
__device__ __forceinline__ void p1_ln_mod(Frame& F) {
    const int gw = F.vcu * NWAVES + F.wave, NGW = F.G * NWAVES; const float* mod = (const float*)(F.ws + WS_MOD); bf16_t* H = (bf16_t*)(F.ws + WS_H);
    for (int row = gw; row < M; row += NGW) {
        const float* xr = row < MP ? F.in[IN_XP] + (size_t)row * DM : F.in[IN_XS] + (size_t)(row - MP) * DM; const float* mr = mod + (size_t)mod_row(row) * 6144;
        f32x4 v[4];
#pragma unroll
        for (int j = 0; j < 4; ++j) v[j] = *(const f32x4*)(xr + 4 * F.lane + 256 * j);
        ln_norm(v);
#pragma unroll
        for (int j = 0; j < 4; ++j) { const f32x4 sh = *(const f32x4*)(mr + 4 * F.lane + 256 * j), sc = *(const f32x4*)(mr + 1024 + 4 * F.lane + 256 * j); v[j] = v[j] * (sc + 1.0f) + sh; }
        store_row_bf16(H + (size_t)row * DM, F.lane, v);
    }
}
__device__ __forceinline__ void p8_ln_mix(Frame& F) {
    const int gw = F.vcu * NWAVES + F.wave, NGW = F.G * NWAVES; const float* mod = (const float*)(F.ws + WS_MOD); bf16_t* H = (bf16_t*)(F.ws + WS_H);
    const float* Z1 = (const float*)(F.ws + WS_Z1); float* X1 = (float*)(F.ws + WS_X1);
    f32x4 gg[4], bb[4];
#pragma unroll
    for (int j = 0; j < 4; ++j) { gg[j] = *(const f32x4*)(F.in[IN_LNMG] + 4 * F.lane + 256 * j); bb[j] = *(const f32x4*)(F.in[IN_LNMB] + 4 * F.lane + 256 * j); }
    for (int row = gw; row < M; row += NGW) {
        const float* mr = mod + (size_t)mod_row(row) * 6144;
        f32x4 v[4];
#pragma unroll
        for (int j = 0; j < 4; ++j) v[j] = *(const f32x4*)(Z1 + (size_t)row * DM + 4 * F.lane + 256 * j);
        ln_norm(v);
#pragma unroll
        for (int j = 0; j < 4; ++j) { v[j] = v[j] * gg[j] + bb[j]; *(f32x4*)(X1 + (size_t)row * DM + 4 * F.lane + 256 * j) = v[j]; }
        ln_norm(v);
#pragma unroll
        for (int j = 0; j < 4; ++j) { const f32x4 sh = *(const f32x4*)(mr + 3072 + 4 * F.lane + 256 * j), sc = *(const f32x4*)(mr + 4096 + 4 * F.lane + 256 * j); v[j] = v[j] * (sc + 1.0f) + sh; }
        store_row_bf16(H + (size_t)row * DM, F.lane, v);
    }
}
__device__ __forceinline__ void p11_ln_out(Frame& F) {
    const int gw = F.vcu * NWAVES + F.wave, NGW = F.G * NWAVES;
    f32x4 gg[4], bb[4];
#pragma unroll
    for (int j = 0; j < 4; ++j) { gg[j] = *(const f32x4*)(F.in[IN_LNFG] + 4 * F.lane + 256 * j); bb[j] = *(const f32x4*)(F.in[IN_LNFB] + 4 * F.lane + 256 * j); }
    for (int row = gw; row < M; row += NGW) {
        float* zr = F.out + (size_t)row * DM;
        f32x4 v[4];
#pragma unroll
        for (int j = 0; j < 4; ++j) v[j] = *(const f32x4*)(zr + 4 * F.lane + 256 * j);
        ln_norm(v);
#pragma unroll
        for (int j = 0; j < 4; ++j) *(f32x4*)(zr + 4 * F.lane + 256 * j) = v[j] * gg[j] + bb[j];
    }
}

__device__ __forceinline__ void attn_simple(Frame& F) {
    bf16_t* QB = (bf16_t*)(F.ws + WS_QB); const bf16_t* KB = (const bf16_t*)(F.ws + WS_KB); const bf16_t* VB = (const bf16_t*)(F.ws + WS_VB);
    LAS bf16_t* Ks = (LAS bf16_t*)F.lds; LAS bf16_t* Vs = (LAS bf16_t*)(F.lds + 192 * 64 * 2);
    for (int unit = F.vcu; unit < 544 * 2; unit += F.G) {
        const int ci = unit >> 1, j = unit & 1; const bool samp = ci >= 512;
        const int row0 = samp ? MP + (ci - 512) * DSEQ : (ci >> 7) * SEQ + (ci & 127) * 64; const int c = ci & 127;
        for (int idx = F.tid; idx < 192 * 8 * 2; idx += 512) { const int kv = idx / (192 * 8), r = idx % (192 * 8), i = r >> 3, ch = r & 7;
            u32x4 w = (u32x4){0u, 0u, 0u, 0u};
            if (samp && i < 128) { const float* src = F.in[kv ? IN_CV : IN_CK] + ((size_t)((ci - 512) * 128 + i) * 2 + j) * 64 + ch * 8;
                const f32x4 a = *(const f32x4*)src, b = *(const f32x4*)(src + 4); w.x = pk2(a[0], a[1]); w.y = pk2(a[2], a[3]); w.z = pk2(b[0], b[1]); w.w = pk2(b[2], b[3]); }
            else if (samp || c * 64 - 128 + i >= 0) { const size_t krow = (size_t)(row0 - 128 + i); w = *(const u32x4*)((kv ? VB : KB) + krow * 128 + j * 64 + ch * 8); }
            *(LAS u32x4*)((kv ? Vs : Ks) + i * 64 + ch * 8) = w; }
        __syncthreads();
        if (F.tid < 256) {
            const int g = F.tid >> 6, t = F.tid & 63, hq = 4 * j + g; bf16_t* qp = QB + (size_t)(row0 + t) * 512 + hq * 64;
            float q[64], o[64];
#pragma unroll
            for (int ch = 0; ch < 8; ++ch) { const u32x4 w = *(const u32x4*)(qp + ch * 8);
                q[ch * 8 + 0] = __uint_as_float(w.x << 16); q[ch * 8 + 1] = __uint_as_float(w.x & 0xffff0000u); q[ch * 8 + 2] = __uint_as_float(w.y << 16); q[ch * 8 + 3] = __uint_as_float(w.y & 0xffff0000u);
                q[ch * 8 + 4] = __uint_as_float(w.z << 16); q[ch * 8 + 5] = __uint_as_float(w.z & 0xffff0000u); q[ch * 8 + 6] = __uint_as_float(w.w << 16); q[ch * 8 + 7] = __uint_as_float(w.w & 0xffff0000u); }
#pragma unroll
            for (int d = 0; d < 64; ++d) o[d] = 0.f;
            const float slope = exp2f(-(float)(hq + 1)); float mx = F.in[IN_SINK][hq], l = 1.f;
            const int i0 = samp ? 0 : (128 - c * 64 > 0 ? 128 - c * 64 : 0);
            for (int i = i0; i < 192; ++i) {
                float s = 0.f;
#pragma unroll
                for (int d2 = 0; d2 < 32; ++d2) { const unsigned kw = *(LAS unsigned*)(Ks + i * 64 + 2 * d2); s += q[2 * d2] * __uint_as_float(kw << 16) + q[2 * d2 + 1] * __uint_as_float(kw & 0xffff0000u); }
                s -= slope * fabsf((float)(128 + t - i));
                const float mn = fmaxf(mx, s), sc = __expf(mx - mn), p = __expf(s - mn); l = l * sc + p; mx = mn;
#pragma unroll
                for (int d2 = 0; d2 < 32; ++d2) { const unsigned vw = *(LAS unsigned*)(Vs + i * 64 + 2 * d2);
                    o[2 * d2] = o[2 * d2] * sc + p * __uint_as_float(vw << 16); o[2 * d2 + 1] = o[2 * d2 + 1] * sc + p * __uint_as_float(vw & 0xffff0000u); }
            }
            const float rl = 1.f / l;
#pragma unroll
            for (int ch = 0; ch < 8; ++ch) { u32x4 w; w.x = pk2(o[ch * 8] * rl, o[ch * 8 + 1] * rl); w.y = pk2(o[ch * 8 + 2] * rl, o[ch * 8 + 3] * rl); w.z = pk2(o[ch * 8 + 4] * rl, o[ch * 8 + 5] * rl); w.w = pk2(o[ch * 8 + 6] * rl, o[ch * 8 + 7] * rl);
                *(u32x4*)(qp + ch * 8) = w; }
        }
        __syncthreads();
    }
}

__device__ __forceinline__ void hgrn_simple(Frame& F) {
    const bf16_t* HQ = (const bf16_t*)(F.ws + WS_HQ); const bf16_t* HZ = (const bf16_t*)(F.ws + WS_HZ); const bf16_t* HV = (const bf16_t*)(F.ws + WS_HV); const bf16_t* HG = (const bf16_t*)(F.ws + WS_HG);
    bf16_t* YH = (bf16_t*)(F.ws + WS_YH);
    LAS float* fs = (LAS float*)F.lds; LAS float* ks = fs + 128; LAS float* qs = fs + 256; LAS float* vs = fs + 384; LAS float* op = fs + 512; LAS float* red = fs + 1024;
    const int e = F.tid & 127, dq = F.tid >> 7;
    for (int unit = F.vcu; unit < NMOD * 8; unit += F.G) {
        const int sidx = unit < 32 ? unit >> 3 : 4 + ((unit - 32) >> 3), h = unit & 7;
        const int T = sidx < NBP ? SEQ : DSEQ, rbase = sidx < NBP ? sidx * SEQ : MP + (sidx - NBP) * DSEQ, col = h * 128;
        float S[32];
#pragma unroll
        for (int i = 0; i < 32; ++i) S[i] = sidx < NBP ? 0.f : F.in[IN_ST][((size_t)((sidx - NBP) * 8 + h) * 128 + 32 * dq + i) * 128 + e];
        float lb = 0.f, nw = 0.f;
        if (F.tid < 128) { const float l0 = F.in[IN_LBL][col + F.tid], l1 = F.in[IN_LBL][1024 + col + F.tid]; lb = 1.f / (1.f + __expf(l1 - l0)); nw = F.in[IN_NORMW][col + F.tid]; }
        for (int t = 0; t < T; ++t) {
            const size_t ro = (size_t)(rbase + t) * DM + col;
            if (F.tid < 128) { const float z = bf2f(HZ[ro + F.tid]), sg = 1.f / (1.f + __expf(-z)); fs[F.tid] = lb + (1.f - lb) * sg; ks[F.tid] = (1.f - lb) * (1.f - sg); qs[F.tid] = bf2f(HQ[ro + F.tid]); }
            else if (F.tid < 256) vs[F.tid - 128] = bf2f(HV[ro + F.tid - 128]);
            __syncthreads();
            const float v = vs[e]; float part = 0.f;
#pragma unroll
            for (int i = 0; i < 32; ++i) { const int d = 32 * dq + i; S[i] = fs[d] * S[i] + ks[d] * v; part += S[i] * qs[d]; }
            op[dq * 128 + e] = part;
            __syncthreads();
            float o = 0.f;
            if (F.tid < 128) { o = (op[e] + op[128 + e]) + (op[256 + e] + op[384 + e]); const float ss = wave_sum(o * o); if (F.lane == 0) red[F.wave] = ss; }
            __syncthreads();
            if (F.tid < 128) { const float r = 1.f / sqrtf((red[0] + red[1]) * (1.f / 128.f) + RMS_EPS); YH[ro + e] = (bf16_t)f2bf(o * r * nw * bf2f(HG[ro + e])); }
        }
        float* so = F.out + (sidx < NBP ? OFF_NSP + (size_t)(sidx * 8 + h) * 16384 : OFF_NSS + (size_t)((sidx - NBP) * 8 + h) * 16384);
#pragma unroll
        for (int i = 0; i < 32; ++i) so[(size_t)(32 * dq + i) * 128 + e] = S[i];
        __syncthreads();
    }
}
struct Args { const float* in[22]; float* out; unsigned char* ws; int ph_lo, ph_hi; };
__global__ void __launch_bounds__(NWAVES * 64, 2) fwd(Args args) {
    extern __shared__ __attribute__((aligned(16))) unsigned char lds[];
    Frame F;
    F.lds = (LAS unsigned char*)lds;
    F.tid = threadIdx.x; F.lane = F.tid & 63; F.wave = __builtin_amdgcn_readfirstlane(F.tid >> 6);
    F.G = gridDim.x; { const int bx = blockIdx.x; F.vcu = (F.G % 8 == 0) ? (bx % 8) * (F.G / 8) + bx / 8 : bx; }
#pragma unroll
    for (int i = 0; i < 22; ++i) F.in[i] = args.in[i];
    F.out = args.out; F.ws = args.ws;
    cooperative_groups::grid_group grid = cooperative_groups::this_grid();
    const int lo = args.ph_lo, hi = args.ph_hi;
#define IN(k) (lo <= (k) && (k) < hi)
#define SEAM(k) do { if (IN(k) && IN((k) + 1)) { grid.sync(); } } while (0)
    unsigned char* ws = args.ws;
    bf16_t* H = (bf16_t*)(ws + WS_H);

    if (IN(0)) { p0_prologue(F); }
    SEAM(0);
    if (IN(1)) { p1_ln_mod(F); }
    SEAM(1);
    if (IN(2)) {
        pg8::Gemm g{H, (const bf16_t*)(ws + WS_WIN), M, INW, DM}; pg8::StaticOrder S; S.init(M, INW, F.G, (int)blockIdx.x);
        pg8::EpiProj E{(bf16_t*)(ws + WS_QB), (bf16_t*)(ws + WS_KB), (bf16_t*)(ws + WS_VB), (bf16_t*)(ws + WS_HQ), (bf16_t*)(ws + WS_HZ), (bf16_t*)(ws + WS_HV), (bf16_t*)(ws + WS_HG), (bf16_t*)F.out, F.out};
        pg8::gemm_phase<pg8::EpiProj, pg8::StaticOrder, true, true>(F.lds, g, S, E);
    }
    SEAM(2);
    if (IN(3)) {
        attn_simple(F);
        hgrn_simple(F);
    }
    SEAM(3);
    if (IN(6)) {
        { pg8::Gemm g{(const bf16_t*)(ws + WS_QB), (const bf16_t*)(ws + WS_WBA), M, DM, 512}; pg8::StaticOrder S; S.init(M, DM, F.G, (int)blockIdx.x);
          pg8::EpiMerge<true> E{(const bf16_t*)F.out, nullptr, (bf16_t*)(ws + WS_T1)};
          pg8::gemm_phase<pg8::EpiMerge<true>, pg8::StaticOrder, true, true>(F.lds, g, S, E); }
        __syncthreads();
        { pg8::Gemm g{(const bf16_t*)(ws + WS_YH), (const bf16_t*)(ws + WS_WBH), M, DM, DM}; pg8::StaticOrder S; S.init(M, DM, F.G, (int)blockIdx.x);
          pg8::EpiMerge<false> E{(const bf16_t*)F.out, (const bf16_t*)(ws + WS_T1), (bf16_t*)(ws + WS_MERGED)};
          pg8::gemm_phase<pg8::EpiMerge<false>, pg8::StaticOrder, true, true>(F.lds, g, S, E); }
    }
    SEAM(6);
    if (IN(7)) {
        pg8::Gemm g{(const bf16_t*)(ws + WS_MERGED), (const bf16_t*)(ws + WS_WOUT), M, DM, DM}; pg8::StaticOrder S; S.init(M, DM, F.G, (int)blockIdx.x);
        pg8::EpiResid E{F.in[IN_XP], F.in[IN_XS], (const float*)(ws + WS_MOD) + 2048, (float*)(ws + WS_Z1), ALPHA};
        pg8::gemm_phase<pg8::EpiResid, pg8::StaticOrder, true, true>(F.lds, g, S, E);
    }
    SEAM(7);
    if (IN(8)) { p8_ln_mix(F); }
    SEAM(8);
    if (IN(9)) {
        pg8::Gemm g{H, (const bf16_t*)(ws + WS_WUP), M, 2 * DFF, DM}; pg8::StaticOrder S; S.init(M, 2 * DFF, F.G, (int)blockIdx.x);
        pg8::EpiSwiGLU E{(bf16_t*)(ws + WS_ACT)};
        pg8::gemm_phase<pg8::EpiSwiGLU, pg8::StaticOrder, true, true>(F.lds, g, S, E);
    }
    SEAM(9);
    if (IN(10)) {
        pg8::Gemm g{(const bf16_t*)(ws + WS_ACT), (const bf16_t*)(ws + WS_WDN), M, DM, DFF}; pg8::StaticOrder S; S.init(M, DM, F.G, (int)blockIdx.x);
        const float* X1 = (const float*)(ws + WS_X1);
        pg8::EpiResid E{X1, X1 + (size_t)MP * DM, (const float*)(ws + WS_MOD) + 5120, F.out, ALPHA};
        pg8::gemm_phase<pg8::EpiResid, pg8::StaticOrder, true, true>(F.lds, g, S, E);
    }
    SEAM(10);
    if (IN(11)) { p11_ln_out(F); }
#undef IN
#undef SEAM
}

extern "C" void kernel_launch(void* const* d_in, const int* in_sizes, int n_in, void* d_out, int out_size, void* d_ws, size_t ws_size, hipStream_t stream) {
    static int grid = 0;
    if (grid == 0) {
        if (n_in != 22 || out_size != 41549824 || ws_size < WS_END) { fprintf(stderr, "kernel_launch: unexpected problem (n_in %d, out %d, ws %zu)\n", n_in, out_size, ws_size); grid = -1; return; }
        int dev = 0, cus = 0, per_cu = 0;
        if (hipGetDevice(&dev) != hipSuccess || hipDeviceGetAttribute(&cus, hipDeviceAttributeMultiprocessorCount, dev) != hipSuccess) { grid = -1; return; }
        if (hipFuncSetAttribute((const void*)fwd, hipFuncAttributeMaxDynamicSharedMemorySize, LDS_BYTES) != hipSuccess) { fprintf(stderr, "kernel_launch: hipFuncSetAttribute failed\n"); grid = -1; return; }
        if (hipOccupancyMaxActiveBlocksPerMultiprocessor(&per_cu, (const void*)fwd, NWAVES * 64, LDS_BYTES) != hipSuccess || per_cu < 1) { fprintf(stderr, "kernel_launch: occupancy query says %d\n", per_cu); (void)hipGetLastError(); grid = -1; return; }
        grid = cus;
    }
    if (grid < 0) return;
    (void)hipMemsetAsync((char*)d_ws + WS_CTL, 0, CTL_ZERO_BYTES, stream);
    Args a{};
    for (int i = 0; i < 22; ++i) a.in[i] = (const float*)d_in[i];
    a.out = (float*)d_out; a.ws = (unsigned char*)d_ws;
#if MK_N_LAUNCHES == 1
    a.ph_lo = 0; a.ph_hi = N_PHASES;
    void* kargs[] = {&a};
    hipError_t e = hipLaunchCooperativeKernel((const void*)fwd, dim3(grid), dim3(NWAVES * 64), kargs, LDS_BYTES, stream);
    if (e != hipSuccess) fprintf(stderr, "kernel_launch: cooperative launch failed: %s\n", hipGetErrorString(e));
#else
    for (int p = 0; p < N_PHASES; ++p) {
        if (p == 4 || p == 5) { if (!HGRN_IMPL) continue; }
        a.ph_lo = p; a.ph_hi = p + 1;
        hipLaunchKernelGGL(fwd, dim3(grid), dim3(NWAVES * 64), LDS_BYTES, stream, a);
    }
#endif
}
```

```cpp
#define MK_N_LAUNCHES 1
#define ATTN_IMPL 0
#define HGRN_IMPL 1
#include <hip/hip_runtime.h>
#include <hip/hip_cooperative_groups.h>
#include <cstdio>
#include <cstdint>
namespace pg8 {
#define PG8_LAS __attribute__((address_space(3)))
typedef unsigned short bf16_t;
typedef short bf16x8 __attribute__((ext_vector_type(8)));
typedef float f32x4 __attribute__((ext_vector_type(4)));
typedef unsigned u32x4 __attribute__((ext_vector_type(4)));
constexpr int BM = 256, BK = 64, HALF = 128, HTB = HALF * BK * 2  , STAGE_BYTES = 8 * HTB, NXCD = 8, WGM = 8;

__host__ __device__ __forceinline__ int lds_byte(int r, int c) { const int st = (r >> 4) * 2 + (c >> 5), rr = r & 15, cc = c & 31, ob = rr * 64 + cc * 2; return st * 1024 + (ob ^ (((ob >> 9) & 1) << 5)); }
__host__ __device__ __forceinline__ void stage_rc(int b, int& R, int& C) { const int st = b / 1024, sb = b % 1024, swz = sb ^ (((sb >> 9) & 1) << 5); R = (st >> 1) * 16 + swz / 64; C = (st & 1) * 32 + (swz % 64) / 2; }
__host__ __device__ __forceinline__ int perm32(int rho) { const int n = rho >> 4, i = rho & 15; return 8 * (i >> 2) + 4 * n + (i & 3); }

struct Unit { int pm, pn; };
struct Gemm { const bf16_t* A; const bf16_t* Bt; int M, N, K; };

struct StaticOrder {
    int nM, nN, nwg, G, c;
    __host__ __device__ void init(int M, int N, int G_, int c_) { nM = M / BM; nN = N / BM; nwg = nM * nN; G = G_; c = c_; }
    __host__ __device__ bool next(int i, Unit& u) const {
        const long L = (long)i * G + c; if (L >= nwg) return false;
        int wgid = (int)L; { const int q = nwg / NXCD, r = nwg % NXCD, xcd = wgid % NXCD, off = wgid / NXCD; wgid = (xcd < r ? xcd * (q + 1) : r * (q + 1) + (xcd - r) * q) + off; }
        const int nig = WGM * nN, gid = wgid / nig, fm = gid * WGM, gsz = (nM - fm) < WGM ? (nM - fm) : WGM;
        u.pm = fm + ((wgid % nig) % gsz); u.pn = (wgid % nig) / gsz; return true;
    }
    __device__ __forceinline__ void a_ready(const Unit&) const {}
    __device__ __forceinline__ void done(const Unit&) const {}
};

__device__ __forceinline__ unsigned cvt_pk_bf16(float lo, float hi) { unsigned r; asm volatile("v_cvt_pk_bf16_f32 %0, %1, %2" : "=v"(r) : "v"(lo), "v"(hi)); return r; }
typedef float f32x2 __attribute__((ext_vector_type(2)));
__device__ __forceinline__ float bf2f(unsigned short b) { return __uint_as_float(((unsigned)b) << 16); }
__device__ __forceinline__ float fsigmoid(float x) { return __builtin_amdgcn_rcpf(1.0f + __expf(-x)); }
__device__ __forceinline__ float fsilu(float x) { return x * fsigmoid(x); }
__device__ __forceinline__ int mod_row(int row) { return row < 32768 ? (row >> 13) : 4 + ((row - 32768) >> 6); }
constexpr int OFF_NKP = 35651584, OFF_NVP = 35717120, OFF_NSP = 35782656, OFF_NKS = 36306944, OFF_NVS = 36831232, OFF_NSS = 37355520;

struct EpiProj {
    static constexpr bool PERM = true, AFTER_DRAIN = false;
    bf16_t *QB, *KB, *VB, *HQ, *HZ, *HV, *HG, *GT; float* dout;
    __device__ __forceinline__ void operator()(const f32x4 (&acc)[2][2][4][2], const Unit& u, int wr, int wc, int fr, int fq) const {
        const int pn = u.pn, row0 = u.pm * BM + wr * 64 + fr, cl = wc * 32 + 8 * fq;
        if (pn == 2) {
#pragma unroll
            for (int ai = 0; ai < 2; ++ai)
#pragma unroll
                for (int m = 0; m < 4; ++m) { const int row = row0 + ai * HALF + m * 16;
                    float* wdst = nullptr;
                    if (row < 32768) { const int t = row & 8191; if (t >= 8064) wdst = dout + OFF_NKP + (size_t)(((row >> 13) * 128 + (t - 8064)) * 128 + cl); }
                    else { const int r2 = row - 32768; wdst = dout + OFF_NKS + (size_t)(((r2 >> 6) * 128 + 64 + (r2 & 63)) * 128 + cl); }
#pragma unroll
                    for (int bj = 0; bj < 2; ++bj) { const f32x4 v0 = acc[ai][bj][m][0], v1 = acc[ai][bj][m][1];
                        u32x4 w; w.x = cvt_pk_bf16(v0[0], v0[1]); w.y = cvt_pk_bf16(v0[2], v0[3]); w.z = cvt_pk_bf16(v1[0], v1[1]); w.w = cvt_pk_bf16(v1[2], v1[3]);
                        *(u32x4*)((bj == 0 ? KB : VB) + (size_t)row * 128 + cl) = w;
                        if (wdst) { float* d = wdst + (bj == 0 ? 0 : (row < 32768 ? (OFF_NVP - OFF_NKP) : (OFF_NVS - OFF_NKS))); *(f32x4*)d = v0; *(f32x4*)(d + 4) = v1; } } }
            return;
        }
        int mode; bf16_t* base; int ldc, cb;
        if (pn < 2)       { mode = 0; base = QB; ldc = 512;  cb = pn * 256; }
        else if (pn < 7)  { mode = 1; base = HQ; ldc = 1024; cb = (pn - 3) * 256; }
        else if (pn < 11) { mode = 3; base = HZ; ldc = 1024; cb = (pn - 7) * 256; }
        else if (pn < 15) { mode = 3; base = HV; ldc = 1024; cb = (pn - 11) * 256; }
        else if (pn < 19) { mode = 1; base = HG; ldc = 1024; cb = (pn - 15) * 256; }
        else              { mode = 2; base = GT; ldc = 2048; cb = (pn - 19) * 256; }
#pragma unroll
        for (int ai = 0; ai < 2; ++ai)
#pragma unroll
            for (int m = 0; m < 4; ++m) { bf16_t* rowp = base + (size_t)(row0 + ai * HALF + m * 16) * ldc + cb + cl;
#pragma unroll
                for (int bj = 0; bj < 2; ++bj) { f32x4 v0 = acc[ai][bj][m][0], v1 = acc[ai][bj][m][1];
                    if (mode == 0) { v0 = v0 * 0.125f; v1 = v1 * 0.125f; }
                    else if (mode == 1) {
#pragma unroll
                        for (int i = 0; i < 4; ++i) { v0[i] = fsilu(v0[i]); v1[i] = fsilu(v1[i]); } }
                    else if (mode == 2) {
#pragma unroll
                        for (int i = 0; i < 4; ++i) { v0[i] = fsigmoid(v0[i]); v1[i] = fsigmoid(v1[i]); } }
                    u32x4 w; w.x = cvt_pk_bf16(v0[0], v0[1]); w.y = cvt_pk_bf16(v0[2], v0[3]); w.z = cvt_pk_bf16(v1[0], v1[1]); w.w = cvt_pk_bf16(v1[2], v1[3]);
                    *(u32x4*)(rowp + bj * HALF) = w; } }
    }
};
struct EpiSwiGLU {
    static constexpr bool PERM = true, AFTER_DRAIN = false;
    bf16_t* O;
    __device__ __forceinline__ void operator()(const f32x4 (&acc)[2][2][4][2], const Unit& u, int wr, int wc, int fr, int fq) const {
        const int row0 = u.pm * BM + wr * 64 + fr, col = u.pn * 128 + wc * 32 + 8 * fq;
#pragma unroll
        for (int ai = 0; ai < 2; ++ai)
#pragma unroll
            for (int m = 0; m < 4; ++m) { f32x4 v0, v1;
#pragma unroll
                for (int i = 0; i < 4; ++i) { v0[i] = fsilu(acc[ai][1][m][0][i]) * acc[ai][0][m][0][i]; v1[i] = fsilu(acc[ai][1][m][1][i]) * acc[ai][0][m][1][i]; }
                u32x4 w; w.x = cvt_pk_bf16(v0[0], v0[1]); w.y = cvt_pk_bf16(v0[2], v0[3]); w.z = cvt_pk_bf16(v1[0], v1[1]); w.w = cvt_pk_bf16(v1[2], v1[3]);
                *(u32x4*)(O + (size_t)(row0 + ai * HALF + m * 16) * 2816 + col) = w; }
    }
};
template <bool FIRST> struct EpiMerge {
    static constexpr bool PERM = true, AFTER_DRAIN = false;
    const bf16_t* GT; const bf16_t* T1in; bf16_t* O;
    __device__ __forceinline__ void operator()(const f32x4 (&acc)[2][2][4][2], const Unit& u, int wr, int wc, int fr, int fq) const {
        const int row0 = u.pm * BM + wr * 64 + fr, col0 = u.pn * BM + wc * 32 + 8 * fq;
#pragma unroll
        for (int ai = 0; ai < 2; ++ai)
#pragma unroll
            for (int m = 0; m < 4; ++m) { const size_t row = (size_t)(row0 + ai * HALF + m * 16);
#pragma unroll
                for (int bj = 0; bj < 2; ++bj) { const int col = col0 + bj * HALF;
                    const u32x4 g = *(const u32x4*)(GT + row * 2048 + (FIRST ? 0 : 1024) + col);
                    f32x4 v0 = acc[ai][bj][m][0], v1 = acc[ai][bj][m][1];
                    v0[0] *= __uint_as_float(g.x << 16); v0[1] *= __uint_as_float(g.x & 0xffff0000u); v0[2] *= __uint_as_float(g.y << 16); v0[3] *= __uint_as_float(g.y & 0xffff0000u);
                    v1[0] *= __uint_as_float(g.z << 16); v1[1] *= __uint_as_float(g.z & 0xffff0000u); v1[2] *= __uint_as_float(g.w << 16); v1[3] *= __uint_as_float(g.w & 0xffff0000u);
                    if (!FIRST) { const u32x4 t = *(const u32x4*)(T1in + row * 1024 + col);
                        v0[0] += __uint_as_float(t.x << 16); v0[1] += __uint_as_float(t.x & 0xffff0000u); v0[2] += __uint_as_float(t.y << 16); v0[3] += __uint_as_float(t.y & 0xffff0000u);
                        v1[0] += __uint_as_float(t.z << 16); v1[1] += __uint_as_float(t.z & 0xffff0000u); v1[2] += __uint_as_float(t.w << 16); v1[3] += __uint_as_float(t.w & 0xffff0000u); }
                    u32x4 w; w.x = cvt_pk_bf16(v0[0], v0[1]); w.y = cvt_pk_bf16(v0[2], v0[3]); w.z = cvt_pk_bf16(v1[0], v1[1]); w.w = cvt_pk_bf16(v1[2], v1[3]);
                    *(u32x4*)(O + row * 1024 + col) = w; } }
    }
};
struct EpiResid {
    static constexpr bool PERM = false, AFTER_DRAIN = false;
    const float* xa; const float* xb; const float* gate;
    float* out; float alpha;
    __device__ __forceinline__ void operator()(const f32x4 (&acc)[2][2][4][2], const Unit& u, int wr, int wc, int fr, int fq) const {
        const int row0 = u.pm * BM + wr * 64 + fr, col0 = u.pn * BM + wc * 32 + 4 * fq;
#pragma unroll
        for (int ai = 0; ai < 2; ++ai)
#pragma unroll
            for (int m = 0; m < 4; ++m) { const int row = row0 + ai * HALF + m * 16;
                const float* xr = row < 32768 ? xa + (size_t)row * 1024 : xb + (size_t)(row - 32768) * 1024;
                const float* gr = gate + (size_t)mod_row(row) * 6144; float* orow = out + (size_t)row * 1024;
#pragma unroll
                for (int bj = 0; bj < 2; ++bj)
#pragma unroll
                    for (int n = 0; n < 2; ++n) { const int c = col0 + bj * HALF + n * 16;
                        const f32x4 xv = *(const f32x4*)(xr + c), gv = *(const f32x4*)(gr + c);
                        *(f32x4*)(orow + c) = xv * alpha + gv * acc[ai][bj][m][n]; } }
    }
};
template <class Epi, class Sched, bool ALIGN_EPI = false, bool SP2 = false>
__device__ __forceinline__ void gemm_phase(PG8_LAS unsigned char* lds, const Gemm g, const Sched& S, const Epi& E) {
    const int tid = threadIdx.x, wid = __builtin_amdgcn_readfirstlane(tid >> 6), lane = tid & 63, wr = wid >> 2, wc = wid & 3, fr = lane & 15, fq = lane >> 4;
    const int K = g.K, nt = K / BK;
    unsigned voffA[2], voffB[2];
#pragma unroll
    for (int i = 0; i < 2; ++i) { int R, C; stage_rc(tid * 16 + i * 8192, R, C); const int Rb = Epi::PERM ? ((R & ~31) + perm32(R & 31)) : R;
        voffA[i] = (unsigned)(R * K + C) * 2u; voffB[i] = (unsigned)(Rb * K + C) * 2u; }
    const size_t kstep = (size_t)(BK * 2);
    const size_t hstep = (size_t)HALF * K * 2;
    const size_t tstep = 2 * hstep;
    const unsigned ldsw = (unsigned)wid * 1024u;
    const int aoff = lds_byte(wr * 64 + fr, fq * 8), boff = lds_byte(wc * 32 + fr, fq * 8);
#define PG8_SA(b, h) (((b) * 2 + (h)) * HTB)
#define PG8_SB(b, h) ((4 + (b) * 2 + (h)) * HTB)
#define PG8_STAGE(bufoff, gbase, voff) do { _Pragma("unroll") for (int _i = 0; _i < 2; ++_i) \
        __builtin_amdgcn_global_load_lds((const unsigned*)((const char*)(gbase) + (voff)[_i]), (PG8_LAS unsigned*)(lds + (bufoff) + ldsw + _i * 8192), 16, 0, 0); } while (0)
#define PG8_LDA(dst, b, h) do { _Pragma("unroll") for (int m = 0; m < 4; ++m) _Pragma("unroll") for (int k = 0; k < 2; ++k) dst[m][k] = *(const PG8_LAS bf16x8*)(lds + PG8_SA(b, h) + aoff + m * 2048 + k * 1024); } while (0)
#define PG8_LDB(dst, b, h) do { _Pragma("unroll") for (int n = 0; n < 2; ++n) _Pragma("unroll") for (int k = 0; k < 2; ++k) dst[n][k] = *(const PG8_LAS bf16x8*)(lds + PG8_SB(b, h) + boff + n * 2048 + k * 1024); } while (0)
#define PG8_MMA(ai, bj, At, Bt) do { __builtin_amdgcn_s_setprio(1); _Pragma("unroll") for (int m = 0; m < 4; ++m) _Pragma("unroll") for (int n = 0; n < 2; ++n) _Pragma("unroll") for (int k = 0; k < 2; ++k) \
        acc[ai][bj][m][n] = __builtin_amdgcn_mfma_f32_16x16x32_bf16(Bt[n][k], At[m][k], acc[ai][bj][m][n], 0, 0, 0); __builtin_amdgcn_s_setprio(0); } while (0)
#define PG8_WAIT_V(n) asm volatile("s_waitcnt vmcnt(" #n ")" ::: "memory")
#define PG8_WAIT_L(n) asm volatile("s_waitcnt lgkmcnt(" #n ")" ::: "memory")
#define PG8_BAR __builtin_amdgcn_s_barrier()
#define PG8_SCHED __builtin_amdgcn_sched_barrier(0)
    Unit cur, nxt; int ui = 0;
    if (!S.next(0, cur)) return;
    f32x4 acc[2][2][4][2];
#pragma unroll
    for (int a = 0; a < 2; ++a)
#pragma unroll
        for (int b = 0; b < 2; ++b)
#pragma unroll
            for (int m = 0; m < 4; ++m)
#pragma unroll
                for (int n = 0; n < 2; ++n) acc[a][b][m][n] = (f32x4){0.f, 0.f, 0.f, 0.f};
    bf16x8 At[4][2], B0[2][2], B1[2][2];
    const char* cA = (const char*)g.A + (size_t)cur.pm * tstep; const char* cB = (const char*)g.Bt + (size_t)cur.pn * tstep;
    S.a_ready(cur);
    if constexpr (SP2) {
        PG8_STAGE(PG8_SB(0, 0), cB, voffB); PG8_STAGE(PG8_SB(0, 1), cB + hstep, voffB); PG8_STAGE(PG8_SA(0, 0), cA, voffA); PG8_STAGE(PG8_SA(0, 1), cA + hstep, voffA);
        if (wr == 1) PG8_BAR;
        PG8_WAIT_V(2); PG8_BAR;
        PG8_STAGE(PG8_SB(1, 0), cB + kstep, voffB); PG8_STAGE(PG8_SA(1, 0), cA + kstep, voffA); PG8_STAGE(PG8_SB(1, 1), cB + hstep + kstep, voffB);
        PG8_WAIT_V(6); PG8_BAR;
    } else {
        PG8_STAGE(PG8_SB(0, 0), cB, voffB); PG8_STAGE(PG8_SA(0, 0), cA, voffA); PG8_STAGE(PG8_SB(0, 1), cB + hstep, voffB); PG8_STAGE(PG8_SA(0, 1), cA + hstep, voffA);
        if (wr == 1) PG8_BAR;
        PG8_WAIT_V(4); PG8_BAR;
        PG8_STAGE(PG8_SB(1, 0), cB + kstep, voffB); PG8_STAGE(PG8_SA(1, 0), cA + kstep, voffA); PG8_STAGE(PG8_SB(1, 1), cB + hstep + kstep, voffB);
        PG8_WAIT_V(6); PG8_BAR;
    }
    for (;;) {
        const bool has_next = S.next(ui + 1, nxt);
        const char* nA = has_next ? (const char*)g.A + (size_t)nxt.pm * tstep : cA; const char* nB = has_next ? (const char*)g.Bt + (size_t)nxt.pn * tstep : cB;
        for (int t = 0; t < nt; t += 2) {
            const bool last = (t == nt - 2);
            const char* a1 = cA + (size_t)(t + 1) * kstep;
            const char* a2 = last ? nA : cA + (size_t)(t + 2) * kstep; const char* b2 = last ? nB : cB + (size_t)(t + 2) * kstep;
            const char* a3 = a2 + kstep; const char* b3 = b2 + kstep;
            if (last && has_next) S.a_ready(nxt);
            if constexpr (SP2) {
            PG8_LDB(B0, 0, 0); PG8_LDB(B1, 0, 1); PG8_SCHED; PG8_LDA(At, 0, 0); PG8_STAGE(PG8_SA(1, 1), a1 + hstep, voffA);
            PG8_WAIT_V(8); PG8_WAIT_L(0); PG8_BAR; PG8_MMA(0, 0, At, B0); PG8_MMA(0, 1, At, B1); PG8_BAR; PG8_SCHED;
            PG8_LDA(At, 0, 1); PG8_STAGE(PG8_SB(0, 0), b2, voffB); PG8_STAGE(PG8_SB(0, 1), b2 + hstep, voffB); PG8_STAGE(PG8_SA(0, 0), a2, voffA);
            PG8_WAIT_V(8); PG8_WAIT_L(0); PG8_BAR; PG8_MMA(1, 0, At, B0); PG8_MMA(1, 1, At, B1); PG8_BAR; PG8_SCHED;
            PG8_LDB(B0, 1, 0); PG8_LDB(B1, 1, 1); PG8_SCHED; PG8_LDA(At, 1, 0); PG8_STAGE(PG8_SA(0, 1), a2 + hstep, voffA);
            PG8_WAIT_V(8); PG8_WAIT_L(0); PG8_BAR; PG8_MMA(0, 0, At, B0); PG8_MMA(0, 1, At, B1); PG8_BAR; PG8_SCHED;
            PG8_LDA(At, 1, 1); PG8_STAGE(PG8_SB(1, 0), b3, voffB); PG8_STAGE(PG8_SB(1, 1), b3 + hstep, voffB); PG8_STAGE(PG8_SA(1, 0), a3, voffA);
            PG8_WAIT_V(8); PG8_WAIT_L(0); PG8_BAR; PG8_MMA(1, 0, At, B0); PG8_MMA(1, 1, At, B1); PG8_BAR; PG8_SCHED;
            } else {
            PG8_LDB(B0, 0, 0); PG8_SCHED; PG8_LDA(At, 0, 0); PG8_STAGE(PG8_SA(1, 1), a1 + hstep, voffA);
            PG8_WAIT_L(8); PG8_BAR; PG8_WAIT_L(0); PG8_MMA(0, 0, At, B0); PG8_BAR; PG8_SCHED;
            PG8_LDB(B1, 0, 1); PG8_STAGE(PG8_SB(0, 0), b2, voffB);
            PG8_BAR; PG8_WAIT_L(0); PG8_MMA(0, 1, At, B1); PG8_BAR;
            PG8_LDA(At, 0, 1); PG8_STAGE(PG8_SA(0, 0), a2, voffA);
            PG8_BAR; PG8_WAIT_L(0); PG8_MMA(1, 0, At, B0); PG8_BAR; PG8_SCHED;
            PG8_STAGE(PG8_SB(0, 1), b2 + hstep, voffB);
            PG8_WAIT_V(6); PG8_BAR; PG8_MMA(1, 1, At, B1); PG8_BAR;
            PG8_LDB(B0, 1, 0); PG8_SCHED; PG8_LDA(At, 1, 0); PG8_STAGE(PG8_SA(0, 1), a2 + hstep, voffA);
            PG8_WAIT_L(8); PG8_BAR; PG8_WAIT_L(0); PG8_MMA(0, 0, At, B0); PG8_BAR; PG8_SCHED;
            PG8_LDB(B1, 1, 1); PG8_STAGE(PG8_SB(1, 0), b3, voffB);
            PG8_BAR; PG8_WAIT_L(0); PG8_MMA(0, 1, At, B1); PG8_BAR;
            PG8_LDA(At, 1, 1); PG8_STAGE(PG8_SA(1, 0), a3, voffA);
            PG8_BAR; PG8_WAIT_L(0); PG8_MMA(1, 0, At, B0); PG8_BAR; PG8_SCHED;
            PG8_STAGE(PG8_SB(1, 1), b3 + hstep, voffB);
            PG8_WAIT_V(6); PG8_BAR; PG8_MMA(1, 1, At, B1); PG8_BAR;
            }
        }
        if constexpr (ALIGN_EPI) { if (wr == 0) PG8_BAR; }
        if constexpr (!Epi::AFTER_DRAIN) { E(acc, cur, wr, wc, fr, fq); S.done(cur); }
        if (!has_next) break;
#pragma unroll
        for (int a = 0; a < 2; ++a)
#pragma unroll
            for (int b = 0; b < 2; ++b)
#pragma unroll
                for (int m = 0; m < 4; ++m)
#pragma unroll
                    for (int n = 0; n < 2; ++n) acc[a][b][m][n] = (f32x4){0.f, 0.f, 0.f, 0.f};
        cur = nxt; cA = nA; cB = nB; ++ui;
        if constexpr (ALIGN_EPI) { if (wr == 1) PG8_BAR; }
    }
    PG8_WAIT_V(0);
    if constexpr (!ALIGN_EPI) { if (wr == 0) PG8_BAR; }
    PG8_BAR;
    if constexpr (Epi::AFTER_DRAIN) { E.fused(acc, cur, wr, wc, fr, fq, lds, wid, lane); S.done(cur); }
#undef PG8_SA
#undef PG8_SB
#undef PG8_STAGE
#undef PG8_LDA
#undef PG8_LDB
#undef PG8_MMA
#undef PG8_WAIT_V
#undef PG8_WAIT_L
#undef PG8_BAR
#undef PG8_SCHED
}
}
#define GAS __attribute__((address_space(1)))
#define LAS __attribute__((address_space(3)))
typedef unsigned short bf16;
typedef unsigned v4u __attribute__((ext_vector_type(4)));
typedef float f32x4 __attribute__((ext_vector_type(4)));
typedef short bf16x8 __attribute__((ext_vector_type(8)));
typedef GAS unsigned gu32;
typedef GAS unsigned long long gu64;
#define RLX_AGENT __ATOMIC_RELAXED, __HIP_MEMORY_SCOPE_AGENT
#define LDS_WAIT() asm volatile("s_waitcnt lgkmcnt(0)" ::: "memory")
#define VM_WAIT() asm volatile("s_waitcnt vmcnt(0)" ::: "memory")
__device__ __forceinline__ unsigned long long rt() { return __builtin_amdgcn_s_memrealtime(); }
__device__ __forceinline__ unsigned f2bf(float f) { unsigned u = __builtin_bit_cast(unsigned, f); return (u + 0x7fffu + ((u >> 16) & 1u)) >> 16; }
__device__ __forceinline__ unsigned pk2(float lo, float hi) { return f2bf(lo) | (f2bf(hi) << 16); }
#ifndef MK_N_LAUNCHES
#define MK_N_LAUNCHES 1
#endif
#ifndef ATTN_IMPL
#define ATTN_IMPL 0
#endif
#ifndef HGRN_IMPL
#define HGRN_IMPL 0
#endif
constexpr int NWAVES = 8;
constexpr int N_PHASES = 12;

constexpr int DM = 1024, SEQ = 8192, NBP = 4, NBS = 32, DSEQ = 64, MP = NBP * SEQ, MS = NBS * DSEQ, M = MP + MS;
constexpr int INW = 6912, DFF = 2816, NMOD = NBP + NBS;
constexpr float LN_EPS = 1e-5f, RMS_EPS = 1e-6f;
constexpr float ALPHA = 1.189207115002721f;
static_assert(M % 256 == 0 && INW % 256 == 0 && (2 * DFF) % 256 == 0, "tile shapes");

constexpr size_t MiB = 1u << 20, HMiB = 1u << 19;
constexpr size_t WS_CTL = 0, WS_MOD = 1 * MiB, CTL_ZERO_BYTES = 2 * MiB;
constexpr size_t WS_WIN = 2 * MiB, WS_WBA = 31 * HMiB, WS_WBH = 33 * HMiB, WS_WOUT = 37 * HMiB, WS_WUP = 41 * HMiB, WS_WDN = 63 * HMiB;
constexpr size_t WS_H = 37 * MiB, WS_QB = 105 * MiB, WS_KB = 139 * MiB, WS_VB = 295 * HMiB, WS_HQ = 156 * MiB, WS_HZ = 224 * MiB, WS_HV = 292 * MiB, WS_HG = 360 * MiB;
constexpr size_t WS_U = 428 * MiB, WS_D = 492 * MiB, WS_END = 985 * HMiB;
constexpr size_t WS_YH = WS_H, WS_T1 = WS_HQ, WS_MERGED = WS_HZ, WS_Z1 = WS_HV, WS_X1 = WS_HQ, WS_ACT = WS_HV;
static_assert(WS_WIN + (size_t)INW * DM * 2 == WS_WBA && WS_WBA + 512 * 1024 * 2 == WS_WBH && WS_WBH + 1024 * 1024 * 2 == WS_WOUT && WS_WOUT + 1024 * 1024 * 2 == WS_WUP &&
              WS_WUP + (size_t)2 * DFF * DM * 2 == WS_WDN && WS_WDN + (size_t)DM * DFF * 2 == WS_H && WS_H + (size_t)M * DM * 2 == WS_QB && WS_QB + (size_t)M * 512 * 2 == WS_KB &&
              WS_KB + (size_t)M * 128 * 2 == WS_VB && WS_VB + (size_t)M * 128 * 2 == WS_HQ && WS_HQ + (size_t)M * DM * 2 == WS_HZ && WS_HG + (size_t)M * DM * 2 == WS_U &&
              WS_ACT + (size_t)M * DFF * 2 <= WS_D && WS_END <= 512 * MiB, "d_ws map");
constexpr int CW_BAR = 4096;

constexpr int RING_BYTES = 131072, LDSCTL_OFF = RING_BYTES, MISC_OFF = LDSCTL_OFF + 320, LDS_BYTES = 147456;

typedef unsigned short bf16_t;
typedef unsigned u32x4 __attribute__((ext_vector_type(4)));
typedef unsigned u32x2 __attribute__((ext_vector_type(2)));
using pg8::bf2f; using pg8::fsigmoid; using pg8::fsilu; using pg8::mod_row;
using pg8::OFF_NKP; using pg8::OFF_NVP; using pg8::OFF_NSP; using pg8::OFF_NKS; using pg8::OFF_NVS; using pg8::OFF_NSS;

struct Frame {
    LAS unsigned char* lds;
    int tid, lane, wave, vcu, G;
    const float* in[22]; float* out; unsigned char* ws;
};
#define IN_XP 0
#define IN_XS 1
#define IN_CK 2
#define IN_CV 3
#define IN_ST 4
#define IN_CP 5
#define IN_CS 6
#define IN_WADA 7
#define IN_BADA 8
#define IN_WIN 9
#define IN_SINK 10
#define IN_LBL 11
#define IN_NORMW 12
#define IN_WBA 13
#define IN_WBH 14
#define IN_WOUT 15
#define IN_LNMG 16
#define IN_LNMB 17
#define IN_WUP 18
#define IN_WDN 19
#define IN_LNFG 20
#define IN_LNFB 21

__device__ __forceinline__ float wave_sum(float v) {
#pragma unroll
    for (int o = 1; o < 64; o <<= 1) v += __shfl_xor(v, o);
    return v;
}
template <class RMap>
__device__ __forceinline__ void transpose_item(const float* W, int K, int N, bf16_t* WT, LAS float* scr, int item, int lane, RMap rmap) {
    const int nblk = N / 32, kb = item / nblk, nb = item % nblk, k0 = 64 * kb, n0 = 32 * nb;
#pragma unroll 8
    for (int i = 0; i < 32; ++i) { const int kk = 2 * i + (lane >> 5); scr[kk * 33 + (lane & 31)] = W[(size_t)(k0 + kk) * N + n0 + (lane & 31)]; }
    LDS_WAIT(); asm volatile("" ::: "memory");
    const int c = lane & 7; const int nd0 = rmap(n0);
#pragma unroll
    for (int j = 0; j < 4; ++j) { const int n = (lane >> 3) + 8 * j; const LAS float* s = scr + (8 * c) * 33 + n;
        v4u o; o.x = pk2(s[0 * 33], s[1 * 33]); o.y = pk2(s[2 * 33], s[3 * 33]); o.z = pk2(s[4 * 33], s[5 * 33]); o.w = pk2(s[6 * 33], s[7 * 33]);
        *(GAS v4u*)(WT + (size_t)(nd0 + n) * K + k0 + 8 * c) = o; }
    LDS_WAIT(); asm volatile("" ::: "memory");
}
struct RMapId { __device__ __forceinline__ int operator()(int n0) const { return n0; } };
struct RMapUp { __device__ __forceinline__ int operator()(int n0) const { return n0 < DFF ? 256 * (n0 >> 7) + (n0 & 127) : 256 * ((n0 - DFF) >> 7) + 128 + ((n0 - DFF) & 127); } };

__device__ __forceinline__ void p0_prologue(Frame& F) {
    if (F.vcu < 192) {
        const int kc = F.vcu / 12, ec = F.vcu % 12, k0 = kc * 64, col = ec * 512 + F.tid;
        LAS float* sc = (LAS float*)F.lds;
        for (int i = F.tid; i < 64 * NMOD; i += 512) { const int kk = i / NMOD, mb = i % NMOD;
            const float cv = mb < NBP ? F.in[IN_CP][mb * DM + k0 + kk] : F.in[IN_CS][(mb - NBP) * DM + k0 + kk]; sc[kk * NMOD + mb] = fsilu(cv); }
        __syncthreads();
        float acc[NMOD];
#pragma unroll
        for (int i = 0; i < NMOD; ++i) acc[i] = 0.f;
        const float* wp = F.in[IN_WADA] + (size_t)k0 * 6144 + col;
#pragma unroll 4
        for (int kk = 0; kk < 64; ++kk) { const float w = wp[(size_t)kk * 6144];
#pragma unroll
            for (int i = 0; i < NMOD; ++i) acc[i] += sc[kk * NMOD + i] * w; }
        const float bias = kc == 0 ? F.in[IN_BADA][col] : 0.f;
        float* mod = (float*)(F.ws + WS_MOD);
#pragma unroll
        for (int i = 0; i < NMOD; ++i) atomicAdd(mod + i * 6144 + col, acc[i] + bias);
        __syncthreads();
    }
    LAS float* scr = (LAS float*)(F.lds + F.wave * 16384);
    const int gw = F.vcu * NWAVES + F.wave, NGW = F.G * NWAVES;
    constexpr int I_IN = (DM / 64) * (INW / 32), I_BA = (512 / 64) * (DM / 32), I_BH = (DM / 64) * (DM / 32), I_OUT = I_BH, I_UP = (DM / 64) * (2 * DFF / 32), I_DN = (DFF / 64) * (DM / 32);
    constexpr int NITEMS = I_IN + I_BA + I_BH + I_OUT + I_UP + I_DN;
    for (int it = gw; it < NITEMS; it += NGW) {
        int r = it;
        if (r < I_IN) { transpose_item(F.in[IN_WIN], DM, INW, (bf16_t*)(F.ws + WS_WIN), scr, r, F.lane, RMapId()); continue; } r -= I_IN;
        if (r < I_BA) { transpose_item(F.in[IN_WBA], 512, DM, (bf16_t*)(F.ws + WS_WBA), scr, r, F.lane, RMapId()); continue; } r -= I_BA;
        if (r < I_BH) { transpose_item(F.in[IN_WBH], DM, DM, (bf16_t*)(F.ws + WS_WBH), scr, r, F.lane, RMapId()); continue; } r -= I_BH;
        if (r < I_OUT) { transpose_item(F.in[IN_WOUT], DM, DM, (bf16_t*)(F.ws + WS_WOUT), scr, r, F.lane, RMapId()); continue; } r -= I_OUT;
        if (r < I_UP) { transpose_item(F.in[IN_WUP], DM, 2 * DFF, (bf16_t*)(F.ws + WS_WUP), scr, r, F.lane, RMapUp()); continue; } r -= I_UP;
        transpose_item(F.in[IN_WDN], DFF, DM, (bf16_t*)(F.ws + WS_WDN), scr, r, F.lane, RMapId());
    }
    const int gt = F.vcu * 512 + F.tid, NGT = F.G * 512;
    for (int i = gt; i < 2 * NBS * 64 * 32; i += NGT) {
        const int kv = i / (NBS * 64 * 32), r = i % (NBS * 64 * 32), b = r / (64 * 32), q = r % (64 * 32);
        const f32x4 v = *(const f32x4*)(F.in[kv ? IN_CV : IN_CK] + (size_t)b * 128 * 128 + 64 * 128 + q * 4);
        *(f32x4*)(F.out + (kv ? OFF_NVS : OFF_NKS) + (size_t)b * 128 * 128 + q * 4) = v;
    }
}

__device__ __forceinline__ void ln_norm(f32x4 (&v)[4]) {
    float s = 0.f;
#pragma unroll
    for (int j = 0; j < 4; ++j) s += (v[j][0] + v[j][1]) + (v[j][2] + v[j][3]);
    const float mean = wave_sum(s) * (1.f / DM); float s2 = 0.f;
#pragma unroll
    for (int j = 0; j < 4; ++j) { v[j] = v[j] - mean; s2 += (v[j][0] * v[j][0] + v[j][1] * v[j][1]) + (v[j][2] * v[j][2] + v[j][3] * v[j][3]); }
    const float rstd = 1.f / sqrtf(wave_sum(s2) * (1.f / DM) + LN_EPS);
#pragma unroll
    for (int j = 0; j < 4; ++j) v[j] = v[j] * rstd;
}
__device__ __forceinline__ void store_row_bf16(bf16_t* orow, int lane, const f32x4 (&v)[4]) {
#pragma unroll
    for (int j = 0; j < 4; ++j) { u32x2 w; w.x = pk2(v[j][0], v[j][1]); w.y = pk2(v[j][2], v[j][3]); *(u32x2*)(orow + 4 * lane + 256 * j) = w; }
}
__device__ __forceinline__ void p1_ln_mod(Frame& F) {
    const int gw = F.vcu * NWAVES + F.wave, NGW = F.G * NWAVES; const float* mod = (const float*)(F.ws + WS_MOD); bf16_t* H = (bf16_t*)(F.ws + WS_H);
    for (int row = gw; row < M; row += NGW) {
        const float* xr = row < MP ? F.in[IN_XP] + (size_t)row * DM : F.in[IN_XS] + (size_t)(row - MP) * DM; const float* mr = mod + (size_t)mod_row(row) * 6144;
        f32x4 v[4];
#pragma unroll
        for (int j = 0; j < 4; ++j) v[j] = *(const f32x4*)(xr + 4 * F.lane + 256 * j);
        ln_norm(v);
#pragma unroll
        for (int j = 0; j < 4; ++j) { const f32x4 sh = *(const f32x4*)(mr + 4 * F.lane + 256 * j), sc = *(const f32x4*)(mr + 1024 + 4 * F.lane + 256 * j); v[j] = v[j] * (sc + 1.0f) + sh; }
        store_row_bf16(H + (size_t)row * DM, F.lane, v);
    }
}
__device__ __forceinline__ void p8_ln_mix(Frame& F) {
    const int gw = F.vcu * NWAVES + F.wave, NGW = F.G * NWAVES; const float* mod = (const float*)(F.ws + WS_MOD); bf16_t* H = (bf16_t*)(F.ws + WS_H);
    const float* Z1 = (const float*)(F.ws + WS_Z1); float* X1 = (float*)(F.ws + WS_X1);
    f32x4 gg[4], bb[4];
#pragma unroll
    for (int j = 0; j < 4; ++j) { gg[j] = *(const f32x4*)(F.in[IN_LNMG] + 4 * F.lane + 256 * j); bb[j] = *(const f32x4*)(F.in[IN_LNMB] + 4 * F.lane + 256 * j); }
    for (int row = gw; row < M; row += NGW) {
        const float* mr = mod + (size_t)mod_row(row) * 6144;
        f32x4 v[4];
#pragma unroll
        for (int j = 0; j < 4; ++j) v[j] = *(const f32x4*)(Z1 + (size_t)row * DM + 4 * F.lane + 256 * j);
        ln_norm(v);
#pragma unroll
        for (int j = 0; j < 4; ++j) { v[j] = v[j] * gg[j] + bb[j]; *(f32x4*)(X1 + (size_t)row * DM + 4 * F.lane + 256 * j) = v[j]; }
        ln_norm(v);
#pragma unroll
        for (int j = 0; j < 4; ++j) { const f32x4 sh = *(const f32x4*)(mr + 3072 + 4 * F.lane + 256 * j), sc = *(const f32x4*)(mr + 4096 + 4 * F.lane + 256 * j); v[j] = v[j] * (sc + 1.0f) + sh; }
        store_row_bf16(H + (size_t)row * DM, F.lane, v);
    }
}
__device__ __forceinline__ void p11_ln_out(Frame& F) {
    const int gw = F.vcu * NWAVES + F.wave, NGW = F.G * NWAVES;
    f32x4 gg[4], bb[4];
#pragma unroll
    for (int j = 0; j < 4; ++j) { gg[j] = *(const f32x4*)(F.in[IN_LNFG] + 4 * F.lane + 256 * j); bb[j] = *(const f32x4*)(F.in[IN_LNFB] + 4 * F.lane + 256 * j); }
    for (int row = gw; row < M; row += NGW) {
        float* zr = F.out + (size_t)row * DM;
        f32x4 v[4];
#pragma unroll
        for (int j = 0; j < 4; ++j) v[j] = *(const f32x4*)(zr + 4 * F.lane + 256 * j);
        ln_norm(v);
#pragma unroll
        for (int j = 0; j < 4; ++j) *(f32x4*)(zr + 4 * F.lane + 256 * j) = v[j] * gg[j] + bb[j];
    }
}

__device__ __forceinline__ void attn_simple(Frame& F) {
    bf16_t* QB = (bf16_t*)(F.ws + WS_QB); const bf16_t* KB = (const bf16_t*)(F.ws + WS_KB); const bf16_t* VB = (const bf16_t*)(F.ws + WS_VB);
    LAS bf16_t* Ks = (LAS bf16_t*)F.lds; LAS bf16_t* Vs = (LAS bf16_t*)(F.lds + 192 * 64 * 2);
    for (int unit = F.vcu; unit < 544 * 2; unit += F.G) {
        const int ci = unit >> 1, j = unit & 1; const bool samp = ci >= 512;
        const int row0 = samp ? MP + (ci - 512) * DSEQ : (ci >> 7) * SEQ + (ci & 127) * 64; const int c = ci & 127;
        for (int idx = F.tid; idx < 192 * 8 * 2; idx += 512) { const int kv = idx / (192 * 8), r = idx % (192 * 8), i = r >> 3, ch = r & 7;
            u32x4 w = (u32x4){0u, 0u, 0u, 0u};
            if (samp && i < 128) { const float* src = F.in[kv ? IN_CV : IN_CK] + ((size_t)((ci - 512) * 128 + i) * 2 + j) * 64 + ch * 8;
                const f32x4 a = *(const f32x4*)src, b = *(const f32x4*)(src + 4); w.x = pk2(a[0], a[1]); w.y = pk2(a[2], a[3]); w.z = pk2(b[0], b[1]); w.w = pk2(b[2], b[3]); }
            else if (samp || c * 64 - 128 + i >= 0) { const size_t krow = (size_t)(row0 - 128 + i); w = *(const u32x4*)((kv ? VB : KB) + krow * 128 + j * 64 + ch * 8); }
            *(LAS u32x4*)((kv ? Vs : Ks) + i * 64 + ch * 8) = w; }
        __syncthreads();
        if (F.tid < 256) {
            const int g = F.tid >> 6, t = F.tid & 63, hq = 4 * j + g; bf16_t* qp = QB + (size_t)(row0 + t) * 512 + hq * 64;
            float q[64], o[64];
#pragma unroll
            for (int ch = 0; ch < 8; ++ch) { const u32x4 w = *(const u32x4*)(qp + ch * 8);
                q[ch * 8 + 0] = __uint_as_float(w.x << 16); q[ch * 8 + 1] = __uint_as_float(w.x & 0xffff0000u); q[ch * 8 + 2] = __uint_as_float(w.y << 16); q[ch * 8 + 3] = __uint_as_float(w.y & 0xffff0000u);
                q[ch * 8 + 4] = __uint_as_float(w.z << 16); q[ch * 8 + 5] = __uint_as_float(w.z & 0xffff0000u); q[ch * 8 + 6] = __uint_as_float(w.w << 16); q[ch * 8 + 7] = __uint_as_float(w.w & 0xffff0000u); }
#pragma unroll
            for (int d = 0; d < 64; ++d) o[d] = 0.f;
            const float slope = exp2f(-(float)(hq + 1)); float mx = F.in[IN_SINK][hq], l = 1.f;
            const int i0 = samp ? 0 : (128 - c * 64 > 0 ? 128 - c * 64 : 0);
            for (int i = i0; i < 192; ++i) {
                float s = 0.f;
#pragma unroll
                for (int d2 = 0; d2 < 32; ++d2) { const unsigned kw = *(LAS unsigned*)(Ks + i * 64 + 2 * d2); s += q[2 * d2] * __uint_as_float(kw << 16) + q[2 * d2 + 1] * __uint_as_float(kw & 0xffff0000u); }
                s -= slope * fabsf((float)(128 + t - i));
                const float mn = fmaxf(mx, s), sc = __expf(mx - mn), p = __expf(s - mn); l = l * sc + p; mx = mn;
#pragma unroll
                for (int d2 = 0; d2 < 32; ++d2) { const unsigned vw = *(LAS unsigned*)(Vs + i * 64 + 2 * d2);
                    o[2 * d2] = o[2 * d2] * sc + p * __uint_as_float(vw << 16); o[2 * d2 + 1] = o[2 * d2 + 1] * sc + p * __uint_as_float(vw & 0xffff0000u); }
            }
            const float rl = 1.f / l;
#pragma unroll
            for (int ch = 0; ch < 8; ++ch) { u32x4 w; w.x = pk2(o[ch * 8] * rl, o[ch * 8 + 1] * rl); w.y = pk2(o[ch * 8 + 2] * rl, o[ch * 8 + 3] * rl); w.z = pk2(o[ch * 8 + 4] * rl, o[ch * 8 + 5] * rl); w.w = pk2(o[ch * 8 + 6] * rl, o[ch * 8 + 7] * rl);
                *(u32x4*)(qp + ch * 8) = w; }
        }
        __syncthreads();
    }
}

__device__ __forceinline__ void hgrn_simple(Frame& F) {
    const bf16_t* HQ = (const bf16_t*)(F.ws + WS_HQ); const bf16_t* HZ = (const bf16_t*)(F.ws + WS_HZ); const bf16_t* HV = (const bf16_t*)(F.ws + WS_HV); const bf16_t* HG = (const bf16_t*)(F.ws + WS_HG);
    bf16_t* YH = (bf16_t*)(F.ws + WS_YH);
    LAS float* fs = (LAS float*)F.lds; LAS float* ks = fs + 128; LAS float* qs = fs + 256; LAS float* vs = fs + 384; LAS float* op = fs + 512; LAS float* red = fs + 1024;
    const int e = F.tid & 127, dq = F.tid >> 7;
    for (int unit = F.vcu; unit < NMOD * 8; unit += F.G) {
        const int sidx = unit < 32 ? unit >> 3 : 4 + ((unit - 32) >> 3), h = unit & 7;
        const int T = sidx < NBP ? SEQ : DSEQ, rbase = sidx < NBP ? sidx * SEQ : MP + (sidx - NBP) * DSEQ, col = h * 128;
        float S[32];
#pragma unroll
        for (int i = 0; i < 32; ++i) S[i] = sidx < NBP ? 0.f : F.in[IN_ST][((size_t)((sidx - NBP) * 8 + h) * 128 + 32 * dq + i) * 128 + e];
        float lb = 0.f, nw = 0.f;
        if (F.tid < 128) { const float l0 = F.in[IN_LBL][col + F.tid], l1 = F.in[IN_LBL][1024 + col + F.tid]; lb = 1.f / (1.f + __expf(l1 - l0)); nw = F.in[IN_NORMW][col + F.tid]; }
        for (int t = 0; t < T; ++t) {
            const size_t ro = (size_t)(rbase + t) * DM + col;
            if (F.tid < 128) { const float z = bf2f(HZ[ro + F.tid]), sg = 1.f / (1.f + __expf(-z)); fs[F.tid] = lb + (1.f - lb) * sg; ks[F.tid] = (1.f - lb) * (1.f - sg); qs[F.tid] = bf2f(HQ[ro + F.tid]); }
            else if (F.tid < 256) vs[F.tid - 128] = bf2f(HV[ro + F.tid - 128]);
            __syncthreads();
            const float v = vs[e]; float part = 0.f;
#pragma unroll
            for (int i = 0; i < 32; ++i) { const int d = 32 * dq + i; S[i] = fs[d] * S[i] + ks[d] * v; part += S[i] * qs[d]; }
            op[dq * 128 + e] = part;
            __syncthreads();
            float o = 0.f;
            if (F.tid < 128) { o = (op[e] + op[128 + e]) + (op[256 + e] + op[384 + e]); const float ss = wave_sum(o * o); if (F.lane == 0) red[F.wave] = ss; }
            __syncthreads();
            if (F.tid < 128) { const float r = 1.f / sqrtf((red[0] + red[1]) * (1.f / 128.f) + RMS_EPS); YH[ro + e] = (bf16_t)f2bf(o * r * nw * bf2f(HG[ro + e])); }
        }
        float* so = F.out + (sidx < NBP ? OFF_NSP + (size_t)(sidx * 8 + h) * 16384 : OFF_NSS + (size_t)((sidx - NBP) * 8 + h) * 16384);
#pragma unroll
        for (int i = 0; i < 32; ++i) so[(size_t)(32 * dq + i) * 128 + e] = S[i];
        __syncthreads();
    }
}
typedef float f32x16 __attribute__((ext_vector_type(16)));
typedef short s16x4 __attribute__((ext_vector_type(4)));
__device__ __forceinline__ bf16x8 cat8(u32x2 lo, u32x2 hi) { u32x4 w; w.x = lo.x; w.y = lo.y; w.z = hi.x; w.w = hi.y; return __builtin_bit_cast(bf16x8, w); }
__device__ __forceinline__ unsigned cvtpk(float lo, float hi) { return pg8::cvt_pk_bf16(lo, hi); }

constexpr int AL_K = 0, AL_KROW = 144, AL_VT = 192 * 144, AL_VROW = 392, AL_LINV = AL_VT + 64 * AL_VROW, AL_END = AL_LINV + 8 * 32 * 4;
__device__ __forceinline__ void attn_fast(Frame& F) {
    bf16_t* QB = (bf16_t*)(F.ws + WS_QB); const bf16_t* KB = (const bf16_t*)(F.ws + WS_KB); const bf16_t* VB = (const bf16_t*)(F.ws + WS_VB);
    const int lane = F.lane, w = F.wave, r31 = lane & 31, hi = lane >> 5;
    constexpr float LOG2E = 1.4426950408889634f;
    for (int unit = F.vcu; unit < 544 * 2; unit += F.G) {
        const int ci = unit >> 1, j = unit & 1; const bool samp = ci >= 512;
        const int row0 = samp ? MP + (ci - 512) * DSEQ : (ci >> 7) * SEQ + (ci & 127) * 64; const int c = ci & 127;
        const int i0 = samp ? 0 : (128 - c * 64 > 0 ? 128 - c * 64 : 0);
        for (int idx = F.tid; idx < 192 * 8 * 2; idx += 512) { const int kv = idx / (192 * 8), r = idx % (192 * 8), i = r >> 3, ch = r & 7;
            u32x4 wv = (u32x4){0u, 0u, 0u, 0u};
            if (samp && i < 128) { const float* src = F.in[kv ? IN_CV : IN_CK] + ((size_t)((ci - 512) * 128 + i) * 2 + j) * 64 + ch * 8;
                const f32x4 a = *(const f32x4*)src, b = *(const f32x4*)(src + 4); wv.x = pk2(a[0], a[1]); wv.y = pk2(a[2], a[3]); wv.z = pk2(b[0], b[1]); wv.w = pk2(b[2], b[3]); }
            else if (i >= i0) { const size_t krow = (size_t)(row0 - 128 + i); wv = *(const u32x4*)((kv ? VB : KB) + krow * 128 + j * 64 + ch * 8); }
            if (kv == 0) *(LAS u32x4*)(F.lds + AL_K + i * AL_KROW + ch * 16) = wv;
            else { LAS bf16_t* vt = (LAS bf16_t*)(F.lds + AL_VT + (8 * ch) * AL_VROW + i * 2);
                vt[0] = (bf16_t)(wv.x & 0xffffu); vt[AL_VROW / 2] = (bf16_t)(wv.x >> 16); vt[2 * (AL_VROW / 2)] = (bf16_t)(wv.y & 0xffffu); vt[3 * (AL_VROW / 2)] = (bf16_t)(wv.y >> 16);
                vt[4 * (AL_VROW / 2)] = (bf16_t)(wv.z & 0xffffu); vt[5 * (AL_VROW / 2)] = (bf16_t)(wv.z >> 16); vt[6 * (AL_VROW / 2)] = (bf16_t)(wv.w & 0xffffu); vt[7 * (AL_VROW / 2)] = (bf16_t)(wv.w >> 16); } }
        const int g = w >> 1, th = w & 1, hq = 4 * j + g, t = 32 * th + r31;
        bf16_t* qp = QB + (size_t)(row0 + t) * 512 + hq * 64;
        bf16x8 qf[4];
#pragma unroll
        for (int kap = 0; kap < 4; ++kap) qf[kap] = *(const bf16x8*)(qp + 16 * kap + 8 * hi);
        __syncthreads();
        f32x16 st[6];
#pragma unroll
        for (int kt = 0; kt < 6; ++kt) { st[kt] = (f32x16){0.f, 0.f, 0.f, 0.f, 0.f, 0.f, 0.f, 0.f, 0.f, 0.f, 0.f, 0.f, 0.f, 0.f, 0.f, 0.f};
#pragma unroll
            for (int kap = 0; kap < 4; ++kap) { const bf16x8 a = *(const LAS bf16x8*)(F.lds + AL_K + (32 * kt + r31) * AL_KROW + (16 * kap + 8 * hi) * 2);
                st[kt] = __builtin_amdgcn_mfma_f32_32x32x16_bf16(a, qf[kap], st[kt], 0, 0, 0); } }
        const float slope2 = exp2f(-(float)(hq + 1)) * LOG2E, sink2 = F.in[IN_SINK][hq] * LOG2E;
        float mx = sink2;
#pragma unroll
        for (int kt = 0; kt < 6; ++kt)
#pragma unroll
            for (int r = 0; r < 16; ++r) { const int key = 32 * kt + (r & 3) + 8 * (r >> 2) + 4 * hi;
                float v = st[kt][r] * LOG2E - slope2 * fabsf((float)(128 + t - key)); v = key < i0 ? -1e30f : v; st[kt][r] = v; mx = fmaxf(mx, v); }
        mx = fmaxf(mx, __shfl_xor(mx, 32));
        float l = 0.f;
        u32x4 pw[12];
#pragma unroll
        for (int kt = 0; kt < 6; ++kt) {
#pragma unroll
            for (int r = 0; r < 16; ++r) { const float p = __builtin_amdgcn_exp2f(st[kt][r] - mx); st[kt][r] = p; l += p; }
#pragma unroll
            for (int hs = 0; hs < 2; ++hs) { pw[2 * kt + hs].x = cvtpk(st[kt][8 * hs + 0], st[kt][8 * hs + 1]); pw[2 * kt + hs].y = cvtpk(st[kt][8 * hs + 2], st[kt][8 * hs + 3]);
                pw[2 * kt + hs].z = cvtpk(st[kt][8 * hs + 4], st[kt][8 * hs + 5]); pw[2 * kt + hs].w = cvtpk(st[kt][8 * hs + 6], st[kt][8 * hs + 7]); }
        }
        l += __shfl_xor(l, 32); l += __builtin_amdgcn_exp2f(sink2 - mx);
        LAS float* linv = (LAS float*)(F.lds + AL_LINV) + w * 32;
        if (hi == 0) linv[r31] = 1.0f / l;
        f32x16 o[2];
        o[0] = (f32x16){0.f, 0.f, 0.f, 0.f, 0.f, 0.f, 0.f, 0.f, 0.f, 0.f, 0.f, 0.f, 0.f, 0.f, 0.f, 0.f}; o[1] = o[0];
        __builtin_amdgcn_sched_barrier(0);
#pragma unroll
        for (int s16 = 0; s16 < 12; ++s16) {
            const bf16x8 pa = __builtin_bit_cast(bf16x8, pw[s16]);
#pragma unroll
            for (int dt = 0; dt < 2; ++dt) { const LAS unsigned char* vp = F.lds + AL_VT + (32 * dt + r31) * AL_VROW + (16 * s16 + 4 * hi) * 2;
                const bf16x8 b = cat8(*(const LAS u32x2*)vp, *(const LAS u32x2*)(vp + 16));
                o[dt] = __builtin_amdgcn_mfma_f32_32x32x16_bf16(pa, b, o[dt], 0, 0, 0); }
            if (s16 & 1) __builtin_amdgcn_sched_barrier(0);
        }
        asm volatile("s_waitcnt lgkmcnt(0)" ::: "memory");
        bf16_t* op = QB + (size_t)(row0 + 32 * th) * 512 + hq * 64 + r31;
#pragma unroll
        for (int r = 0; r < 16; ++r) { const int qq = (r & 3) + 8 * (r >> 2) + 4 * hi; const float li = linv[qq];
            op[(size_t)qq * 512] = (bf16_t)f2bf(o[0][r] * li); op[(size_t)qq * 512 + 32] = (bf16_t)f2bf(o[1][r] * li); }
        __syncthreads();
    }
}

constexpr int HL_QE = 0, HL_QROW = 272, HL_KE = 32 * 272, HL_KDT = 2 * 32 * 272, HL_TROW = 80, HL_VT = HL_KDT + 128 * 80, HL_EM = HL_VT + 128 * 80, HL_DEC = HL_EM + 512, HL_PART = HL_DEC + 512,
              HL_O = HL_PART + 2048, HL_OROW = 528, HL_END = HL_O + 32 * 528;
static_assert(HL_END <= RING_BYTES && AL_END <= RING_BYTES, "phase scratch inside the ring region");

template <bool FULL>
__device__ __forceinline__ void hgrn_prep(Frame& F, size_t rowoff  , float lb, float& btot) {
    const bf16_t* HQ = (const bf16_t*)(F.ws + WS_HQ); const bf16_t* HZ = (const bf16_t*)(F.ws + WS_HZ); const bf16_t* HV = (const bf16_t*)(F.ws + WS_HV);
    const int d = F.tid & 127, p = F.tid >> 7;
    float z[8], qv[8]; unsigned short vr[8];
#pragma unroll
    for (int i = 0; i < 8; ++i) { const size_t o = rowoff + (size_t)(8 * p + i) * DM + d; z[i] = bf2f(HZ[o]); vr[i] = HV[o]; qv[i] = FULL ? bf2f(HQ[o]) : 0.f; }
    { u32x4 wv; wv.x = vr[0] | ((unsigned)vr[1] << 16); wv.y = vr[2] | ((unsigned)vr[3] << 16); wv.z = vr[4] | ((unsigned)vr[5] << 16); wv.w = vr[6] | ((unsigned)vr[7] << 16);
      *(LAS u32x4*)(F.lds + HL_VT + d * HL_TROW + p * 16) = wv; }
    float kk[8], cs[8]; float run = 0.f;
#pragma unroll
    for (int i = 0; i < 8; ++i) { const float ez = __expf(-fmaxf(z[i], -60.f)), sg = __builtin_amdgcn_rcpf(1.f + ez); const float f = lb + (1.f - lb) * sg; kk[i] = (1.f - lb) * (ez * sg); run += __logf(f); cs[i] = run; }
    LAS float* part = (LAS float*)(F.lds + HL_PART);
    part[p * 128 + d] = run;
    __syncthreads();
    const float p0 = part[d], p1 = part[128 + d], p2 = part[256 + d], p3 = part[384 + d];
    const float m = p0 + p1, bl = (p0 + p1) + (p2 + p3), pre = (p >= 1 ? p0 : 0.f) + (p >= 2 ? p1 : 0.f) + (p >= 3 ? p2 : 0.f);
    float kd[8];
#pragma unroll
    for (int i = 0; i < 8; ++i) { const float b = pre + cs[i];
        if (FULL) { const float up = __expf(b - m), dn = __expf(m - b);
            *(LAS bf16_t*)(F.lds + HL_QE + (8 * p + i) * HL_QROW + d * 2) = (bf16_t)f2bf(qv[i] * up); *(LAS bf16_t*)(F.lds + HL_KE + (8 * p + i) * HL_QROW + d * 2) = (bf16_t)f2bf(kk[i] * dn); }
        kd[i] = kk[i] * __expf(bl - b); }
    { u32x4 wv; wv.x = pk2(kd[0], kd[1]); wv.y = pk2(kd[2], kd[3]); wv.z = pk2(kd[4], kd[5]); wv.w = pk2(kd[6], kd[7]); *(LAS u32x4*)(F.lds + HL_KDT + d * HL_TROW + p * 16) = wv; }
    if (p == 0) { if (FULL) ((LAS float*)(F.lds + HL_EM))[d] = __expf(m); ((LAS float*)(F.lds + HL_DEC))[d] = __expf(bl); btot += bl; }
    __syncthreads();
}
template <bool FULL>
__device__ __forceinline__ void hgrn_mma(Frame& F, f32x4 (&S)[8]) {
    const int lane = F.lane, w = F.wave, r15 = lane & 15, g = lane >> 4;
    const LAS unsigned char* L = F.lds;
    const LAS unsigned char* vrow = L + HL_VT + (16 * w + r15) * HL_TROW;
    const bf16x8 vn = *(const LAS bf16x8*)(vrow + 16 * g);
    if (FULL) {
        bf16x8 qe[2][4], ke[2][4];
#pragma unroll
        for (int tau = 0; tau < 2; ++tau)
#pragma unroll
            for (int kap = 0; kap < 4; ++kap) { const int off = (16 * tau + r15) * HL_QROW + (32 * kap + 4 * g) * 2;
                qe[tau][kap] = cat8(*(const LAS u32x2*)(L + HL_QE + off), *(const LAS u32x2*)(L + HL_QE + off + 32));
                ke[tau][kap] = cat8(*(const LAS u32x2*)(L + HL_KE + off), *(const LAS u32x2*)(L + HL_KE + off + 32)); }
        f32x4 at00 = (f32x4){0.f, 0.f, 0.f, 0.f}, at01 = at00, at11 = at00;
#pragma unroll
        for (int kap = 0; kap < 4; ++kap) { at00 = __builtin_amdgcn_mfma_f32_16x16x32_bf16(ke[0][kap], qe[0][kap], at00, 0, 0, 0);
            at01 = __builtin_amdgcn_mfma_f32_16x16x32_bf16(ke[0][kap], qe[1][kap], at01, 0, 0, 0); at11 = __builtin_amdgcn_mfma_f32_16x16x32_bf16(ke[1][kap], qe[1][kap], at11, 0, 0, 0); }
#pragma unroll
        for (int r = 0; r < 4; ++r) { const bool dead = (4 * g + r) > r15; at00[r] = dead ? 0.f : at00[r]; at11[r] = dead ? 0.f : at11[r]; }
        u32x4 a0, a1; a0.x = cvtpk(at00[0], at00[1]); a0.y = cvtpk(at00[2], at00[3]); a0.z = 0u; a0.w = 0u;
        a1.x = cvtpk(at01[0], at01[1]); a1.y = cvtpk(at01[2], at01[3]); a1.z = cvtpk(at11[0], at11[1]); a1.w = cvtpk(at11[2], at11[3]);
        const bf16x8 vp = cat8(*(const LAS u32x2*)(vrow + 8 * g), *(const LAS u32x2*)(vrow + 32 + 8 * g));
        f32x4 o0 = __builtin_amdgcn_mfma_f32_16x16x32_bf16(__builtin_bit_cast(bf16x8, a0), vp, (f32x4){0.f, 0.f, 0.f, 0.f}, 0, 0, 0);
        f32x4 o1 = __builtin_amdgcn_mfma_f32_16x16x32_bf16(__builtin_bit_cast(bf16x8, a1), vp, (f32x4){0.f, 0.f, 0.f, 0.f}, 0, 0, 0);
#pragma unroll
        for (int kap = 0; kap < 4; ++kap) { const f32x4 e0 = *(const LAS f32x4*)(L + HL_EM + (32 * kap + 4 * g) * 4), e1 = *(const LAS f32x4*)(L + HL_EM + (32 * kap + 16 + 4 * g) * 4);
            const f32x4 s0 = S[2 * kap] * e0, s1 = S[2 * kap + 1] * e1;
            u32x4 sw; sw.x = cvtpk(s0[0], s0[1]); sw.y = cvtpk(s0[2], s0[3]); sw.z = cvtpk(s1[0], s1[1]); sw.w = cvtpk(s1[2], s1[3]); const bf16x8 sp = __builtin_bit_cast(bf16x8, sw);
            o0 = __builtin_amdgcn_mfma_f32_16x16x32_bf16(qe[0][kap], sp, o0, 0, 0, 0); o1 = __builtin_amdgcn_mfma_f32_16x16x32_bf16(qe[1][kap], sp, o1, 0, 0, 0); }
        LAS float* ot = (LAS float*)(F.lds + HL_O) + 16 * w + r15;
#pragma unroll
        for (int r = 0; r < 4; ++r) { ot[(4 * g + r) * (HL_OROW / 4)] = o0[r]; ot[(16 + 4 * g + r) * (HL_OROW / 4)] = o1[r]; }
    }
#pragma unroll
    for (int dl = 0; dl < 8; ++dl) { const f32x4 dc = *(const LAS f32x4*)(L + HL_DEC + (16 * dl + 4 * g) * 4);
        const bf16x8 a = *(const LAS bf16x8*)(L + HL_KDT + (16 * dl + r15) * HL_TROW + 16 * g);
        S[dl] = __builtin_amdgcn_mfma_f32_16x16x32_bf16(a, vn, S[dl] * dc, 0, 0, 0); }
}
__device__ __forceinline__ void hgrn_norm(Frame& F, size_t rowoff) {
    const bf16_t* HG = (const bf16_t*)(F.ws + WS_HG); bf16_t* YH = (bf16_t*)(F.ws + WS_YH);
    const int t = F.tid >> 4, sub = F.tid & 15;
    const LAS float* op = (const LAS float*)(F.lds + HL_O + t * HL_OROW) + 8 * sub;
    const f32x4 a = *(const LAS f32x4*)op, b = *(const LAS f32x4*)(op + 4);
    float ss = (a[0] * a[0] + a[1] * a[1]) + (a[2] * a[2] + a[3] * a[3]) + (b[0] * b[0] + b[1] * b[1]) + (b[2] * b[2] + b[3] * b[3]);
    ss += __shfl_xor(ss, 1); ss += __shfl_xor(ss, 2); ss += __shfl_xor(ss, 4); ss += __shfl_xor(ss, 8);
    const float r = 1.f / sqrtf(ss * (1.f / 128.f) + RMS_EPS);
    const size_t o = rowoff + (size_t)t * DM + 8 * sub; const int hc = (int)(rowoff & 1023) + 8 * sub;
    const u32x4 gq = *(const u32x4*)(HG + o); const f32x4 n0 = *(const f32x4*)(F.in[IN_NORMW] + hc), n1 = *(const f32x4*)(F.in[IN_NORMW] + hc + 4);
    u32x4 wv;
    wv.x = pk2(a[0] * r * n0[0] * __uint_as_float(gq.x << 16), a[1] * r * n0[1] * __uint_as_float(gq.x & 0xffff0000u));
    wv.y = pk2(a[2] * r * n0[2] * __uint_as_float(gq.y << 16), a[3] * r * n0[3] * __uint_as_float(gq.y & 0xffff0000u));
    wv.z = pk2(b[0] * r * n1[0] * __uint_as_float(gq.z << 16), b[1] * r * n1[1] * __uint_as_float(gq.z & 0xffff0000u));
    wv.w = pk2(b[2] * r * n1[2] * __uint_as_float(gq.w << 16), b[3] * r * n1[3] * __uint_as_float(gq.w & 0xffff0000u));
    *(u32x4*)(YH + o) = wv;
}
__device__ __forceinline__ float hgrn_lb(Frame& F, int h) { const int c = h * 128 + (F.tid & 127); const float l0 = F.in[IN_LBL][c], l1 = F.in[IN_LBL][1024 + c]; return 1.f / (1.f + __expf(l1 - l0)); }
__device__ __forceinline__ void hgrn_state_load(Frame& F, const float* base, f32x4 (&S)[8]) {
    const int r15 = F.lane & 15, g = F.lane >> 4; const float* p = base + (size_t)(4 * g) * 128 + 16 * F.wave + r15;
#pragma unroll
    for (int dl = 0; dl < 8; ++dl)
#pragma unroll
        for (int r = 0; r < 4; ++r) S[dl][r] = p[(size_t)(16 * dl + r) * 128];
}
__device__ __forceinline__ void hgrn_state_store(Frame& F, float* base, const f32x4 (&S)[8]) {
    const int r15 = F.lane & 15, g = F.lane >> 4; float* p = base + (size_t)(4 * g) * 128 + 16 * F.wave + r15;
#pragma unroll
    for (int dl = 0; dl < 8; ++dl)
#pragma unroll
        for (int r = 0; r < 4; ++r) p[(size_t)(16 * dl + r) * 128] = S[dl][r];
}
__device__ __forceinline__ void hgrn_pass_a(Frame& F) {
    float* U = (float*)(F.ws + WS_U); float* D = (float*)(F.ws + WS_D);
    for (int unit = F.vcu; unit < 128 * 8; unit += F.G) {
        const int n = unit >> 3, h = unit & 7; const float lb = hgrn_lb(F, h); float btot = 0.f;
        f32x4 S[8];
#pragma unroll
        for (int dl = 0; dl < 8; ++dl) S[dl] = (f32x4){0.f, 0.f, 0.f, 0.f};
        for (int blk = 0; blk < 8; ++blk) { hgrn_prep<false>(F, (size_t)(n * 256 + blk * 32) * DM + h * 128, lb, btot); hgrn_mma<false>(F, S); __syncthreads(); }
        hgrn_state_store(F, U + (size_t)unit * 16384, S);
        if (F.tid < 128) D[unit * 128 + F.tid] = __expf(btot);
    }
}
__device__ __forceinline__ void hgrn_scan(Frame& F) {
    float* U = (float*)(F.ws + WS_U); const float* D = (const float*)(F.ws + WS_D);
    for (int gid = F.vcu * 512 + F.tid; gid < NBP * 8 * 128 * 32; gid += F.G * 512) {
        const int e4 = gid & 31, d = (gid >> 5) & 127, h = (gid >> 12) & 7, b = gid >> 15;
        f32x4 S = (f32x4){0.f, 0.f, 0.f, 0.f};
        for (int n0 = 0; n0 < 32; n0 += 8) {
            f32x4 u[8]; float dc[8];
#pragma unroll
            for (int i = 0; i < 8; ++i) { const size_t unit = (size_t)((b * 32 + n0 + i) * 8 + h); u[i] = *(const f32x4*)(U + unit * 16384 + d * 128 + e4 * 4); dc[i] = D[unit * 128 + d]; }
#pragma unroll
            for (int i = 0; i < 8; ++i) { const size_t unit = (size_t)((b * 32 + n0 + i) * 8 + h); *(f32x4*)(U + unit * 16384 + d * 128 + e4 * 4) = S; S = S * dc[i] + u[i]; }
        }
        *(f32x4*)(F.out + OFF_NSP + (size_t)(b * 8 + h) * 16384 + d * 128 + e4 * 4) = S;
    }
}
__device__ __forceinline__ void hgrn_pass_b(Frame& F) {
    const float* U = (const float*)(F.ws + WS_U);
    for (int unit = F.vcu; unit < 128 * 8 + NBS * 8; unit += F.G) {
        const bool samp = unit >= 1024; const int su = unit - 1024;
        const int h = unit & 7, nblk = samp ? 2 : 8; const size_t row0 = samp ? (size_t)MP + (size_t)(su >> 3) * DSEQ : (size_t)(unit >> 3) * 256;
        const float lb = hgrn_lb(F, h); float btot = 0.f;
        f32x4 S[8];
        hgrn_state_load(F, samp ? F.in[IN_ST] + (size_t)su * 16384 : U + (size_t)unit * 16384, S);
        for (int blk = 0; blk < nblk; ++blk) { const size_t ro = (row0 + blk * 32) * DM + h * 128;
            hgrn_prep<true>(F, ro, lb, btot); hgrn_mma<true>(F, S); __syncthreads(); hgrn_norm(F, ro); }
        if (samp) hgrn_state_store(F, F.out + OFF_NSS + (size_t)su * 16384, S);
        __syncthreads();
    }
}
struct Args { const float* in[22]; float* out; unsigned char* ws; int ph_lo, ph_hi; };
__global__ void __launch_bounds__(NWAVES * 64, 2) fwd(Args args) {
    extern __shared__ __attribute__((aligned(16))) unsigned char lds[];
    Frame F;
    F.lds = (LAS unsigned char*)lds;
    F.tid = threadIdx.x; F.lane = F.tid & 63; F.wave = __builtin_amdgcn_readfirstlane(F.tid >> 6);
    F.G = gridDim.x; { const int bx = blockIdx.x; F.vcu = (F.G % 8 == 0) ? (bx % 8) * (F.G / 8) + bx / 8 : bx; }
#pragma unroll
    for (int i = 0; i < 22; ++i) F.in[i] = args.in[i];
    F.out = args.out; F.ws = args.ws;
    cooperative_groups::grid_group grid = cooperative_groups::this_grid();
    const int lo = args.ph_lo, hi = args.ph_hi;
#define IN(k) (lo <= (k) && (k) < hi)
#define SEAM(k) do { if (IN(k) && IN((k) + 1)) { grid.sync(); } } while (0)
    unsigned char* ws = args.ws;
    bf16_t* H = (bf16_t*)(ws + WS_H);

    if (IN(0)) { p0_prologue(F); }
    SEAM(0);
    if (IN(1)) { p1_ln_mod(F); }
    SEAM(1);
    if (IN(2)) {
        pg8::Gemm g{H, (const bf16_t*)(ws + WS_WIN), M, INW, DM}; pg8::StaticOrder S; S.init(M, INW, F.G, (int)blockIdx.x);
        pg8::EpiProj E{(bf16_t*)(ws + WS_QB), (bf16_t*)(ws + WS_KB), (bf16_t*)(ws + WS_VB), (bf16_t*)(ws + WS_HQ), (bf16_t*)(ws + WS_HZ), (bf16_t*)(ws + WS_HV), (bf16_t*)(ws + WS_HG), (bf16_t*)F.out, F.out};
        pg8::gemm_phase<pg8::EpiProj, pg8::StaticOrder, true, true>(F.lds, g, S, E);
    }
    SEAM(2);
    if (IN(3)) {
#if ATTN_IMPL
        attn_fast(F);
#else
        attn_simple(F);
#endif
#if HGRN_IMPL
        hgrn_pass_a(F);
#else
        hgrn_simple(F);
#endif
    }
    SEAM(3);
#if HGRN_IMPL
    if (IN(4)) { hgrn_scan(F); }
    SEAM(4);
    if (IN(5)) { hgrn_pass_b(F); }
    SEAM(5);
#endif
    if (IN(6)) {
        { pg8::Gemm g{(const bf16_t*)(ws + WS_QB), (const bf16_t*)(ws + WS_WBA), M, DM, 512}; pg8::StaticOrder S; S.init(M, DM, F.G, (int)blockIdx.x);
          pg8::EpiMerge<true> E{(const bf16_t*)F.out, nullptr, (bf16_t*)(ws + WS_T1)};
          pg8::gemm_phase<pg8::EpiMerge<true>, pg8::StaticOrder, true, true>(F.lds, g, S, E); }
        __syncthreads();
        { pg8::Gemm g{(const bf16_t*)(ws + WS_YH), (const bf16_t*)(ws + WS_WBH), M, DM, DM}; pg8::StaticOrder S; S.init(M, DM, F.G, (int)blockIdx.x);
          pg8::EpiMerge<false> E{(const bf16_t*)F.out, (const bf16_t*)(ws + WS_T1), (bf16_t*)(ws + WS_MERGED)};
          pg8::gemm_phase<pg8::EpiMerge<false>, pg8::StaticOrder, true, true>(F.lds, g, S, E); }
    }
    SEAM(6);
    if (IN(7)) {
        pg8::Gemm g{(const bf16_t*)(ws + WS_MERGED), (const bf16_t*)(ws + WS_WOUT), M, DM, DM}; pg8::StaticOrder S; S.init(M, DM, F.G, (int)blockIdx.x);
        pg8::EpiResid E{F.in[IN_XP], F.in[IN_XS], (const float*)(ws + WS_MOD) + 2048, (float*)(ws + WS_Z1), ALPHA};
        pg8::gemm_phase<pg8::EpiResid, pg8::StaticOrder, true, true>(F.lds, g, S, E);
    }
    SEAM(7);
    if (IN(8)) { p8_ln_mix(F); }
    SEAM(8);
    if (IN(9)) {
        pg8::Gemm g{H, (const bf16_t*)(ws + WS_WUP), M, 2 * DFF, DM}; pg8::StaticOrder S; S.init(M, 2 * DFF, F.G, (int)blockIdx.x);
        pg8::EpiSwiGLU E{(bf16_t*)(ws + WS_ACT)};
        pg8::gemm_phase<pg8::EpiSwiGLU, pg8::StaticOrder, true, true>(F.lds, g, S, E);
    }
    SEAM(9);
    if (IN(10)) {
        pg8::Gemm g{(const bf16_t*)(ws + WS_ACT), (const bf16_t*)(ws + WS_WDN), M, DM, DFF}; pg8::StaticOrder S; S.init(M, DM, F.G, (int)blockIdx.x);
        const float* X1 = (const float*)(ws + WS_X1);
        pg8::EpiResid E{X1, X1 + (size_t)MP * DM, (const float*)(ws + WS_MOD) + 5120, F.out, ALPHA};
        pg8::gemm_phase<pg8::EpiResid, pg8::StaticOrder, true, true>(F.lds, g, S, E);
    }
    SEAM(10);
    if (IN(11)) { p11_ln_out(F); }
#undef IN
#undef SEAM
}

extern "C" void kernel_launch(void* const* d_in, const int* in_sizes, int n_in, void* d_out, int out_size, void* d_ws, size_t ws_size, hipStream_t stream) {
    static int grid = 0;
    if (grid == 0) {
        if (n_in != 22 || out_size != 41549824 || ws_size < WS_END) { fprintf(stderr, "kernel_launch: unexpected problem (n_in %d, out %d, ws %zu)\n", n_in, out_size, ws_size); grid = -1; return; }
        int dev = 0, cus = 0, per_cu = 0;
        if (hipGetDevice(&dev) != hipSuccess || hipDeviceGetAttribute(&cus, hipDeviceAttributeMultiprocessorCount, dev) != hipSuccess) { grid = -1; return; }
        if (hipFuncSetAttribute((const void*)fwd, hipFuncAttributeMaxDynamicSharedMemorySize, LDS_BYTES) != hipSuccess) { fprintf(stderr, "kernel_launch: hipFuncSetAttribute failed\n"); grid = -1; return; }
        if (hipOccupancyMaxActiveBlocksPerMultiprocessor(&per_cu, (const void*)fwd, NWAVES * 64, LDS_BYTES) != hipSuccess || per_cu < 1) { fprintf(stderr, "kernel_launch: occupancy query says %d\n", per_cu); (void)hipGetLastError(); grid = -1; return; }
        grid = cus;
    }
    if (grid < 0) return;
    (void)hipMemsetAsync((char*)d_ws + WS_CTL, 0, CTL_ZERO_BYTES, stream);
    Args a{};
    for (int i = 0; i < 22; ++i) a.in[i] = (const float*)d_in[i];
    a.out = (float*)d_out; a.ws = (unsigned char*)d_ws;
#if MK_N_LAUNCHES == 1
    a.ph_lo = 0; a.ph_hi = N_PHASES;
    void* kargs[] = {&a};
    hipError_t e = hipLaunchCooperativeKernel((const void*)fwd, dim3(grid), dim3(NWAVES * 64), kargs, LDS_BYTES, stream);
    if (e != hipSuccess) fprintf(stderr, "kernel_launch: cooperative launch failed: %s\n", hipGetErrorString(e));
#else
    for (int p = 0; p < N_PHASES; ++p) {
        if (p == 4 || p == 5) { if (!HGRN_IMPL) continue; }
        a.ph_lo = p; a.ph_hi = p + 1;
        hipLaunchKernelGGL(fwd, dim3(grid), dim3(NWAVES * 64), LDS_BYTES, stream, a);
    }
#endif
}
```

```cpp
#define MK_N_LAUNCHES 1
#define ATTN_IMPL 1
#define HGRN_IMPL 1
#include <hip/hip_runtime.h>
#include <hip/hip_cooperative_groups.h>
#include <cstdio>
#include <cstdint>
namespace pg8 {
#define PG8_LAS __attribute__((address_space(3)))
typedef unsigned short bf16_t;
typedef short bf16x8 __attribute__((ext_vector_type(8)));
typedef float f32x4 __attribute__((ext_vector_type(4)));
typedef unsigned u32x4 __attribute__((ext_vector_type(4)));
constexpr int BM = 256, BK = 64, HALF = 128, HTB = HALF * BK * 2  , STAGE_BYTES = 8 * HTB, NXCD = 8, WGM = 8;

__host__ __device__ __forceinline__ int lds_byte(int r, int c) { const int st = (r >> 4) * 2 + (c >> 5), rr = r & 15, cc = c & 31, ob = rr * 64 + cc * 2; return st * 1024 + (ob ^ (((ob >> 9) & 1) << 5)); }
__host__ __device__ __forceinline__ void stage_rc(int b, int& R, int& C) { const int st = b / 1024, sb = b % 1024, swz = sb ^ (((sb >> 9) & 1) << 5); R = (st >> 1) * 16 + swz / 64; C = (st & 1) * 32 + (swz % 64) / 2; }
__host__ __device__ __forceinline__ int perm32(int rho) { const int n = rho >> 4, i = rho & 15; return 8 * (i >> 2) + 4 * n + (i & 3); }

struct Unit { int pm, pn; };
struct Gemm { const bf16_t* A; const bf16_t* Bt; int M, N, K; };

struct StaticOrder {
    int nM, nN, nwg, G, c;
    __host__ __device__ void init(int M, int N, int G_, int c_) { nM = M / BM; nN = N / BM; nwg = nM * nN; G = G_; c = c_; }
    __host__ __device__ bool next(int i, Unit& u) const {
        const long L = (long)i * G + c; if (L >= nwg) return false;
        int wgid = (int)L; { const int q = nwg / NXCD, r = nwg % NXCD, xcd = wgid % NXCD, off = wgid / NXCD; wgid = (xcd < r ? xcd * (q + 1) : r * (q + 1) + (xcd - r) * q) + off; }
        const int nig = WGM * nN, gid = wgid / nig, fm = gid * WGM, gsz = (nM - fm) < WGM ? (nM - fm) : WGM;
        u.pm = fm + ((wgid % nig) % gsz); u.pn = (wgid % nig) / gsz; return true;
    }
    __device__ __forceinline__ void a_ready(const Unit&) const {}
    __device__ __forceinline__ void done(const Unit&) const {}
};

__device__ __forceinline__ unsigned cvt_pk_bf16(float lo, float hi) { unsigned r; asm volatile("v_cvt_pk_bf16_f32 %0, %1, %2" : "=v"(r) : "v"(lo), "v"(hi)); return r; }
typedef float f32x2 __attribute__((ext_vector_type(2)));
__device__ __forceinline__ float bf2f(unsigned short b) { return __uint_as_float(((unsigned)b) << 16); }
__device__ __forceinline__ float fsigmoid(float x) { return __builtin_amdgcn_rcpf(1.0f + __expf(-x)); }
__device__ __forceinline__ float fsilu(float x) { return x * fsigmoid(x); }
__device__ __forceinline__ int mod_row(int row) { return row < 32768 ? (row >> 13) : 4 + ((row - 32768) >> 6); }
constexpr int OFF_NKP = 35651584, OFF_NVP = 35717120, OFF_NSP = 35782656, OFF_NKS = 36306944, OFF_NVS = 36831232, OFF_NSS = 37355520;

struct EpiProj {
    static constexpr bool PERM = true, AFTER_DRAIN = false;
    bf16_t *QB, *KB, *VB, *HQ, *HZ, *HV, *HG, *GT; float* dout;
    __device__ __forceinline__ void operator()(const f32x4 (&acc)[2][2][4][2], const Unit& u, int wr, int wc, int fr, int fq) const {
        const int pn = u.pn, row0 = u.pm * BM + wr * 64 + fr, cl = wc * 32 + 8 * fq;
        if (pn == 2) {
#pragma unroll
            for (int ai = 0; ai < 2; ++ai)
#pragma unroll
                for (int m = 0; m < 4; ++m) { const int row = row0 + ai * HALF + m * 16;
                    float* wdst = nullptr;
                    if (row < 32768) { const int t = row & 8191; if (t >= 8064) wdst = dout + OFF_NKP + (size_t)(((row >> 13) * 128 + (t - 8064)) * 128 + cl); }
                    else { const int r2 = row - 32768; wdst = dout + OFF_NKS + (size_t)(((r2 >> 6) * 128 + 64 + (r2 & 63)) * 128 + cl); }
#pragma unroll
                    for (int bj = 0; bj < 2; ++bj) { const f32x4 v0 = acc[ai][bj][m][0], v1 = acc[ai][bj][m][1];
                        u32x4 w; w.x = cvt_pk_bf16(v0[0], v0[1]); w.y = cvt_pk_bf16(v0[2], v0[3]); w.z = cvt_pk_bf16(v1[0], v1[1]); w.w = cvt_pk_bf16(v1[2], v1[3]);
                        *(u32x4*)((bj == 0 ? KB : VB) + (size_t)row * 128 + cl) = w;
                        if (wdst) { float* d = wdst + (bj == 0 ? 0 : (row < 32768 ? (OFF_NVP - OFF_NKP) : (OFF_NVS - OFF_NKS))); *(f32x4*)d = v0; *(f32x4*)(d + 4) = v1; } } }
            return;
        }
        int mode; bf16_t* base; int ldc, cb;
        if (pn < 2)       { mode = 0; base = QB; ldc = 512;  cb = pn * 256; }
        else if (pn < 7)  { mode = 1; base = HQ; ldc = 1024; cb = (pn - 3) * 256; }
        else if (pn < 11) { mode = 3; base = HZ; ldc = 1024; cb = (pn - 7) * 256; }
        else if (pn < 15) { mode = 3; base = HV; ldc = 1024; cb = (pn - 11) * 256; }
        else if (pn < 19) { mode = 1; base = HG; ldc = 1024; cb = (pn - 15) * 256; }
        else              { mode = 2; base = GT; ldc = 2048; cb = (pn - 19) * 256; }
#pragma unroll
        for (int ai = 0; ai < 2; ++ai)
#pragma unroll
            for (int m = 0; m < 4; ++m) { bf16_t* rowp = base + (size_t)(row0 + ai * HALF + m * 16) * ldc + cb + cl;
#pragma unroll
                for (int bj = 0; bj < 2; ++bj) { f32x4 v0 = acc[ai][bj][m][0], v1 = acc[ai][bj][m][1];
                    if (mode == 0) { v0 = v0 * 0.125f; v1 = v1 * 0.125f; }
                    else if (mode == 1) {
#pragma unroll
                        for (int i = 0; i < 4; ++i) { v0[i] = fsilu(v0[i]); v1[i] = fsilu(v1[i]); } }
                    else if (mode == 2) {
#pragma unroll
                        for (int i = 0; i < 4; ++i) { v0[i] = fsigmoid(v0[i]); v1[i] = fsigmoid(v1[i]); } }
                    u32x4 w; w.x = cvt_pk_bf16(v0[0], v0[1]); w.y = cvt_pk_bf16(v0[2], v0[3]); w.z = cvt_pk_bf16(v1[0], v1[1]); w.w = cvt_pk_bf16(v1[2], v1[3]);
                    *(u32x4*)(rowp + bj * HALF) = w; } }
    }
};
struct EpiSwiGLU {
    static constexpr bool PERM = true, AFTER_DRAIN = false;
    bf16_t* O;
    __device__ __forceinline__ void operator()(const f32x4 (&acc)[2][2][4][2], const Unit& u, int wr, int wc, int fr, int fq) const {
        const int row0 = u.pm * BM + wr * 64 + fr, col = u.pn * 128 + wc * 32 + 8 * fq;
#pragma unroll
        for (int ai = 0; ai < 2; ++ai)
#pragma unroll
            for (int m = 0; m < 4; ++m) { f32x4 v0, v1;
#pragma unroll
                for (int i = 0; i < 4; ++i) { v0[i] = fsilu(acc[ai][1][m][0][i]) * acc[ai][0][m][0][i]; v1[i] = fsilu(acc[ai][1][m][1][i]) * acc[ai][0][m][1][i]; }
                u32x4 w; w.x = cvt_pk_bf16(v0[0], v0[1]); w.y = cvt_pk_bf16(v0[2], v0[3]); w.z = cvt_pk_bf16(v1[0], v1[1]); w.w = cvt_pk_bf16(v1[2], v1[3]);
                *(u32x4*)(O + (size_t)(row0 + ai * HALF + m * 16) * 2816 + col) = w; }
    }
};
template <bool FIRST> struct EpiMerge {
    static constexpr bool PERM = true, AFTER_DRAIN = false;
    const bf16_t* GT; const bf16_t* T1in; bf16_t* O;
    __device__ __forceinline__ void operator()(const f32x4 (&acc)[2][2][4][2], const Unit& u, int wr, int wc, int fr, int fq) const {
        const int row0 = u.pm * BM + wr * 64 + fr, col0 = u.pn * BM + wc * 32 + 8 * fq;
#pragma unroll
        for (int ai = 0; ai < 2; ++ai)
#pragma unroll
            for (int m = 0; m < 4; ++m) { const size_t row = (size_t)(row0 + ai * HALF + m * 16);
#pragma unroll
                for (int bj = 0; bj < 2; ++bj) { const int col = col0 + bj * HALF;
                    const u32x4 g = *(const u32x4*)(GT + row * 2048 + (FIRST ? 0 : 1024) + col);
                    f32x4 v0 = acc[ai][bj][m][0], v1 = acc[ai][bj][m][1];
                    v0[0] *= __uint_as_float(g.x << 16); v0[1] *= __uint_as_float(g.x & 0xffff0000u); v0[2] *= __uint_as_float(g.y << 16); v0[3] *= __uint_as_float(g.y & 0xffff0000u);
                    v1[0] *= __uint_as_float(g.z << 16); v1[1] *= __uint_as_float(g.z & 0xffff0000u); v1[2] *= __uint_as_float(g.w << 16); v1[3] *= __uint_as_float(g.w & 0xffff0000u);
                    if (!FIRST) { const u32x4 t = *(const u32x4*)(T1in + row * 1024 + col);
                        v0[0] += __uint_as_float(t.x << 16); v0[1] += __uint_as_float(t.x & 0xffff0000u); v0[2] += __uint_as_float(t.y << 16); v0[3] += __uint_as_float(t.y & 0xffff0000u);
                        v1[0] += __uint_as_float(t.z << 16); v1[1] += __uint_as_float(t.z & 0xffff0000u); v1[2] += __uint_as_float(t.w << 16); v1[3] += __uint_as_float(t.w & 0xffff0000u); }
                    u32x4 w; w.x = cvt_pk_bf16(v0[0], v0[1]); w.y = cvt_pk_bf16(v0[2], v0[3]); w.z = cvt_pk_bf16(v1[0], v1[1]); w.w = cvt_pk_bf16(v1[2], v1[3]);
                    *(u32x4*)(O + row * 1024 + col) = w; } }
    }
};
struct EpiResid {
    static constexpr bool PERM = false, AFTER_DRAIN = false;
    const float* xa; const float* xb; const float* gate;
    float* out; float alpha;
    __device__ __forceinline__ void operator()(const f32x4 (&acc)[2][2][4][2], const Unit& u, int wr, int wc, int fr, int fq) const {
        const int row0 = u.pm * BM + wr * 64 + fr, col0 = u.pn * BM + wc * 32 + 4 * fq;
#pragma unroll
        for (int ai = 0; ai < 2; ++ai)
#pragma unroll
            for (int m = 0; m < 4; ++m) { const int row = row0 + ai * HALF + m * 16;
                const float* xr = row < 32768 ? xa + (size_t)row * 1024 : xb + (size_t)(row - 32768) * 1024;
                const float* gr = gate + (size_t)mod_row(row) * 6144; float* orow = out + (size_t)row * 1024;
#pragma unroll
                for (int bj = 0; bj < 2; ++bj)
#pragma unroll
                    for (int n = 0; n < 2; ++n) { const int c = col0 + bj * HALF + n * 16;
                        const f32x4 xv = *(const f32x4*)(xr + c), gv = *(const f32x4*)(gr + c);
                        *(f32x4*)(orow + c) = xv * alpha + gv * acc[ai][bj][m][n]; } }
    }
};
template <class Epi, class Sched, bool ALIGN_EPI = false, bool SP2 = false>
__device__ __forceinline__ void gemm_phase(PG8_LAS unsigned char* lds, const Gemm g, const Sched& S, const Epi& E) {
    const int tid = threadIdx.x, wid = __builtin_amdgcn_readfirstlane(tid >> 6), lane = tid & 63, wr = wid >> 2, wc = wid & 3, fr = lane & 15, fq = lane >> 4;
    const int K = g.K, nt = K / BK;
    unsigned voffA[2], voffB[2];
#pragma unroll
    for (int i = 0; i < 2; ++i) { int R, C; stage_rc(tid * 16 + i * 8192, R, C); const int Rb = Epi::PERM ? ((R & ~31) + perm32(R & 31)) : R;
        voffA[i] = (unsigned)(R * K + C) * 2u; voffB[i] = (unsigned)(Rb * K + C) * 2u; }
    const size_t kstep = (size_t)(BK * 2);
    const size_t hstep = (size_t)HALF * K * 2;
    const size_t tstep = 2 * hstep;
    const unsigned ldsw = (unsigned)wid * 1024u;
    const int aoff = lds_byte(wr * 64 + fr, fq * 8), boff = lds_byte(wc * 32 + fr, fq * 8);
#define PG8_SA(b, h) (((b) * 2 + (h)) * HTB)
#define PG8_SB(b, h) ((4 + (b) * 2 + (h)) * HTB)
#define PG8_STAGE(bufoff, gbase, voff) do { _Pragma("unroll") for (int _i = 0; _i < 2; ++_i) \
        __builtin_amdgcn_global_load_lds((const unsigned*)((const char*)(gbase) + (voff)[_i]), (PG8_LAS unsigned*)(lds + (bufoff) + ldsw + _i * 8192), 16, 0, 0); } while (0)
#define PG8_LDA(dst, b, h) do { _Pragma("unroll") for (int m = 0; m < 4; ++m) _Pragma("unroll") for (int k = 0; k < 2; ++k) dst[m][k] = *(const PG8_LAS bf16x8*)(lds + PG8_SA(b, h) + aoff + m * 2048 + k * 1024); } while (0)
#define PG8_LDB(dst, b, h) do { _Pragma("unroll") for (int n = 0; n < 2; ++n) _Pragma("unroll") for (int k = 0; k < 2; ++k) dst[n][k] = *(const PG8_LAS bf16x8*)(lds + PG8_SB(b, h) + boff + n * 2048 + k * 1024); } while (0)
#define PG8_MMA(ai, bj, At, Bt) do { __builtin_amdgcn_s_setprio(1); _Pragma("unroll") for (int m = 0; m < 4; ++m) _Pragma("unroll") for (int n = 0; n < 2; ++n) _Pragma("unroll") for (int k = 0; k < 2; ++k) \
        acc[ai][bj][m][n] = __builtin_amdgcn_mfma_f32_16x16x32_bf16(Bt[n][k], At[m][k], acc[ai][bj][m][n], 0, 0, 0); __builtin_amdgcn_s_setprio(0); } while (0)
#define PG8_WAIT_V(n) asm volatile("s_waitcnt vmcnt(" #n ")" ::: "memory")
#define PG8_WAIT_L(n) asm volatile("s_waitcnt lgkmcnt(" #n ")" ::: "memory")
#define PG8_BAR __builtin_amdgcn_s_barrier()
#define PG8_SCHED __builtin_amdgcn_sched_barrier(0)
    Unit cur, nxt; int ui = 0;
    if (!S.next(0, cur)) return;
    f32x4 acc[2][2][4][2];
#pragma unroll
    for (int a = 0; a < 2; ++a)
#pragma unroll
        for (int b = 0; b < 2; ++b)
#pragma unroll
            for (int m = 0; m < 4; ++m)
#pragma unroll
                for (int n = 0; n < 2; ++n) acc[a][b][m][n] = (f32x4){0.f, 0.f, 0.f, 0.f};
    bf16x8 At[4][2], B0[2][2], B1[2][2];
    const char* cA = (const char*)g.A + (size_t)cur.pm * tstep; const char* cB = (const char*)g.Bt + (size_t)cur.pn * tstep;
    S.a_ready(cur);
    if constexpr (SP2) {
        PG8_STAGE(PG8_SB(0, 0), cB, voffB); PG8_STAGE(PG8_SB(0, 1), cB + hstep, voffB); PG8_STAGE(PG8_SA(0, 0), cA, voffA); PG8_STAGE(PG8_SA(0, 1), cA + hstep, voffA);
        if (wr == 1) PG8_BAR;
        PG8_WAIT_V(2); PG8_BAR;
        PG8_STAGE(PG8_SB(1, 0), cB + kstep, voffB); PG8_STAGE(PG8_SA(1, 0), cA + kstep, voffA); PG8_STAGE(PG8_SB(1, 1), cB + hstep + kstep, voffB);
        PG8_WAIT_V(6); PG8_BAR;
    } else {
        PG8_STAGE(PG8_SB(0, 0), cB, voffB); PG8_STAGE(PG8_SA(0, 0), cA, voffA); PG8_STAGE(PG8_SB(0, 1), cB + hstep, voffB); PG8_STAGE(PG8_SA(0, 1), cA + hstep, voffA);
        if (wr == 1) PG8_BAR;
        PG8_WAIT_V(4); PG8_BAR;
        PG8_STAGE(PG8_SB(1, 0), cB + kstep, voffB); PG8_STAGE(PG8_SA(1, 0), cA + kstep, voffA); PG8_STAGE(PG8_SB(1, 1), cB + hstep + kstep, voffB);
        PG8_WAIT_V(6); PG8_BAR;
    }
    for (;;) {
        const bool has_next = S.next(ui + 1, nxt);
        const char* nA = has_next ? (const char*)g.A + (size_t)nxt.pm * tstep : cA; const char* nB = has_next ? (const char*)g.Bt + (size_t)nxt.pn * tstep : cB;
        for (int t = 0; t < nt; t += 2) {
            const bool last = (t == nt - 2);
            const char* a1 = cA + (size_t)(t + 1) * kstep;
            const char* a2 = last ? nA : cA + (size_t)(t + 2) * kstep; const char* b2 = last ? nB : cB + (size_t)(t + 2) * kstep;
            const char* a3 = a2 + kstep; const char* b3 = b2 + kstep;
            if (last && has_next) S.a_ready(nxt);
            if constexpr (SP2) {
            PG8_LDB(B0, 0, 0); PG8_LDB(B1, 0, 1); PG8_SCHED; PG8_LDA(At, 0, 0); PG8_STAGE(PG8_SA(1, 1), a1 + hstep, voffA);
            PG8_WAIT_V(8); PG8_WAIT_L(0); PG8_BAR; PG8_MMA(0, 0, At, B0); PG8_MMA(0, 1, At, B1); PG8_BAR; PG8_SCHED;
            PG8_LDA(At, 0, 1); PG8_STAGE(PG8_SB(0, 0), b2, voffB); PG8_STAGE(PG8_SB(0, 1), b2 + hstep, voffB); PG8_STAGE(PG8_SA(0, 0), a2, voffA);
            PG8_WAIT_V(8); PG8_WAIT_L(0); PG8_BAR; PG8_MMA(1, 0, At, B0); PG8_MMA(1, 1, At, B1); PG8_BAR; PG8_SCHED;
            PG8_LDB(B0, 1, 0); PG8_LDB(B1, 1, 1); PG8_SCHED; PG8_LDA(At, 1, 0); PG8_STAGE(PG8_SA(0, 1), a2 + hstep, voffA);
            PG8_WAIT_V(8); PG8_WAIT_L(0); PG8_BAR; PG8_MMA(0, 0, At, B0); PG8_MMA(0, 1, At, B1); PG8_BAR; PG8_SCHED;
            PG8_LDA(At, 1, 1); PG8_STAGE(PG8_SB(1, 0), b3, voffB); PG8_STAGE(PG8_SB(1, 1), b3 + hstep, voffB); PG8_STAGE(PG8_SA(1, 0), a3, voffA);
            PG8_WAIT_V(8); PG8_WAIT_L(0); PG8_BAR; PG8_MMA(1, 0, At, B0); PG8_MMA(1, 1, At, B1); PG8_BAR; PG8_SCHED;
            } else {
            PG8_LDB(B0, 0, 0); PG8_SCHED; PG8_LDA(At, 0, 0); PG8_STAGE(PG8_SA(1, 1), a1 + hstep, voffA);
            PG8_WAIT_L(8); PG8_BAR; PG8_WAIT_L(0); PG8_MMA(0, 0, At, B0); PG8_BAR; PG8_SCHED;
            PG8_LDB(B1, 0, 1); PG8_STAGE(PG8_SB(0, 0), b2, voffB);
            PG8_BAR; PG8_WAIT_L(0); PG8_MMA(0, 1, At, B1); PG8_BAR;
            PG8_LDA(At, 0, 1); PG8_STAGE(PG8_SA(0, 0), a2, voffA);
            PG8_BAR; PG8_WAIT_L(0); PG8_MMA(1, 0, At, B0); PG8_BAR; PG8_SCHED;
            PG8_STAGE(PG8_SB(0, 1), b2 + hstep, voffB);
            PG8_WAIT_V(6); PG8_BAR; PG8_MMA(1, 1, At, B1); PG8_BAR;
            PG8_LDB(B0, 1, 0); PG8_SCHED; PG8_LDA(At, 1, 0); PG8_STAGE(PG8_SA(0, 1), a2 + hstep, voffA);
            PG8_WAIT_L(8); PG8_BAR; PG8_WAIT_L(0); PG8_MMA(0, 0, At, B0); PG8_BAR; PG8_SCHED;
            PG8_LDB(B1, 1, 1); PG8_STAGE(PG8_SB(1, 0), b3, voffB);
            PG8_BAR; PG8_WAIT_L(0); PG8_MMA(0, 1, At, B1); PG8_BAR;
            PG8_LDA(At, 1, 1); PG8_STAGE(PG8_SA(1, 0), a3, voffA);
            PG8_BAR; PG8_WAIT_L(0); PG8_MMA(1, 0, At, B0); PG8_BAR; PG8_SCHED;
            PG8_STAGE(PG8_SB(1, 1), b3 + hstep, voffB);
            PG8_WAIT_V(6); PG8_BAR; PG8_MMA(1, 1, At, B1); PG8_BAR;
            }
        }
        if constexpr (ALIGN_EPI) { if (wr == 0) PG8_BAR; }
        if constexpr (!Epi::AFTER_DRAIN) { E(acc, cur, wr, wc, fr, fq); S.done(cur); }
        if (!has_next) break;
#pragma unroll
        for (int a = 0; a < 2; ++a)
#pragma unroll
            for (int b = 0; b < 2; ++b)
#pragma unroll
                for (int m = 0; m < 4; ++m)
#pragma unroll
                    for (int n = 0; n < 2; ++n) acc[a][b][m][n] = (f32x4){0.f, 0.f, 0.f, 0.f};
        cur = nxt; cA = nA; cB = nB; ++ui;
        if constexpr (ALIGN_EPI) { if (wr == 1) PG8_BAR; }
    }
    PG8_WAIT_V(0);
    if constexpr (!ALIGN_EPI) { if (wr == 0) PG8_BAR; }
    PG8_BAR;
    if constexpr (Epi::AFTER_DRAIN) { E.fused(acc, cur, wr, wc, fr, fq, lds, wid, lane); S.done(cur); }
#undef PG8_SA
#undef PG8_SB
#undef PG8_STAGE
#undef PG8_LDA
#undef PG8_LDB
#undef PG8_MMA
#undef PG8_WAIT_V
#undef PG8_WAIT_L
#undef PG8_BAR
#undef PG8_SCHED
}
}
#define GAS __attribute__((address_space(1)))
#define LAS __attribute__((address_space(3)))
typedef unsigned short bf16;
typedef unsigned v4u __attribute__((ext_vector_type(4)));
typedef float f32x4 __attribute__((ext_vector_type(4)));
typedef short bf16x8 __attribute__((ext_vector_type(8)));
typedef GAS unsigned gu32;
typedef GAS unsigned long long gu64;
#define RLX_AGENT __ATOMIC_RELAXED, __HIP_MEMORY_SCOPE_AGENT
#define LDS_WAIT() asm volatile("s_waitcnt lgkmcnt(0)" ::: "memory")
#define VM_WAIT() asm volatile("s_waitcnt vmcnt(0)" ::: "memory")
__device__ __forceinline__ unsigned long long rt() { return __builtin_amdgcn_s_memrealtime(); }
__device__ __forceinline__ unsigned f2bf(float f) { unsigned u = __builtin_bit_cast(unsigned, f); return (u + 0x7fffu + ((u >> 16) & 1u)) >> 16; }
__device__ __forceinline__ unsigned pk2(float lo, float hi) { return f2bf(lo) | (f2bf(hi) << 16); }
#ifndef MK_N_LAUNCHES
#define MK_N_LAUNCHES 1
#endif
#ifndef ATTN_IMPL
#define ATTN_IMPL 0
#endif
#ifndef HGRN_IMPL
#define HGRN_IMPL 0
#endif
constexpr int NWAVES = 8;
constexpr int N_PHASES = 12;

constexpr int DM = 1024, SEQ = 8192, NBP = 4, NBS = 32, DSEQ = 64, MP = NBP * SEQ, MS = NBS * DSEQ, M = MP + MS;
constexpr int INW = 6912, DFF = 2816, NMOD = NBP + NBS;
constexpr float LN_EPS = 1e-5f, RMS_EPS = 1e-6f;
constexpr float ALPHA = 1.189207115002721f;
static_assert(M % 256 == 0 && INW % 256 == 0 && (2 * DFF) % 256 == 0, "tile shapes");

constexpr size_t MiB = 1u << 20, HMiB = 1u << 19;
constexpr size_t WS_CTL = 0, WS_MOD = 1 * MiB, CTL_ZERO_BYTES = 2 * MiB;
constexpr size_t WS_WIN = 2 * MiB, WS_WBA = 31 * HMiB, WS_WBH = 33 * HMiB, WS_WOUT = 37 * HMiB, WS_WUP = 41 * HMiB, WS_WDN = 63 * HMiB;
constexpr size_t WS_H = 37 * MiB, WS_QB = 105 * MiB, WS_KB = 139 * MiB, WS_VB = 295 * HMiB, WS_HQ = 156 * MiB, WS_HZ = 224 * MiB, WS_HV = 292 * MiB, WS_HG = 360 * MiB;
constexpr size_t WS_U = 428 * MiB, WS_D = 492 * MiB, WS_END = 985 * HMiB;
constexpr size_t WS_YH = WS_H, WS_T1 = WS_HQ, WS_MERGED = WS_HZ, WS_Z1 = WS_HV, WS_X1 = WS_HQ, WS_ACT = WS_HV;
static_assert(WS_WIN + (size_t)INW * DM * 2 == WS_WBA && WS_WBA + 512 * 1024 * 2 == WS_WBH && WS_WBH + 1024 * 1024 * 2 == WS_WOUT && WS_WOUT + 1024 * 1024 * 2 == WS_WUP &&
              WS_WUP + (size_t)2 * DFF * DM * 2 == WS_WDN && WS_WDN + (size_t)DM * DFF * 2 == WS_H && WS_H + (size_t)M * DM * 2 == WS_QB && WS_QB + (size_t)M * 512 * 2 == WS_KB &&
              WS_KB + (size_t)M * 128 * 2 == WS_VB && WS_VB + (size_t)M * 128 * 2 == WS_HQ && WS_HQ + (size_t)M * DM * 2 == WS_HZ && WS_HG + (size_t)M * DM * 2 == WS_U &&
              WS_ACT + (size_t)M * DFF * 2 <= WS_D && WS_END <= 512 * MiB, "d_ws map");
constexpr int CW_BAR = 4096;

constexpr int RING_BYTES = 131072, LDSCTL_OFF = RING_BYTES, MISC_OFF = LDSCTL_OFF + 320, LDS_BYTES = 147456;

typedef unsigned short bf16_t;
typedef unsigned u32x4 __attribute__((ext_vector_type(4)));
typedef unsigned u32x2 __attribute__((ext_vector_type(2)));
using pg8::bf2f; using pg8::fsigmoid; using pg8::fsilu; using pg8::mod_row;
using pg8::OFF_NKP; using pg8::OFF_NVP; using pg8::OFF_NSP; using pg8::OFF_NKS; using pg8::OFF_NVS; using pg8::OFF_NSS;

struct Frame {
    LAS unsigned char* lds;
    int tid, lane, wave, vcu, G;
    const float* in[22]; float* out; unsigned char* ws;
};
#define IN_XP 0
#define IN_XS 1
#define IN_CK 2
#define IN_CV 3
#define IN_ST 4
#define IN_CP 5
#define IN_CS 6
#define IN_WADA 7
#define IN_BADA 8
#define IN_WIN 9
#define IN_SINK 10
#define IN_LBL 11
#define IN_NORMW 12
#define IN_WBA 13
#define IN_WBH 14
#define IN_WOUT 15
#define IN_LNMG 16
#define IN_LNMB 17
#define IN_WUP 18
#define IN_WDN 19
#define IN_LNFG 20
#define IN_LNFB 21

__device__ __forceinline__ float wave_sum(float v) {
#pragma unroll
    for (int o = 1; o < 64; o <<= 1) v += __shfl_xor(v, o);
    return v;
}
template <class RMap>
__device__ __forceinline__ void transpose_item(const float* W, int K, int N, bf16_t* WT, LAS float* scr, int item, int lane, RMap rmap) {
    const int nblk = N / 32, kb = item / nblk, nb = item % nblk, k0 = 64 * kb, n0 = 32 * nb;
#pragma unroll 8
    for (int i = 0; i < 32; ++i) { const int kk = 2 * i + (lane >> 5); scr[kk * 33 + (lane & 31)] = W[(size_t)(k0 + kk) * N + n0 + (lane & 31)]; }
    LDS_WAIT(); asm volatile("" ::: "memory");
    const int c = lane & 7; const int nd0 = rmap(n0);
#pragma unroll
    for (int j = 0; j < 4; ++j) { const int n = (lane >> 3) + 8 * j; const LAS float* s = scr + (8 * c) * 33 + n;
        v4u o; o.x = pk2(s[0 * 33], s[1 * 33]); o.y = pk2(s[2 * 33], s[3 * 33]); o.z = pk2(s[4 * 33], s[5 * 33]); o.w = pk2(s[6 * 33], s[7 * 33]);
        *(GAS v4u*)(WT + (size_t)(nd0 + n) * K + k0 + 8 * c) = o; }
    LDS_WAIT(); asm volatile("" ::: "memory");
}
struct RMapId { __device__ __forceinline__ int operator()(int n0) const { return n0; } };
struct RMapUp { __device__ __forceinline__ int operator()(int n0) const { return n0 < DFF ? 256 * (n0 >> 7) + (n0 & 127) : 256 * ((n0 - DFF) >> 7) + 128 + ((n0 - DFF) & 127); } };

__device__ __forceinline__ void p0_prologue(Frame& F) {
    if (F.vcu < 192) {
        const int kc = F.vcu / 12, ec = F.vcu % 12, k0 = kc * 64, col = ec * 512 + F.tid;
        LAS float* sc = (LAS float*)F.lds;
        for (int i = F.tid; i < 64 * NMOD; i += 512) { const int kk = i / NMOD, mb = i % NMOD;
            const float cv = mb < NBP ? F.in[IN_CP][mb * DM + k0 + kk] : F.in[IN_CS][(mb - NBP) * DM + k0 + kk]; sc[kk * NMOD + mb] = fsilu(cv); }
        __syncthreads();
        float acc[NMOD];
#pragma unroll
        for (int i = 0; i < NMOD; ++i) acc[i] = 0.f;
        const float* wp = F.in[IN_WADA] + (size_t)k0 * 6144 + col;
#pragma unroll 4
        for (int kk = 0; kk < 64; ++kk) { const float w = wp[(size_t)kk * 6144];
#pragma unroll
            for (int i = 0; i < NMOD; ++i) acc[i] += sc[kk * NMOD + i] * w; }
        const float bias = kc == 0 ? F.in[IN_BADA][col] : 0.f;
        float* mod = (float*)(F.ws + WS_MOD);
#pragma unroll
        for (int i = 0; i < NMOD; ++i) atomicAdd(mod + i * 6144 + col, acc[i] + bias);
        __syncthreads();
    }
    LAS float* scr = (LAS float*)(F.lds + F.wave * 16384);
    const int gw = F.vcu * NWAVES + F.wave, NGW = F.G * NWAVES;
    constexpr int I_IN = (DM / 64) * (INW / 32), I_BA = (512 / 64) * (DM / 32), I_BH = (DM / 64) * (DM / 32), I_OUT = I_BH, I_UP = (DM / 64) * (2 * DFF / 32), I_DN = (DFF / 64) * (DM / 32);
    constexpr int NITEMS = I_IN + I_BA + I_BH + I_OUT + I_UP + I_DN;
    for (int it = gw; it < NITEMS; it += NGW) {
        int r = it;
        if (r < I_IN) { transpose_item(F.in[IN_WIN], DM, INW, (bf16_t*)(F.ws + WS_WIN), scr, r, F.lane, RMapId()); continue; } r -= I_IN;
        if (r < I_BA) { transpose_item(F.in[IN_WBA], 512, DM, (bf16_t*)(F.ws + WS_WBA), scr, r, F.lane, RMapId()); continue; } r -= I_BA;
        if (r < I_BH) { transpose_item(F.in[IN_WBH], DM, DM, (bf16_t*)(F.ws + WS_WBH), scr, r, F.lane, RMapId()); continue; } r -= I_BH;
        if (r < I_OUT) { transpose_item(F.in[IN_WOUT], DM, DM, (bf16_t*)(F.ws + WS_WOUT), scr, r, F.lane, RMapId()); continue; } r -= I_OUT;
        if (r < I_UP) { transpose_item(F.in[IN_WUP], DM, 2 * DFF, (bf16_t*)(F.ws + WS_WUP), scr, r, F.lane, RMapUp()); continue; } r -= I_UP;
        transpose_item(F.in[IN_WDN], DFF, DM, (bf16_t*)(F.ws + WS_WDN), scr, r, F.lane, RMapId());
    }
    const int gt = F.vcu * 512 + F.tid, NGT = F.G * 512;
    for (int i = gt; i < 2 * NBS * 64 * 32; i += NGT) {
        const int kv = i / (NBS * 64 * 32), r = i % (NBS * 64 * 32), b = r / (64 * 32), q = r % (64 * 32);
        const f32x4 v = *(const f32x4*)(F.in[kv ? IN_CV : IN_CK] + (size_t)b * 128 * 128 + 64 * 128 + q * 4);
        *(f32x4*)(F.out + (kv ? OFF_NVS : OFF_NKS) + (size_t)b * 128 * 128 + q * 4) = v;
    }
}

__device__ __forceinline__ void ln_norm(f32x4 (&v)[4]) {
    float s = 0.f;
#pragma unroll
    for (int j = 0; j < 4; ++j) s += (v[j][0] + v[j][1]) + (v[j][2] + v[j][3]);
    const float mean = wave_sum(s) * (1.f / DM); float s2 = 0.f;
#pragma unroll
    for (int j = 0; j < 4; ++j) { v[j] = v[j] - mean; s2 += (v[j][0] * v[j][0] + v[j][1] * v[j][1]) + (v[j][2] * v[j][2] + v[j][3] * v[j][3]); }
    const float rstd = 1.f / sqrtf(wave_sum(s2) * (1.f / DM) + LN_EPS);
#pragma unroll
    for (int j = 0; j < 4; ++j) v[j] = v[j] * rstd;
}
__device__ __forceinline__ void store_row_bf16(bf16_t* orow, int lane, const f32x4 (&v)[4]) {
#pragma unroll
    for (int j = 0; j < 4; ++j) { u32x2 w; w.x = pk2(v[j][0], v[j][1]); w.y = pk2(v[j][2], v[j][3]); *(u32x2*)(orow + 4 * lane + 256 * j) = w; }
}
__device__ __forceinline__ void p1_ln_mod(Frame& F) {
    const int gw = F.vcu * NWAVES + F.wave, NGW = F.G * NWAVES; const float* mod = (const float*)(F.ws + WS_MOD); bf16_t* H = (bf16_t*)(F.ws + WS_H);
    for (int row = gw; row < M; row += NGW) {
        const float* xr = row < MP ? F.in[IN_XP] + (size_t)row * DM : F.in[IN_XS] + (size_t)(row - MP) * DM; const float* mr = mod + (size_t)mod_row(row) * 6144;
        f32x4 v[4];
#pragma unroll
        for (int j = 0; j < 4; ++j) v[j] = *(const f32x4*)(xr + 4 * F.lane + 256 * j);
        ln_norm(v);
#pragma unroll
        for (int j = 0; j < 4; ++j) { const f32x4 sh = *(const f32x4*)(mr + 4 * F.lane + 256 * j), sc = *(const f32x4*)(mr + 1024 + 4 * F.lane + 256 * j); v[j] = v[j] * (sc + 1.0f) + sh; }
        store_row_bf16(H + (size_t)row * DM, F.lane, v);
    }
}
__device__ __forceinline__ void p8_ln_mix(Frame& F) {
    const int gw = F.vcu * NWAVES + F.wave, NGW = F.G * NWAVES; const float* mod = (const float*)(F.ws + WS_MOD); bf16_t* H = (bf16_t*)(F.ws + WS_H);
    const float* Z1 = (const float*)(F.ws + WS_Z1); float* X1 = (float*)(F.ws + WS_X1);
    f32x4 gg[4], bb[4];
#pragma unroll
    for (int j = 0; j < 4; ++j) { gg[j] = *(const f32x4*)(F.in[IN_LNMG] + 4 * F.lane + 256 * j); bb[j] = *(const f32x4*)(F.in[IN_LNMB] + 4 * F.lane + 256 * j); }
    for (int row = gw; row < M; row += NGW) {
        const float* mr = mod + (size_t)mod_row(row) * 6144;
        f32x4 v[4];
#pragma unroll
        for (int j = 0; j < 4; ++j) v[j] = *(const f32x4*)(Z1 + (size_t)row * DM + 4 * F.lane + 256 * j);
        ln_norm(v);
#pragma unroll
        for (int j = 0; j < 4; ++j) { v[j] = v[j] * gg[j] + bb[j]; *(f32x4*)(X1 + (size_t)row * DM + 4 * F.lane + 256 * j) = v[j]; }
        ln_norm(v);
#pragma unroll
        for (int j = 0; j < 4; ++j) { const f32x4 sh = *(const f32x4*)(mr + 3072 + 4 * F.lane + 256 * j), sc = *(const f32x4*)(mr + 4096 + 4 * F.lane + 256 * j); v[j] = v[j] * (sc + 1.0f) + sh; }
        store_row_bf16(H + (size_t)row * DM, F.lane, v);
    }
}
__device__ __forceinline__ void p11_ln_out(Frame& F) {
    const int gw = F.vcu * NWAVES + F.wave, NGW = F.G * NWAVES;
    f32x4 gg[4], bb[4];
#pragma unroll
    for (int j = 0; j < 4; ++j) { gg[j] = *(const f32x4*)(F.in[IN_LNFG] + 4 * F.lane + 256 * j); bb[j] = *(const f32x4*)(F.in[IN_LNFB] + 4 * F.lane + 256 * j); }
    for (int row = gw; row < M; row += NGW) {
        float* zr = F.out + (size_t)row * DM;
        f32x4 v[4];
#pragma unroll
        for (int j = 0; j < 4; ++j) v[j] = *(const f32x4*)(zr + 4 * F.lane + 256 * j);
        ln_norm(v);
#pragma unroll
        for (int j = 0; j < 4; ++j) *(f32x4*)(zr + 4 * F.lane + 256 * j) = v[j] * gg[j] + bb[j];
    }
}

__device__ __forceinline__ void attn_simple(Frame& F) {
    bf16_t* QB = (bf16_t*)(F.ws + WS_QB); const bf16_t* KB = (const bf16_t*)(F.ws + WS_KB); const bf16_t* VB = (const bf16_t*)(F.ws + WS_VB);
    LAS bf16_t* Ks = (LAS bf16_t*)F.lds; LAS bf16_t* Vs = (LAS bf16_t*)(F.lds + 192 * 64 * 2);
    for (int unit = F.vcu; unit < 544 * 2; unit += F.G) {
        const int ci = unit >> 1, j = unit & 1; const bool samp = ci >= 512;
        const int row0 = samp ? MP + (ci - 512) * DSEQ : (ci >> 7) * SEQ + (ci & 127) * 64; const int c = ci & 127;
        for (int idx = F.tid; idx < 192 * 8 * 2; idx += 512) { const int kv = idx / (192 * 8), r = idx % (192 * 8), i = r >> 3, ch = r & 7;
            u32x4 w = (u32x4){0u, 0u, 0u, 0u};
            if (samp && i < 128) { const float* src = F.in[kv ? IN_CV : IN_CK] + ((size_t)((ci - 512) * 128 + i) * 2 + j) * 64 + ch * 8;
                const f32x4 a = *(const f32x4*)src, b = *(const f32x4*)(src + 4); w.x = pk2(a[0], a[1]); w.y = pk2(a[2], a[3]); w.z = pk2(b[0], b[1]); w.w = pk2(b[2], b[3]); }
            else if (samp || c * 64 - 128 + i >= 0) { const size_t krow = (size_t)(row0 - 128 + i); w = *(const u32x4*)((kv ? VB : KB) + krow * 128 + j * 64 + ch * 8); }
            *(LAS u32x4*)((kv ? Vs : Ks) + i * 64 + ch * 8) = w; }
        __syncthreads();
        if (F.tid < 256) {
            const int g = F.tid >> 6, t = F.tid & 63, hq = 4 * j + g; bf16_t* qp = QB + (size_t)(row0 + t) * 512 + hq * 64;
            float q[64], o[64];
#pragma unroll
            for (int ch = 0; ch < 8; ++ch) { const u32x4 w = *(const u32x4*)(qp + ch * 8);
                q[ch * 8 + 0] = __uint_as_float(w.x << 16); q[ch * 8 + 1] = __uint_as_float(w.x & 0xffff0000u); q[ch * 8 + 2] = __uint_as_float(w.y << 16); q[ch * 8 + 3] = __uint_as_float(w.y & 0xffff0000u);
                q[ch * 8 + 4] = __uint_as_float(w.z << 16); q[ch * 8 + 5] = __uint_as_float(w.z & 0xffff0000u); q[ch * 8 + 6] = __uint_as_float(w.w << 16); q[ch * 8 + 7] = __uint_as_float(w.w & 0xffff0000u); }
#pragma unroll
            for (int d = 0; d < 64; ++d) o[d] = 0.f;
            const float slope = exp2f(-(float)(hq + 1)); float mx = F.in[IN_SINK][hq], l = 1.f;
            const int i0 = samp ? 0 : (128 - c * 64 > 0 ? 128 - c * 64 : 0);
            for (int i = i0; i < 192; ++i) {
                float s = 0.f;
#pragma unroll
                for (int d2 = 0; d2 < 32; ++d2) { const unsigned kw = *(LAS unsigned*)(Ks + i * 64 + 2 * d2); s += q[2 * d2] * __uint_as_float(kw << 16) + q[2 * d2 + 1] * __uint_as_float(kw & 0xffff0000u); }
                s -= slope * fabsf((float)(128 + t - i));
                const float mn = fmaxf(mx, s), sc = __expf(mx - mn), p = __expf(s - mn); l = l * sc + p; mx = mn;
#pragma unroll
                for (int d2 = 0; d2 < 32; ++d2) { const unsigned vw = *(LAS unsigned*)(Vs + i * 64 + 2 * d2);
                    o[2 * d2] = o[2 * d2] * sc + p * __uint_as_float(vw << 16); o[2 * d2 + 1] = o[2 * d2 + 1] * sc + p * __uint_as_float(vw & 0xffff0000u); }
            }
            const float rl = 1.f / l;
#pragma unroll
            for (int ch = 0; ch < 8; ++ch) { u32x4 w; w.x = pk2(o[ch * 8] * rl, o[ch * 8 + 1] * rl); w.y = pk2(o[ch * 8 + 2] * rl, o[ch * 8 + 3] * rl); w.z = pk2(o[ch * 8 + 4] * rl, o[ch * 8 + 5] * rl); w.w = pk2(o[ch * 8 + 6] * rl, o[ch * 8 + 7] * rl);
                *(u32x4*)(qp + ch * 8) = w; }
        }
        __syncthreads();
    }
}

__device__ __forceinline__ void hgrn_simple(Frame& F) {
    const bf16_t* HQ = (const bf16_t*)(F.ws + WS_HQ); const bf16_t* HZ = (const bf16_t*)(F.ws + WS_HZ); const bf16_t* HV = (const bf16_t*)(F.ws + WS_HV); const bf16_t* HG = (const bf16_t*)(F.ws + WS_HG);
    bf16_t* YH = (bf16_t*)(F.ws + WS_YH);
    LAS float* fs = (LAS float*)F.lds; LAS float* ks = fs + 128; LAS float* qs = fs + 256; LAS float* vs = fs + 384; LAS float* op = fs + 512; LAS float* red = fs + 1024;
    const int e = F.tid & 127, dq = F.tid >> 7;
    for (int unit = F.vcu; unit < NMOD * 8; unit += F.G) {
        const int sidx = unit < 32 ? unit >> 3 : 4 + ((unit - 32) >> 3), h = unit & 7;
        const int T = sidx < NBP ? SEQ : DSEQ, rbase = sidx < NBP ? sidx * SEQ : MP + (sidx - NBP) * DSEQ, col = h * 128;
        float S[32];
#pragma unroll
        for (int i = 0; i < 32; ++i) S[i] = sidx < NBP ? 0.f : F.in[IN_ST][((size_t)((sidx - NBP) * 8 + h) * 128 + 32 * dq + i) * 128 + e];
        float lb = 0.f, nw = 0.f;
        if (F.tid < 128) { const float l0 = F.in[IN_LBL][col + F.tid], l1 = F.in[IN_LBL][1024 + col + F.tid]; lb = 1.f / (1.f + __expf(l1 - l0)); nw = F.in[IN_NORMW][col + F.tid]; }
        for (int t = 0; t < T; ++t) {
            const size_t ro = (size_t)(rbase + t) * DM + col;
            if (F.tid < 128) { const float z = bf2f(HZ[ro + F.tid]), sg = 1.f / (1.f + __expf(-z)); fs[F.tid] = lb + (1.f - lb) * sg; ks[F.tid] = (1.f - lb) * (1.f - sg); qs[F.tid] = bf2f(HQ[ro + F.tid]); }
            else if (F.tid < 256) vs[F.tid - 128] = bf2f(HV[ro + F.tid - 128]);
            __syncthreads();
            const float v = vs[e]; float part = 0.f;
#pragma unroll
            for (int i = 0; i < 32; ++i) { const int d = 32 * dq + i; S[i] = fs[d] * S[i] + ks[d] * v; part += S[i] * qs[d]; }
            op[dq * 128 + e] = part;
            __syncthreads();
            float o = 0.f;
            if (F.tid < 128) { o = (op[e] + op[128 + e]) + (op[256 + e] + op[384 + e]); const float ss = wave_sum(o * o); if (F.lane == 0) red[F.wave] = ss; }
            __syncthreads();
            if (F.tid < 128) { const float r = 1.f / sqrtf((red[0] + red[1]) * (1.f / 128.f) + RMS_EPS); YH[ro + e] = (bf16_t)f2bf(o * r * nw * bf2f(HG[ro + e])); }
        }
        float* so = F.out + (sidx < NBP ? OFF_NSP + (size_t)(sidx * 8 + h) * 16384 : OFF_NSS + (size_t)((sidx - NBP) * 8 + h) * 16384);
#pragma unroll
        for (int i = 0; i < 32; ++i) so[(size_t)(32 * dq + i) * 128 + e] = S[i];
        __syncthreads();
    }
}
typedef float f32x16 __attribute__((ext_vector_type(16)));
typedef short s16x4 __attribute__((ext_vector_type(4)));
__device__ __forceinline__ bf16x8 cat8(u32x2 lo, u32x2 hi) { u32x4 w; w.x = lo.x; w.y = lo.y; w.z = hi.x; w.w = hi.y; return __builtin_bit_cast(bf16x8, w); }
__device__ __forceinline__ unsigned cvtpk(float lo, float hi) { return pg8::cvt_pk_bf16(lo, hi); }

constexpr int AL_K = 0, AL_KROW = 144, AL_VT = 192 * 144, AL_VROW = 392, AL_LINV = AL_VT + 64 * AL_VROW, AL_END = AL_LINV + 8 * 32 * 4;
__device__ __forceinline__ void attn_fast(Frame& F) {
    bf16_t* QB = (bf16_t*)(F.ws + WS_QB); const bf16_t* KB = (const bf16_t*)(F.ws + WS_KB); const bf16_t* VB = (const bf16_t*)(F.ws + WS_VB);
    const int lane = F.lane, w = F.wave, r31 = lane & 31, hi = lane >> 5;
    constexpr float LOG2E = 1.4426950408889634f;
    for (int unit = F.vcu; unit < 544 * 2; unit += F.G) {
        const int ci = unit >> 1, j = unit & 1; const bool samp = ci >= 512;
        const int row0 = samp ? MP + (ci - 512) * DSEQ : (ci >> 7) * SEQ + (ci & 127) * 64; const int c = ci & 127;
        const int i0 = samp ? 0 : (128 - c * 64 > 0 ? 128 - c * 64 : 0);
        for (int idx = F.tid; idx < 192 * 8 * 2; idx += 512) { const int kv = idx / (192 * 8), r = idx % (192 * 8), i = r >> 3, ch = r & 7;
            u32x4 wv = (u32x4){0u, 0u, 0u, 0u};
            if (samp && i < 128) { const float* src = F.in[kv ? IN_CV : IN_CK] + ((size_t)((ci - 512) * 128 + i) * 2 + j) * 64 + ch * 8;
                const f32x4 a = *(const f32x4*)src, b = *(const f32x4*)(src + 4); wv.x = pk2(a[0], a[1]); wv.y = pk2(a[2], a[3]); wv.z = pk2(b[0], b[1]); wv.w = pk2(b[2], b[3]); }
            else if (i >= i0) { const size_t krow = (size_t)(row0 - 128 + i); wv = *(const u32x4*)((kv ? VB : KB) + krow * 128 + j * 64 + ch * 8); }
            if (kv == 0) *(LAS u32x4*)(F.lds + AL_K + i * AL_KROW + ch * 16) = wv;
            else { LAS bf16_t* vt = (LAS bf16_t*)(F.lds + AL_VT + (8 * ch) * AL_VROW + i * 2);
                vt[0] = (bf16_t)(wv.x & 0xffffu); vt[AL_VROW / 2] = (bf16_t)(wv.x >> 16); vt[2 * (AL_VROW / 2)] = (bf16_t)(wv.y & 0xffffu); vt[3 * (AL_VROW / 2)] = (bf16_t)(wv.y >> 16);
                vt[4 * (AL_VROW / 2)] = (bf16_t)(wv.z & 0xffffu); vt[5 * (AL_VROW / 2)] = (bf16_t)(wv.z >> 16); vt[6 * (AL_VROW / 2)] = (bf16_t)(wv.w & 0xffffu); vt[7 * (AL_VROW / 2)] = (bf16_t)(wv.w >> 16); } }
        const int g = w >> 1, th = w & 1, hq = 4 * j + g, t = 32 * th + r31;
        bf16_t* qp = QB + (size_t)(row0 + t) * 512 + hq * 64;
        bf16x8 qf[4];
#pragma unroll
        for (int kap = 0; kap < 4; ++kap) qf[kap] = *(const bf16x8*)(qp + 16 * kap + 8 * hi);
        __syncthreads();
        f32x16 st[6];
#pragma unroll
        for (int kt = 0; kt < 6; ++kt) { st[kt] = (f32x16){0.f, 0.f, 0.f, 0.f, 0.f, 0.f, 0.f, 0.f, 0.f, 0.f, 0.f, 0.f, 0.f, 0.f, 0.f, 0.f};
#pragma unroll
            for (int kap = 0; kap < 4; ++kap) { const bf16x8 a = *(const LAS bf16x8*)(F.lds + AL_K + (32 * kt + r31) * AL_KROW + (16 * kap + 8 * hi) * 2);
                st[kt] = __builtin_amdgcn_mfma_f32_32x32x16_bf16(a, qf[kap], st[kt], 0, 0, 0); }
            __builtin_amdgcn_sched_barrier(0); }
        const float slope2 = exp2f(-(float)(hq + 1)) * LOG2E, sink2 = F.in[IN_SINK][hq] * LOG2E;
        float mx = sink2;
        int dbase = 128 + t - 4 * hi, kbase = i0 - 4 * hi; asm volatile("" : "+v"(dbase), "+v"(kbase));
#pragma unroll
        for (int kt = 0; kt < 6; ++kt)
#pragma unroll
            for (int r = 0; r < 16; ++r) { const int kc = 32 * kt + (r & 3) + 8 * (r >> 2);
                float v = st[kt][r] * LOG2E - slope2 * fabsf((float)(dbase - kc)); v = kc < kbase ? -1e30f : v; st[kt][r] = v; mx = fmaxf(mx, v); }
        mx = fmaxf(mx, __shfl_xor(mx, 32));
        __builtin_amdgcn_sched_barrier(0);
        float l = 0.f;
        u32x4 pw[12];
#pragma unroll
        for (int kt = 0; kt < 6; ++kt) {
#pragma unroll
            for (int r = 0; r < 16; ++r) { const float p = __builtin_amdgcn_exp2f(st[kt][r] - mx); st[kt][r] = p; l += p; }
#pragma unroll
            for (int hs = 0; hs < 2; ++hs) { pw[2 * kt + hs].x = cvtpk(st[kt][8 * hs + 0], st[kt][8 * hs + 1]); pw[2 * kt + hs].y = cvtpk(st[kt][8 * hs + 2], st[kt][8 * hs + 3]);
                pw[2 * kt + hs].z = cvtpk(st[kt][8 * hs + 4], st[kt][8 * hs + 5]); pw[2 * kt + hs].w = cvtpk(st[kt][8 * hs + 6], st[kt][8 * hs + 7]); }
            __builtin_amdgcn_sched_barrier(0);
        }
        l += __shfl_xor(l, 32); l += __builtin_amdgcn_exp2f(sink2 - mx);
        LAS float* linv = (LAS float*)(F.lds + AL_LINV) + w * 32;
        if (hi == 0) linv[r31] = 1.0f / l;
        f32x16 o[2];
        o[0] = (f32x16){0.f, 0.f, 0.f, 0.f, 0.f, 0.f, 0.f, 0.f, 0.f, 0.f, 0.f, 0.f, 0.f, 0.f, 0.f, 0.f}; o[1] = o[0];
        __builtin_amdgcn_sched_barrier(0);
#pragma unroll
        for (int s16 = 0; s16 < 12; ++s16) {
            const bf16x8 pa = __builtin_bit_cast(bf16x8, pw[s16]);
#pragma unroll
            for (int dt = 0; dt < 2; ++dt) { const LAS unsigned char* vp = F.lds + AL_VT + (32 * dt + r31) * AL_VROW + (16 * s16 + 4 * hi) * 2;
                const bf16x8 b = cat8(*(const LAS u32x2*)vp, *(const LAS u32x2*)(vp + 16));
                o[dt] = __builtin_amdgcn_mfma_f32_32x32x16_bf16(pa, b, o[dt], 0, 0, 0); }
            if (s16 & 1) __builtin_amdgcn_sched_barrier(0);
        }
        asm volatile("s_waitcnt lgkmcnt(0)" ::: "memory");
        int hio = 4 * hi; asm volatile("" : "+v"(hio));
        bf16_t* op = QB + (size_t)(row0 + 32 * th + hio) * 512 + hq * 64 + r31; const LAS float* lq = linv + hio;
#pragma unroll
        for (int r = 0; r < 16; ++r) { const int qq = (r & 3) + 8 * (r >> 2); const float li = lq[qq];
            op[(size_t)qq * 512] = (bf16_t)f2bf(o[0][r] * li); op[(size_t)qq * 512 + 32] = (bf16_t)f2bf(o[1][r] * li); }
        __syncthreads();
    }
}

constexpr int HL_QE = 0, HL_QROW = 272, HL_KE = 32 * 272, HL_KDT = 2 * 32 * 272, HL_TROW = 80, HL_VT = HL_KDT + 128 * 80, HL_EM = HL_VT + 128 * 80, HL_DEC = HL_EM + 512, HL_PART = HL_DEC + 512,
              HL_O = HL_PART + 2048, HL_OROW = 528, HL_END = HL_O + 32 * 528;
static_assert(HL_END <= RING_BYTES && AL_END <= RING_BYTES, "phase scratch inside the ring region");

template <bool FULL>
__device__ __forceinline__ void hgrn_prep(Frame& F, size_t rowoff  , float lb, float& btot) {
    const bf16_t* HQ = (const bf16_t*)(F.ws + WS_HQ); const bf16_t* HZ = (const bf16_t*)(F.ws + WS_HZ); const bf16_t* HV = (const bf16_t*)(F.ws + WS_HV);
    const int d = F.tid & 127, p = F.tid >> 7;
    float z[8], qv[8]; unsigned short vr[8];
#pragma unroll
    for (int i = 0; i < 8; ++i) { const size_t o = rowoff + (size_t)(8 * p + i) * DM + d; z[i] = bf2f(HZ[o]); vr[i] = HV[o]; qv[i] = FULL ? bf2f(HQ[o]) : 0.f; }
    { u32x4 wv; wv.x = vr[0] | ((unsigned)vr[1] << 16); wv.y = vr[2] | ((unsigned)vr[3] << 16); wv.z = vr[4] | ((unsigned)vr[5] << 16); wv.w = vr[6] | ((unsigned)vr[7] << 16);
      *(LAS u32x4*)(F.lds + HL_VT + d * HL_TROW + p * 16) = wv; }
    float kk[8], cs[8]; float run = 0.f;
#pragma unroll
    for (int i = 0; i < 8; ++i) { const float ez = __expf(-fmaxf(z[i], -60.f)), sg = __builtin_amdgcn_rcpf(1.f + ez); const float f = lb + (1.f - lb) * sg; kk[i] = (1.f - lb) * (ez * sg); run += __logf(f); cs[i] = run; }
    LAS float* part = (LAS float*)(F.lds + HL_PART);
    part[p * 128 + d] = run;
    __syncthreads();
    const float p0 = part[d], p1 = part[128 + d], p2 = part[256 + d], p3 = part[384 + d];
    const float m = p0 + p1, bl = (p0 + p1) + (p2 + p3), pre = (p >= 1 ? p0 : 0.f) + (p >= 2 ? p1 : 0.f) + (p >= 3 ? p2 : 0.f);
    float kd[8];
#pragma unroll
    for (int i = 0; i < 8; ++i) { const float b = pre + cs[i];
        if (FULL) { const float up = __expf(b - m), dn = __expf(m - b);
            *(LAS bf16_t*)(F.lds + HL_QE + (8 * p + i) * HL_QROW + d * 2) = (bf16_t)f2bf(qv[i] * up); *(LAS bf16_t*)(F.lds + HL_KE + (8 * p + i) * HL_QROW + d * 2) = (bf16_t)f2bf(kk[i] * dn); }
        kd[i] = kk[i] * __expf(bl - b); }
    { u32x4 wv; wv.x = pk2(kd[0], kd[1]); wv.y = pk2(kd[2], kd[3]); wv.z = pk2(kd[4], kd[5]); wv.w = pk2(kd[6], kd[7]); *(LAS u32x4*)(F.lds + HL_KDT + d * HL_TROW + p * 16) = wv; }
    if (p == 0) { if (FULL) ((LAS float*)(F.lds + HL_EM))[d] = __expf(m); ((LAS float*)(F.lds + HL_DEC))[d] = __expf(bl); btot += bl; }
    __syncthreads();
}
template <bool FULL>
__device__ __forceinline__ void hgrn_mma(Frame& F, f32x4 (&S)[8]) {
    const int lane = F.lane, w = F.wave, r15 = lane & 15, g = lane >> 4;
    const LAS unsigned char* L = F.lds;
    const LAS unsigned char* vrow = L + HL_VT + (16 * w + r15) * HL_TROW;
    const bf16x8 vn = *(const LAS bf16x8*)(vrow + 16 * g);
    if (FULL) {
        bf16x8 qe[2][4], ke[2][4];
#pragma unroll
        for (int tau = 0; tau < 2; ++tau)
#pragma unroll
            for (int kap = 0; kap < 4; ++kap) { const int off = (16 * tau + r15) * HL_QROW + (32 * kap + 4 * g) * 2;
                qe[tau][kap] = cat8(*(const LAS u32x2*)(L + HL_QE + off), *(const LAS u32x2*)(L + HL_QE + off + 32));
                ke[tau][kap] = cat8(*(const LAS u32x2*)(L + HL_KE + off), *(const LAS u32x2*)(L + HL_KE + off + 32)); }
        f32x4 at00 = (f32x4){0.f, 0.f, 0.f, 0.f}, at01 = at00, at11 = at00;
#pragma unroll
        for (int kap = 0; kap < 4; ++kap) { at00 = __builtin_amdgcn_mfma_f32_16x16x32_bf16(ke[0][kap], qe[0][kap], at00, 0, 0, 0);
            at01 = __builtin_amdgcn_mfma_f32_16x16x32_bf16(ke[0][kap], qe[1][kap], at01, 0, 0, 0); at11 = __builtin_amdgcn_mfma_f32_16x16x32_bf16(ke[1][kap], qe[1][kap], at11, 0, 0, 0); }
#pragma unroll
        for (int r = 0; r < 4; ++r) { const bool dead = (4 * g + r) > r15; at00[r] = dead ? 0.f : at00[r]; at11[r] = dead ? 0.f : at11[r]; }
        u32x4 a0, a1; a0.x = cvtpk(at00[0], at00[1]); a0.y = cvtpk(at00[2], at00[3]); a0.z = 0u; a0.w = 0u;
        a1.x = cvtpk(at01[0], at01[1]); a1.y = cvtpk(at01[2], at01[3]); a1.z = cvtpk(at11[0], at11[1]); a1.w = cvtpk(at11[2], at11[3]);
        const bf16x8 vp = cat8(*(const LAS u32x2*)(vrow + 8 * g), *(const LAS u32x2*)(vrow + 32 + 8 * g));
        f32x4 o0 = __builtin_amdgcn_mfma_f32_16x16x32_bf16(__builtin_bit_cast(bf16x8, a0), vp, (f32x4){0.f, 0.f, 0.f, 0.f}, 0, 0, 0);
        f32x4 o1 = __builtin_amdgcn_mfma_f32_16x16x32_bf16(__builtin_bit_cast(bf16x8, a1), vp, (f32x4){0.f, 0.f, 0.f, 0.f}, 0, 0, 0);
#pragma unroll
        for (int kap = 0; kap < 4; ++kap) { const f32x4 e0 = *(const LAS f32x4*)(L + HL_EM + (32 * kap + 4 * g) * 4), e1 = *(const LAS f32x4*)(L + HL_EM + (32 * kap + 16 + 4 * g) * 4);
            const f32x4 s0 = S[2 * kap] * e0, s1 = S[2 * kap + 1] * e1;
            u32x4 sw; sw.x = cvtpk(s0[0], s0[1]); sw.y = cvtpk(s0[2], s0[3]); sw.z = cvtpk(s1[0], s1[1]); sw.w = cvtpk(s1[2], s1[3]); const bf16x8 sp = __builtin_bit_cast(bf16x8, sw);
            o0 = __builtin_amdgcn_mfma_f32_16x16x32_bf16(qe[0][kap], sp, o0, 0, 0, 0); o1 = __builtin_amdgcn_mfma_f32_16x16x32_bf16(qe[1][kap], sp, o1, 0, 0, 0); }
        LAS float* ot = (LAS float*)(F.lds + HL_O) + 16 * w + r15;
#pragma unroll
        for (int r = 0; r < 4; ++r) { ot[(4 * g + r) * (HL_OROW / 4)] = o0[r]; ot[(16 + 4 * g + r) * (HL_OROW / 4)] = o1[r]; }
    }
#pragma unroll
    for (int dl = 0; dl < 8; ++dl) { const f32x4 dc = *(const LAS f32x4*)(L + HL_DEC + (16 * dl + 4 * g) * 4);
        const bf16x8 a = *(const LAS bf16x8*)(L + HL_KDT + (16 * dl + r15) * HL_TROW + 16 * g);
        S[dl] = __builtin_amdgcn_mfma_f32_16x16x32_bf16(a, vn, S[dl] * dc, 0, 0, 0); }
}
__device__ __forceinline__ void hgrn_norm(Frame& F, size_t rowoff) {
    const bf16_t* HG = (const bf16_t*)(F.ws + WS_HG); bf16_t* YH = (bf16_t*)(F.ws + WS_YH);
    const int t = F.tid >> 4, sub = F.tid & 15;
    const LAS float* op = (const LAS float*)(F.lds + HL_O + t * HL_OROW) + 8 * sub;
    const f32x4 a = *(const LAS f32x4*)op, b = *(const LAS f32x4*)(op + 4);
    float ss = (a[0] * a[0] + a[1] * a[1]) + (a[2] * a[2] + a[3] * a[3]) + (b[0] * b[0] + b[1] * b[1]) + (b[2] * b[2] + b[3] * b[3]);
    ss += __shfl_xor(ss, 1); ss += __shfl_xor(ss, 2); ss += __shfl_xor(ss, 4); ss += __shfl_xor(ss, 8);
    const float r = 1.f / sqrtf(ss * (1.f / 128.f) + RMS_EPS);
    const size_t o = rowoff + (size_t)t * DM + 8 * sub; const int hc = (int)(rowoff & 1023) + 8 * sub;
    const u32x4 gq = *(const u32x4*)(HG + o); const f32x4 n0 = *(const f32x4*)(F.in[IN_NORMW] + hc), n1 = *(const f32x4*)(F.in[IN_NORMW] + hc + 4);
    u32x4 wv;
    wv.x = pk2(a[0] * r * n0[0] * __uint_as_float(gq.x << 16), a[1] * r * n0[1] * __uint_as_float(gq.x & 0xffff0000u));
    wv.y = pk2(a[2] * r * n0[2] * __uint_as_float(gq.y << 16), a[3] * r * n0[3] * __uint_as_float(gq.y & 0xffff0000u));
    wv.z = pk2(b[0] * r * n1[0] * __uint_as_float(gq.z << 16), b[1] * r * n1[1] * __uint_as_float(gq.z & 0xffff0000u));
    wv.w = pk2(b[2] * r * n1[2] * __uint_as_float(gq.w << 16), b[3] * r * n1[3] * __uint_as_float(gq.w & 0xffff0000u));
    *(u32x4*)(YH + o) = wv;
}
__device__ __forceinline__ float hgrn_lb(Frame& F, int h) { const int c = h * 128 + (F.tid & 127); const float l0 = F.in[IN_LBL][c], l1 = F.in[IN_LBL][1024 + c]; return 1.f / (1.f + __expf(l1 - l0)); }
__device__ __forceinline__ void hgrn_state_load(Frame& F, const float* base, f32x4 (&S)[8]) {
    const int r15 = F.lane & 15, g = F.lane >> 4; const float* p = base + (size_t)(4 * g) * 128 + 16 * F.wave + r15;
#pragma unroll
    for (int dl = 0; dl < 8; ++dl)
#pragma unroll
        for (int r = 0; r < 4; ++r) S[dl][r] = p[(size_t)(16 * dl + r) * 128];
}
__device__ __forceinline__ void hgrn_state_store(Frame& F, float* base, const f32x4 (&S)[8]) {
    const int r15 = F.lane & 15, g = F.lane >> 4; float* p = base + (size_t)(4 * g) * 128 + 16 * F.wave + r15;
#pragma unroll
    for (int dl = 0; dl < 8; ++dl)
#pragma unroll
        for (int r = 0; r < 4; ++r) p[(size_t)(16 * dl + r) * 128] = S[dl][r];
}
__device__ __forceinline__ void hgrn_pass_a(Frame& F) {
    float* U = (float*)(F.ws + WS_U); float* D = (float*)(F.ws + WS_D);
    for (int unit = F.vcu; unit < 128 * 8; unit += F.G) {
        const int n = unit >> 3, h = unit & 7; const float lb = hgrn_lb(F, h); float btot = 0.f;
        f32x4 S[8];
#pragma unroll
        for (int dl = 0; dl < 8; ++dl) S[dl] = (f32x4){0.f, 0.f, 0.f, 0.f};
        for (int blk = 0; blk < 8; ++blk) { hgrn_prep<false>(F, (size_t)(n * 256 + blk * 32) * DM + h * 128, lb, btot); hgrn_mma<false>(F, S); __syncthreads(); }
        hgrn_state_store(F, U + (size_t)unit * 16384, S);
        if (F.tid < 128) D[unit * 128 + F.tid] = __expf(btot);
    }
}
__device__ __forceinline__ void hgrn_scan(Frame& F) {
    float* U = (float*)(F.ws + WS_U); const float* D = (const float*)(F.ws + WS_D);
    for (int gid = F.vcu * 512 + F.tid; gid < NBP * 8 * 128 * 32; gid += F.G * 512) {
        const int e4 = gid & 31, d = (gid >> 5) & 127, h = (gid >> 12) & 7, b = gid >> 15;
        f32x4 S = (f32x4){0.f, 0.f, 0.f, 0.f};
        for (int n0 = 0; n0 < 32; n0 += 8) {
            f32x4 u[8]; float dc[8];
#pragma unroll
            for (int i = 0; i < 8; ++i) { const size_t unit = (size_t)((b * 32 + n0 + i) * 8 + h); u[i] = *(const f32x4*)(U + unit * 16384 + d * 128 + e4 * 4); dc[i] = D[unit * 128 + d]; }
#pragma unroll
            for (int i = 0; i < 8; ++i) { const size_t unit = (size_t)((b * 32 + n0 + i) * 8 + h); *(f32x4*)(U + unit * 16384 + d * 128 + e4 * 4) = S; S = S * dc[i] + u[i]; }
        }
        *(f32x4*)(F.out + OFF_NSP + (size_t)(b * 8 + h) * 16384 + d * 128 + e4 * 4) = S;
    }
}
__device__ __forceinline__ void hgrn_pass_b(Frame& F) {
    const float* U = (const float*)(F.ws + WS_U);
    for (int unit = F.vcu; unit < 128 * 8 + NBS * 8; unit += F.G) {
        const bool samp = unit >= 1024; const int su = unit - 1024;
        const int h = unit & 7, nblk = samp ? 2 : 8; const size_t row0 = samp ? (size_t)MP + (size_t)(su >> 3) * DSEQ : (size_t)(unit >> 3) * 256;
        const float lb = hgrn_lb(F, h); float btot = 0.f;
        f32x4 S[8];
        hgrn_state_load(F, samp ? F.in[IN_ST] + (size_t)su * 16384 : U + (size_t)unit * 16384, S);
        for (int blk = 0; blk < nblk; ++blk) { const size_t ro = (row0 + blk * 32) * DM + h * 128;
            hgrn_prep<true>(F, ro, lb, btot); hgrn_mma<true>(F, S); __syncthreads(); hgrn_norm(F, ro); }
        if (samp) hgrn_state_store(F, F.out + OFF_NSS + (size_t)su * 16384, S);
        __syncthreads();
    }
}
struct Args { const float* in[22]; float* out; unsigned char* ws; int ph_lo, ph_hi; };
__global__ void __launch_bounds__(NWAVES * 64, 2) fwd(Args args) {
    extern __shared__ __attribute__((aligned(16))) unsigned char lds[];
    Frame F;
    F.lds = (LAS unsigned char*)lds;
    F.tid = threadIdx.x; F.lane = F.tid & 63; F.wave = __builtin_amdgcn_readfirstlane(F.tid >> 6);
    F.G = gridDim.x; { const int bx = blockIdx.x; F.vcu = (F.G % 8 == 0) ? (bx % 8) * (F.G / 8) + bx / 8 : bx; }
#pragma unroll
    for (int i = 0; i < 22; ++i) F.in[i] = args.in[i];
    F.out = args.out; F.ws = args.ws;
    cooperative_groups::grid_group grid = cooperative_groups::this_grid();
    const int lo = args.ph_lo, hi = args.ph_hi;
#define IN(k) (lo <= (k) && (k) < hi)
#define SEAM(k) do { if (IN(k) && IN((k) + 1)) { grid.sync(); } } while (0)
    unsigned char* ws = args.ws;
    bf16_t* H = (bf16_t*)(ws + WS_H);

    if (IN(0)) { p0_prologue(F); }
    SEAM(0);
    if (IN(1)) { p1_ln_mod(F); }
    SEAM(1);
    if (IN(2)) {
        pg8::Gemm g{H, (const bf16_t*)(ws + WS_WIN), M, INW, DM}; pg8::StaticOrder S; S.init(M, INW, F.G, (int)blockIdx.x);
        pg8::EpiProj E{(bf16_t*)(ws + WS_QB), (bf16_t*)(ws + WS_KB), (bf16_t*)(ws + WS_VB), (bf16_t*)(ws + WS_HQ), (bf16_t*)(ws + WS_HZ), (bf16_t*)(ws + WS_HV), (bf16_t*)(ws + WS_HG), (bf16_t*)F.out, F.out};
        pg8::gemm_phase<pg8::EpiProj, pg8::StaticOrder, true, true>(F.lds, g, S, E);
    }
    SEAM(2);
    if (IN(3)) {
#if ATTN_IMPL
        attn_fast(F);
#else
        attn_simple(F);
#endif
#if HGRN_IMPL
        hgrn_pass_a(F);
#else
        hgrn_simple(F);
#endif
    }
    SEAM(3);
#if HGRN_IMPL
    if (IN(4)) { hgrn_scan(F); }
    SEAM(4);
    if (IN(5)) { hgrn_pass_b(F); }
    SEAM(5);
#endif
    if (IN(6)) {
        { pg8::Gemm g{(const bf16_t*)(ws + WS_QB), (const bf16_t*)(ws + WS_WBA), M, DM, 512}; pg8::StaticOrder S; S.init(M, DM, F.G, (int)blockIdx.x);
          pg8::EpiMerge<true> E{(const bf16_t*)F.out, nullptr, (bf16_t*)(ws + WS_T1)};
          pg8::gemm_phase<pg8::EpiMerge<true>, pg8::StaticOrder, true, true>(F.lds, g, S, E); }
        __syncthreads();
        { pg8::Gemm g{(const bf16_t*)(ws + WS_YH), (const bf16_t*)(ws + WS_WBH), M, DM, DM}; pg8::StaticOrder S; S.init(M, DM, F.G, (int)blockIdx.x);
          pg8::EpiMerge<false> E{(const bf16_t*)F.out, (const bf16_t*)(ws + WS_T1), (bf16_t*)(ws + WS_MERGED)};
          pg8::gemm_phase<pg8::EpiMerge<false>, pg8::StaticOrder, true, true>(F.lds, g, S, E); }
    }
    SEAM(6);
    if (IN(7)) {
        pg8::Gemm g{(const bf16_t*)(ws + WS_MERGED), (const bf16_t*)(ws + WS_WOUT), M, DM, DM}; pg8::StaticOrder S; S.init(M, DM, F.G, (int)blockIdx.x);
        pg8::EpiResid E{F.in[IN_XP], F.in[IN_XS], (const float*)(ws + WS_MOD) + 2048, (float*)(ws + WS_Z1), ALPHA};
        pg8::gemm_phase<pg8::EpiResid, pg8::StaticOrder, true, true>(F.lds, g, S, E);
    }
    SEAM(7);
    if (IN(8)) { p8_ln_mix(F); }
    SEAM(8);
    if (IN(9)) {
        pg8::Gemm g{H, (const bf16_t*)(ws + WS_WUP), M, 2 * DFF, DM}; pg8::StaticOrder S; S.init(M, 2 * DFF, F.G, (int)blockIdx.x);
        pg8::EpiSwiGLU E{(bf16_t*)(ws + WS_ACT)};
        pg8::gemm_phase<pg8::EpiSwiGLU, pg8::StaticOrder, true, true>(F.lds, g, S, E);
    }
    SEAM(9);
    if (IN(10)) {
        pg8::Gemm g{(const bf16_t*)(ws + WS_ACT), (const bf16_t*)(ws + WS_WDN), M, DM, DFF}; pg8::StaticOrder S; S.init(M, DM, F.G, (int)blockIdx.x);
        const float* X1 = (const float*)(ws + WS_X1);
        pg8::EpiResid E{X1, X1 + (size_t)MP * DM, (const float*)(ws + WS_MOD) + 5120, F.out, ALPHA};
        pg8::gemm_phase<pg8::EpiResid, pg8::StaticOrder, true, true>(F.lds, g, S, E);
    }
    SEAM(10);
    if (IN(11)) { p11_ln_out(F); }
#undef IN
#undef SEAM
}

extern "C" void kernel_launch(void* const* d_in, const int* in_sizes, int n_in, void* d_out, int out_size, void* d_ws, size_t ws_size, hipStream_t stream) {
    static int grid = 0;
    if (grid == 0) {
        if (n_in != 22 || out_size != 41549824 || ws_size < WS_END) { fprintf(stderr, "kernel_launch: unexpected problem (n_in %d, out %d, ws %zu)\n", n_in, out_size, ws_size); grid = -1; return; }
        int dev = 0, cus = 0, per_cu = 0;
        if (hipGetDevice(&dev) != hipSuccess || hipDeviceGetAttribute(&cus, hipDeviceAttributeMultiprocessorCount, dev) != hipSuccess) { grid = -1; return; }
        if (hipFuncSetAttribute((const void*)fwd, hipFuncAttributeMaxDynamicSharedMemorySize, LDS_BYTES) != hipSuccess) { fprintf(stderr, "kernel_launch: hipFuncSetAttribute failed\n"); grid = -1; return; }
        if (hipOccupancyMaxActiveBlocksPerMultiprocessor(&per_cu, (const void*)fwd, NWAVES * 64, LDS_BYTES) != hipSuccess || per_cu < 1) { fprintf(stderr, "kernel_launch: occupancy query says %d\n", per_cu); (void)hipGetLastError(); grid = -1; return; }
        grid = cus;
    }
    if (grid < 0) return;
    (void)hipMemsetAsync((char*)d_ws + WS_CTL, 0, CTL_ZERO_BYTES, stream);
    Args a{};
    for (int i = 0; i < 22; ++i) a.in[i] = (const float*)d_in[i];
    a.out = (float*)d_out; a.ws = (unsigned char*)d_ws;
#if MK_N_LAUNCHES == 1
    a.ph_lo = 0; a.ph_hi = N_PHASES;
    void* kargs[] = {&a};
    hipError_t e = hipLaunchCooperativeKernel((const void*)fwd, dim3(grid), dim3(NWAVES * 64), kargs, LDS_BYTES, stream);
    if (e != hipSuccess) fprintf(stderr, "kernel_launch: cooperative launch failed: %s\n", hipGetErrorString(e));
#else
    for (int p = 0; p < N_PHASES; ++p) {
        if (p == 4 || p == 5) { if (!HGRN_IMPL) continue; }
        a.ph_lo = p; a.ph_hi = p + 1;
        hipLaunchKernelGGL(fwd, dim3(grid), dim3(NWAVES * 64), LDS_BYTES, stream, a);
    }
#endif
}
```

```cpp
#define MK_N_LAUNCHES 1
#define ATTN_IMPL 1
#define HGRN_IMPL 1
#include <hip/hip_runtime.h>
#include <hip/hip_cooperative_groups.h>
#include <cstdio>
#include <cstdint>
namespace pg8 {
#define PG8_LAS __attribute__((address_space(3)))
typedef unsigned short bf16_t;
typedef short bf16x8 __attribute__((ext_vector_type(8)));
typedef float f32x4 __attribute__((ext_vector_type(4)));
typedef unsigned u32x4 __attribute__((ext_vector_type(4)));
constexpr int BM = 256, BK = 64, HALF = 128, HTB = HALF * BK * 2  , STAGE_BYTES = 8 * HTB, NXCD = 8, WGM = 8;

__host__ __device__ __forceinline__ int lds_byte(int r, int c) { const int st = (r >> 4) * 2 + (c >> 5), rr = r & 15, cc = c & 31, ob = rr * 64 + cc * 2; return st * 1024 + (ob ^ (((ob >> 9) & 1) << 5)); }
__host__ __device__ __forceinline__ void stage_rc(int b, int& R, int& C) { const int st = b / 1024, sb = b % 1024, swz = sb ^ (((sb >> 9) & 1) << 5); R = (st >> 1) * 16 + swz / 64; C = (st & 1) * 32 + (swz % 64) / 2; }
__host__ __device__ __forceinline__ int perm32(int rho) { const int n = rho >> 4, i = rho & 15; return 8 * (i >> 2) + 4 * n + (i & 3); }

struct Unit { int pm, pn; };
struct Gemm { const bf16_t* A; const bf16_t* Bt; int M, N, K; };

struct StaticOrder {
    int nM, nN, nwg, G, c;
    __host__ __device__ void init(int M, int N, int G_, int c_) { nM = M / BM; nN = N / BM; nwg = nM * nN; G = G_; c = c_; }
    __host__ __device__ bool next(int i, Unit& u) const {
        const long L = (long)i * G + c; if (L >= nwg) return false;
        int wgid = (int)L; { const int q = nwg / NXCD, r = nwg % NXCD, xcd = wgid % NXCD, off = wgid / NXCD; wgid = (xcd < r ? xcd * (q + 1) : r * (q + 1) + (xcd - r) * q) + off; }
        const int nig = WGM * nN, gid = wgid / nig, fm = gid * WGM, gsz = (nM - fm) < WGM ? (nM - fm) : WGM;
        u.pm = fm + ((wgid % nig) % gsz); u.pn = (wgid % nig) / gsz; return true;
    }
    __device__ __forceinline__ void a_ready(const Unit&) const {}
    __device__ __forceinline__ void done(const Unit&) const {}
};

__device__ __forceinline__ unsigned cvt_pk_bf16(float lo, float hi) { unsigned r; asm volatile("v_cvt_pk_bf16_f32 %0, %1, %2" : "=v"(r) : "v"(lo), "v"(hi)); return r; }
typedef float f32x2 __attribute__((ext_vector_type(2)));
__device__ __forceinline__ float bf2f(unsigned short b) { return __uint_as_float(((unsigned)b) << 16); }
__device__ __forceinline__ float fsigmoid(float x) { return __builtin_amdgcn_rcpf(1.0f + __expf(-x)); }
__device__ __forceinline__ float fsilu(float x) { return x * fsigmoid(x); }
__device__ __forceinline__ int mod_row(int row) { return row < 32768 ? (row >> 13) : 4 + ((row - 32768) >> 6); }
constexpr int OFF_NKP = 35651584, OFF_NVP = 35717120, OFF_NSP = 35782656, OFF_NKS = 36306944, OFF_NVS = 36831232, OFF_NSS = 37355520;

struct EpiProj {
    static constexpr bool PERM = true, AFTER_DRAIN = false;
    bf16_t *QB, *KB, *VB, *HQ, *HZ, *HV, *HG, *GT; float* dout;
    __device__ __forceinline__ void operator()(const f32x4 (&acc)[2][2][4][2], const Unit& u, int wr, int wc, int fr, int fq) const {
        const int pn = u.pn, row0 = u.pm * BM + wr * 64 + fr, cl = wc * 32 + 8 * fq;
        if (pn == 2) {
#pragma unroll
            for (int ai = 0; ai < 2; ++ai)
#pragma unroll
                for (int m = 0; m < 4; ++m) { const int row = row0 + ai * HALF + m * 16;
                    float* wdst = nullptr;
                    if (row < 32768) { const int t = row & 8191; if (t >= 8064) wdst = dout + OFF_NKP + (size_t)(((row >> 13) * 128 + (t - 8064)) * 128 + cl); }
                    else { const int r2 = row - 32768; wdst = dout + OFF_NKS + (size_t)(((r2 >> 6) * 128 + 64 + (r2 & 63)) * 128 + cl); }
#pragma unroll
                    for (int bj = 0; bj < 2; ++bj) { const f32x4 v0 = acc[ai][bj][m][0], v1 = acc[ai][bj][m][1];
                        u32x4 w; w.x = cvt_pk_bf16(v0[0], v0[1]); w.y = cvt_pk_bf16(v0[2], v0[3]); w.z = cvt_pk_bf16(v1[0], v1[1]); w.w = cvt_pk_bf16(v1[2], v1[3]);
                        *(u32x4*)((bj == 0 ? KB : VB) + (size_t)row * 128 + cl) = w;
                        if (wdst) { float* d = wdst + (bj == 0 ? 0 : (row < 32768 ? (OFF_NVP - OFF_NKP) : (OFF_NVS - OFF_NKS))); *(f32x4*)d = v0; *(f32x4*)(d + 4) = v1; } } }
            return;
        }
        int mode; bf16_t* base; int ldc, cb;
        if (pn < 2)       { mode = 0; base = QB; ldc = 512;  cb = pn * 256; }
        else if (pn < 7)  { mode = 1; base = HQ; ldc = 1024; cb = (pn - 3) * 256; }
        else if (pn < 11) { mode = 3; base = HZ; ldc = 1024; cb = (pn - 7) * 256; }
        else if (pn < 15) { mode = 3; base = HV; ldc = 1024; cb = (pn - 11) * 256; }
        else if (pn < 19) { mode = 1; base = HG; ldc = 1024; cb = (pn - 15) * 256; }
        else              { mode = 2; base = GT; ldc = 2048; cb = (pn - 19) * 256; }
#pragma unroll
        for (int ai = 0; ai < 2; ++ai)
#pragma unroll
            for (int m = 0; m < 4; ++m) { bf16_t* rowp = base + (size_t)(row0 + ai * HALF + m * 16) * ldc + cb + cl;
#pragma unroll
                for (int bj = 0; bj < 2; ++bj) { f32x4 v0 = acc[ai][bj][m][0], v1 = acc[ai][bj][m][1];
                    if (mode == 0) { v0 = v0 * 0.125f; v1 = v1 * 0.125f; }
                    else if (mode == 1) {
#pragma unroll
                        for (int i = 0; i < 4; ++i) { v0[i] = fsilu(v0[i]); v1[i] = fsilu(v1[i]); } }
                    else if (mode == 2) {
#pragma unroll
                        for (int i = 0; i < 4; ++i) { v0[i] = fsigmoid(v0[i]); v1[i] = fsigmoid(v1[i]); } }
                    u32x4 w; w.x = cvt_pk_bf16(v0[0], v0[1]); w.y = cvt_pk_bf16(v0[2], v0[3]); w.z = cvt_pk_bf16(v1[0], v1[1]); w.w = cvt_pk_bf16(v1[2], v1[3]);
                    *(u32x4*)(rowp + bj * HALF) = w; } }
    }
};
struct EpiSwiGLU {
    static constexpr bool PERM = true, AFTER_DRAIN = false;
    bf16_t* O;
    __device__ __forceinline__ void operator()(const f32x4 (&acc)[2][2][4][2], const Unit& u, int wr, int wc, int fr, int fq) const {
        const int row0 = u.pm * BM + wr * 64 + fr, col = u.pn * 128 + wc * 32 + 8 * fq;
#pragma unroll
        for (int ai = 0; ai < 2; ++ai)
#pragma unroll
            for (int m = 0; m < 4; ++m) { f32x4 v0, v1;
#pragma unroll
                for (int i = 0; i < 4; ++i) { v0[i] = fsilu(acc[ai][1][m][0][i]) * acc[ai][0][m][0][i]; v1[i] = fsilu(acc[ai][1][m][1][i]) * acc[ai][0][m][1][i]; }
                u32x4 w; w.x = cvt_pk_bf16(v0[0], v0[1]); w.y = cvt_pk_bf16(v0[2], v0[3]); w.z = cvt_pk_bf16(v1[0], v1[1]); w.w = cvt_pk_bf16(v1[2], v1[3]);
                *(u32x4*)(O + (size_t)(row0 + ai * HALF + m * 16) * 2816 + col) = w; }
    }
};
template <bool FIRST> struct EpiMerge {
    static constexpr bool PERM = true, AFTER_DRAIN = false;
    const bf16_t* GT; const bf16_t* T1in; bf16_t* O;
    __device__ __forceinline__ void operator()(const f32x4 (&acc)[2][2][4][2], const Unit& u, int wr, int wc, int fr, int fq) const {
        const int row0 = u.pm * BM + wr * 64 + fr, col0 = u.pn * BM + wc * 32 + 8 * fq;
#pragma unroll
        for (int ai = 0; ai < 2; ++ai)
#pragma unroll
            for (int m = 0; m < 4; ++m) { const size_t row = (size_t)(row0 + ai * HALF + m * 16);
#pragma unroll
                for (int bj = 0; bj < 2; ++bj) { const int col = col0 + bj * HALF;
                    const u32x4 g = *(const u32x4*)(GT + row * 2048 + (FIRST ? 0 : 1024) + col);
                    f32x4 v0 = acc[ai][bj][m][0], v1 = acc[ai][bj][m][1];
                    v0[0] *= __uint_as_float(g.x << 16); v0[1] *= __uint_as_float(g.x & 0xffff0000u); v0[2] *= __uint_as_float(g.y << 16); v0[3] *= __uint_as_float(g.y & 0xffff0000u);
                    v1[0] *= __uint_as_float(g.z << 16); v1[1] *= __uint_as_float(g.z & 0xffff0000u); v1[2] *= __uint_as_float(g.w << 16); v1[3] *= __uint_as_float(g.w & 0xffff0000u);
                    if (!FIRST) { const u32x4 t = *(const u32x4*)(T1in + row * 1024 + col);
                        v0[0] += __uint_as_float(t.x << 16); v0[1] += __uint_as_float(t.x & 0xffff0000u); v0[2] += __uint_as_float(t.y << 16); v0[3] += __uint_as_float(t.y & 0xffff0000u);
                        v1[0] += __uint_as_float(t.z << 16); v1[1] += __uint_as_float(t.z & 0xffff0000u); v1[2] += __uint_as_float(t.w << 16); v1[3] += __uint_as_float(t.w & 0xffff0000u); }
                    u32x4 w; w.x = cvt_pk_bf16(v0[0], v0[1]); w.y = cvt_pk_bf16(v0[2], v0[3]); w.z = cvt_pk_bf16(v1[0], v1[1]); w.w = cvt_pk_bf16(v1[2], v1[3]);
                    *(u32x4*)(O + row * 1024 + col) = w; } }
    }
};
struct EpiResid {
    static constexpr bool PERM = false, AFTER_DRAIN = false;
    const float* xa; const float* xb; const float* gate;
    float* out; float alpha;
    __device__ __forceinline__ void operator()(const f32x4 (&acc)[2][2][4][2], const Unit& u, int wr, int wc, int fr, int fq) const {
        const int row0 = u.pm * BM + wr * 64 + fr, col0 = u.pn * BM + wc * 32 + 4 * fq;
#pragma unroll
        for (int ai = 0; ai < 2; ++ai)
#pragma unroll
            for (int m = 0; m < 4; ++m) { const int row = row0 + ai * HALF + m * 16;
                const float* xr = row < 32768 ? xa + (size_t)row * 1024 : xb + (size_t)(row - 32768) * 1024;
                const float* gr = gate + (size_t)mod_row(row) * 6144; float* orow = out + (size_t)row * 1024;
#pragma unroll
                for (int bj = 0; bj < 2; ++bj)
#pragma unroll
                    for (int n = 0; n < 2; ++n) { const int c = col0 + bj * HALF + n * 16;
                        const f32x4 xv = *(const f32x4*)(xr + c), gv = *(const f32x4*)(gr + c);
                        *(f32x4*)(orow + c) = xv * alpha + gv * acc[ai][bj][m][n]; } }
    }
};
template <class Epi, class Sched, bool ALIGN_EPI = false, bool SP2 = false>
__device__ __forceinline__ void gemm_phase(PG8_LAS unsigned char* lds, const Gemm g, const Sched& S, const Epi& E) {
    const int tid = threadIdx.x, wid = __builtin_amdgcn_readfirstlane(tid >> 6), lane = tid & 63, wr = wid >> 2, wc = wid & 3, fr = lane & 15, fq = lane >> 4;
    const int K = g.K, nt = K / BK;
    unsigned voffA[2], voffB[2];
#pragma unroll
    for (int i = 0; i < 2; ++i) { int R, C; stage_rc(tid * 16 + i * 8192, R, C); const int Rb = Epi::PERM ? ((R & ~31) + perm32(R & 31)) : R;
        voffA[i] = (unsigned)(R * K + C) * 2u; voffB[i] = (unsigned)(Rb * K + C) * 2u; }
    const size_t kstep = (size_t)(BK * 2);
    const size_t hstep = (size_t)HALF * K * 2;
    const size_t tstep = 2 * hstep;
    const unsigned ldsw = (unsigned)wid * 1024u;
    const int aoff = lds_byte(wr * 64 + fr, fq * 8), boff = lds_byte(wc * 32 + fr, fq * 8);
#define PG8_SA(b, h) (((b) * 2 + (h)) * HTB)
#define PG8_SB(b, h) ((4 + (b) * 2 + (h)) * HTB)
#define PG8_STAGE(bufoff, gbase, voff) do { _Pragma("unroll") for (int _i = 0; _i < 2; ++_i) \
        __builtin_amdgcn_global_load_lds((const unsigned*)((const char*)(gbase) + (voff)[_i]), (PG8_LAS unsigned*)(lds + (bufoff) + ldsw + _i * 8192), 16, 0, 0); } while (0)
#define PG8_LDA(dst, b, h) do { _Pragma("unroll") for (int m = 0; m < 4; ++m) _Pragma("unroll") for (int k = 0; k < 2; ++k) dst[m][k] = *(const PG8_LAS bf16x8*)(lds + PG8_SA(b, h) + aoff + m * 2048 + k * 1024); } while (0)
#define PG8_LDB(dst, b, h) do { _Pragma("unroll") for (int n = 0; n < 2; ++n) _Pragma("unroll") for (int k = 0; k < 2; ++k) dst[n][k] = *(const PG8_LAS bf16x8*)(lds + PG8_SB(b, h) + boff + n * 2048 + k * 1024); } while (0)
#define PG8_MMA(ai, bj, At, Bt) do { __builtin_amdgcn_s_setprio(1); _Pragma("unroll") for (int m = 0; m < 4; ++m) _Pragma("unroll") for (int n = 0; n < 2; ++n) _Pragma("unroll") for (int k = 0; k < 2; ++k) \
        acc[ai][bj][m][n] = __builtin_amdgcn_mfma_f32_16x16x32_bf16(Bt[n][k], At[m][k], acc[ai][bj][m][n], 0, 0, 0); __builtin_amdgcn_s_setprio(0); } while (0)
#define PG8_WAIT_V(n) asm volatile("s_waitcnt vmcnt(" #n ")" ::: "memory")
#define PG8_WAIT_L(n) asm volatile("s_waitcnt lgkmcnt(" #n ")" ::: "memory")
#define PG8_BAR __builtin_amdgcn_s_barrier()
#define PG8_SCHED __builtin_amdgcn_sched_barrier(0)
    Unit cur, nxt; int ui = 0;
    if (!S.next(0, cur)) return;
    f32x4 acc[2][2][4][2];
#pragma unroll
    for (int a = 0; a < 2; ++a)
#pragma unroll
        for (int b = 0; b < 2; ++b)
#pragma unroll
            for (int m = 0; m < 4; ++m)
#pragma unroll
                for (int n = 0; n < 2; ++n) acc[a][b][m][n] = (f32x4){0.f, 0.f, 0.f, 0.f};
    bf16x8 At[4][2], B0[2][2], B1[2][2];
    const char* cA = (const char*)g.A + (size_t)cur.pm * tstep; const char* cB = (const char*)g.Bt + (size_t)cur.pn * tstep;
    S.a_ready(cur);
    if constexpr (SP2) {
        PG8_STAGE(PG8_SB(0, 0), cB, voffB); PG8_STAGE(PG8_SB(0, 1), cB + hstep, voffB); PG8_STAGE(PG8_SA(0, 0), cA, voffA); PG8_STAGE(PG8_SA(0, 1), cA + hstep, voffA);
        if (wr == 1) PG8_BAR;
        PG8_WAIT_V(2); PG8_BAR;
        PG8_STAGE(PG8_SB(1, 0), cB + kstep, voffB); PG8_STAGE(PG8_SA(1, 0), cA + kstep, voffA); PG8_STAGE(PG8_SB(1, 1), cB + hstep + kstep, voffB);
        PG8_WAIT_V(6); PG8_BAR;
    } else {
        PG8_STAGE(PG8_SB(0, 0), cB, voffB); PG8_STAGE(PG8_SA(0, 0), cA, voffA); PG8_STAGE(PG8_SB(0, 1), cB + hstep, voffB); PG8_STAGE(PG8_SA(0, 1), cA + hstep, voffA);
        if (wr == 1) PG8_BAR;
        PG8_WAIT_V(4); PG8_BAR;
        PG8_STAGE(PG8_SB(1, 0), cB + kstep, voffB); PG8_STAGE(PG8_SA(1, 0), cA + kstep, voffA); PG8_STAGE(PG8_SB(1, 1), cB + hstep + kstep, voffB);
        PG8_WAIT_V(6); PG8_BAR;
    }
    for (;;) {
        const bool has_next = S.next(ui + 1, nxt);
        const char* nA = has_next ? (const char*)g.A + (size_t)nxt.pm * tstep : cA; const char* nB = has_next ? (const char*)g.Bt + (size_t)nxt.pn * tstep : cB;
        for (int t = 0; t < nt; t += 2) {
            const bool last = (t == nt - 2);
            const char* a1 = cA + (size_t)(t + 1) * kstep;
            const char* a2 = last ? nA : cA + (size_t)(t + 2) * kstep; const char* b2 = last ? nB : cB + (size_t)(t + 2) * kstep;
            const char* a3 = a2 + kstep; const char* b3 = b2 + kstep;
            if (last && has_next) S.a_ready(nxt);
            if constexpr (SP2) {
            PG8_LDB(B0, 0, 0); PG8_LDB(B1, 0, 1); PG8_SCHED; PG8_LDA(At, 0, 0); PG8_STAGE(PG8_SA(1, 1), a1 + hstep, voffA);
            PG8_WAIT_V(8); PG8_WAIT_L(0); PG8_BAR; PG8_MMA(0, 0, At, B0); PG8_MMA(0, 1, At, B1); PG8_BAR; PG8_SCHED;
            PG8_LDA(At, 0, 1); PG8_STAGE(PG8_SB(0, 0), b2, voffB); PG8_STAGE(PG8_SB(0, 1), b2 + hstep, voffB); PG8_STAGE(PG8_SA(0, 0), a2, voffA);
            PG8_WAIT_V(8); PG8_WAIT_L(0); PG8_BAR; PG8_MMA(1, 0, At, B0); PG8_MMA(1, 1, At, B1); PG8_BAR; PG8_SCHED;
            PG8_LDB(B0, 1, 0); PG8_LDB(B1, 1, 1); PG8_SCHED; PG8_LDA(At, 1, 0); PG8_STAGE(PG8_SA(0, 1), a2 + hstep, voffA);
            PG8_WAIT_V(8); PG8_WAIT_L(0); PG8_BAR; PG8_MMA(0, 0, At, B0); PG8_MMA(0, 1, At, B1); PG8_BAR; PG8_SCHED;
            PG8_LDA(At, 1, 1); PG8_STAGE(PG8_SB(1, 0), b3, voffB); PG8_STAGE(PG8_SB(1, 1), b3 + hstep, voffB); PG8_STAGE(PG8_SA(1, 0), a3, voffA);
            PG8_WAIT_V(8); PG8_WAIT_L(0); PG8_BAR; PG8_MMA(1, 0, At, B0); PG8_MMA(1, 1, At, B1); PG8_BAR; PG8_SCHED;
            } else {
            PG8_LDB(B0, 0, 0); PG8_SCHED; PG8_LDA(At, 0, 0); PG8_STAGE(PG8_SA(1, 1), a1 + hstep, voffA);
            PG8_WAIT_L(8); PG8_BAR; PG8_WAIT_L(0); PG8_MMA(0, 0, At, B0); PG8_BAR; PG8_SCHED;
            PG8_LDB(B1, 0, 1); PG8_STAGE(PG8_SB(0, 0), b2, voffB);
            PG8_BAR; PG8_WAIT_L(0); PG8_MMA(0, 1, At, B1); PG8_BAR;
            PG8_LDA(At, 0, 1); PG8_STAGE(PG8_SA(0, 0), a2, voffA);
            PG8_BAR; PG8_WAIT_L(0); PG8_MMA(1, 0, At, B0); PG8_BAR; PG8_SCHED;
            PG8_STAGE(PG8_SB(0, 1), b2 + hstep, voffB);
            PG8_WAIT_V(6); PG8_BAR; PG8_MMA(1, 1, At, B1); PG8_BAR;
            PG8_LDB(B0, 1, 0); PG8_SCHED; PG8_LDA(At, 1, 0); PG8_STAGE(PG8_SA(0, 1), a2 + hstep, voffA);
            PG8_WAIT_L(8); PG8_BAR; PG8_WAIT_L(0); PG8_MMA(0, 0, At, B0); PG8_BAR; PG8_SCHED;
            PG8_LDB(B1, 1, 1); PG8_STAGE(PG8_SB(1, 0), b3, voffB);
            PG8_BAR; PG8_WAIT_L(0); PG8_MMA(0, 1, At, B1); PG8_BAR;
            PG8_LDA(At, 1, 1); PG8_STAGE(PG8_SA(1, 0), a3, voffA);
            PG8_BAR; PG8_WAIT_L(0); PG8_MMA(1, 0, At, B0); PG8_BAR; PG8_SCHED;
            PG8_STAGE(PG8_SB(1, 1), b3 + hstep, voffB);
            PG8_WAIT_V(6); PG8_BAR; PG8_MMA(1, 1, At, B1); PG8_BAR;
            }
        }
        if constexpr (ALIGN_EPI) { if (wr == 0) PG8_BAR; }
        if constexpr (!Epi::AFTER_DRAIN) { E(acc, cur, wr, wc, fr, fq); S.done(cur); }
        if (!has_next) break;
#pragma unroll
        for (int a = 0; a < 2; ++a)
#pragma unroll
            for (int b = 0; b < 2; ++b)
#pragma unroll
                for (int m = 0; m < 4; ++m)
#pragma unroll
                    for (int n = 0; n < 2; ++n) acc[a][b][m][n] = (f32x4){0.f, 0.f, 0.f, 0.f};
        cur = nxt; cA = nA; cB = nB; ++ui;
        if constexpr (ALIGN_EPI) { if (wr == 1) PG8_BAR; }
    }
    PG8_WAIT_V(0);
    if constexpr (!ALIGN_EPI) { if (wr == 0) PG8_BAR; }
    PG8_BAR;
    if constexpr (Epi::AFTER_DRAIN) { E.fused(acc, cur, wr, wc, fr, fq, lds, wid, lane); S.done(cur); }
#undef PG8_SA
#undef PG8_SB
#undef PG8_STAGE
#undef PG8_LDA
#undef PG8_LDB
#undef PG8_MMA
#undef PG8_WAIT_V
#undef PG8_WAIT_L
#undef PG8_BAR
#undef PG8_SCHED
}
}
#define GAS __attribute__((address_space(1)))
#define LAS __attribute__((address_space(3)))
typedef unsigned short bf16;
typedef unsigned v4u __attribute__((ext_vector_type(4)));
typedef float f32x4 __attribute__((ext_vector_type(4)));
typedef short bf16x8 __attribute__((ext_vector_type(8)));
typedef GAS unsigned gu32;
typedef GAS unsigned long long gu64;
#define RLX_AGENT __ATOMIC_RELAXED, __HIP_MEMORY_SCOPE_AGENT
#define LDS_WAIT() asm volatile("s_waitcnt lgkmcnt(0)" ::: "memory")
#define VM_WAIT() asm volatile("s_waitcnt vmcnt(0)" ::: "memory")
__device__ __forceinline__ unsigned long long rt() { return __builtin_amdgcn_s_memrealtime(); }
__device__ __forceinline__ unsigned f2bf(float f) { unsigned u = __builtin_bit_cast(unsigned, f); return (u + 0x7fffu + ((u >> 16) & 1u)) >> 16; }
__device__ __forceinline__ unsigned pk2(float lo, float hi) { return f2bf(lo) | (f2bf(hi) << 16); }
#define XB_TMO      128
#define XB_XCNT(j)  (256  + 64 * (j))
#define XB_XSUB(j)  (1280 + 64 * (j))
#define XB_XGEN(j)  (2304 + 64 * (j))
#define XB_TOP      3328
#define XB_TOPGEN   3392
#define XCD_BAR_WORDS 3456
#define XB_SPIN_CAP (1u << 18)

__device__ __forceinline__ unsigned xb_ld(unsigned* p)              { return __hip_atomic_load(p, __ATOMIC_RELAXED, __HIP_MEMORY_SCOPE_AGENT); }
__device__ __forceinline__ unsigned xb_add(unsigned* p, unsigned v) { return __hip_atomic_fetch_add(p, v, __ATOMIC_RELAXED, __HIP_MEMORY_SCOPE_AGENT); }
__device__ __forceinline__ unsigned xb_xcc_id() { return (unsigned)__builtin_amdgcn_s_getreg((3 << 11) | 20) & 0xFu; }
#define XB_SPIN(cond, bar) do { unsigned _sp = 0; while (cond) { __builtin_amdgcn_s_sleep(1); \
    if ((++_sp & 255u) == 0u) { if (xb_ld(&(bar)[XB_TMO])) break; if (_sp > XB_SPIN_CAP) { atomicAdd(&(bar)[XB_TMO], 1u); break; } } } } while (0)

struct XcdBarrier {
    unsigned* bar; unsigned x;
    volatile LAS unsigned* st;
};

__device__ __forceinline__ XcdBarrier xcd_barrier_post(unsigned* bar, volatile LAS unsigned* st) {
    XcdBarrier b; b.bar = bar; b.x = xb_xcc_id(); b.st = st;
    if (threadIdx.x == 0) (void)xb_add(&bar[XB_XCNT(b.x)], 1u);
    return b;
}
__device__ __forceinline__ void xcd_barrier_complete(unsigned* bar, unsigned x, unsigned& nloc, unsigned& nx) {
    const unsigned G = gridDim.x * gridDim.y * gridDim.z;
    unsigned sum, cnt, mine, sp = 0u;
    for (;;) {
        sum = 0u; cnt = 0u; mine = 0u;
#pragma unroll
        for (unsigned j = 0; j < 16; ++j) { const unsigned c = xb_ld(&bar[XB_XCNT(j)]); sum += c; cnt += (c > 0u) ? 1u : 0u; mine = (j == x) ? c : mine; }
        if (sum == G) break;
        __builtin_amdgcn_s_sleep(1);
        if ((++sp & 255u) == 0u) { if (xb_ld(&bar[XB_TMO])) break; if (sp > XB_SPIN_CAP) { atomicAdd(&bar[XB_TMO], 1u); break; } }
    }
    nloc = mine > 0u ? mine : 1u; nx = cnt > 0u ? cnt : 1u;
}

__device__ __forceinline__ void xcd_barrier(const XcdBarrier& b) {
    asm volatile("s_waitcnt vmcnt(0)" ::: "memory");
    __syncthreads();
    if (threadIdx.x == 0) {
        unsigned* bar = b.bar;
        __builtin_amdgcn_s_waitcnt(0);
        unsigned nloc = b.st[0], nx = b.st[1];
        if (nloc == 0u) { xcd_barrier_complete(bar, b.x, nloc, nx); b.st[0] = nloc; b.st[1] = nx; }
        const unsigned old = xb_add(&bar[XB_XSUB(b.x)], 1u);
        const unsigned gen = old / nloc;
        if (old + 1u == (gen + 1u) * nloc) {
            __builtin_amdgcn_fence(__ATOMIC_RELEASE, "agent");
            asm volatile("s_waitcnt vmcnt(0)" ::: "memory");
            const unsigned og = xb_add(&bar[XB_TOP], 1u);
            const unsigned tg = og / nx;
            if (og + 1u == (tg + 1u) * nx) xb_add(&bar[XB_TOPGEN], 1u);
            else XB_SPIN(xb_ld(&bar[XB_TOPGEN]) == tg, bar);
            __builtin_amdgcn_fence(__ATOMIC_ACQUIRE, "agent");
            xb_add(&bar[XB_XGEN(b.x)], 1u);
            asm volatile("s_waitcnt vmcnt(0)" ::: "memory");
        } else {
            XB_SPIN(xb_ld(&bar[XB_XGEN(b.x)]) == gen, bar);
            __builtin_amdgcn_fence(__ATOMIC_ACQUIRE, "agent");
            asm volatile("s_waitcnt vmcnt(0)" ::: "memory");
        }
    }
    __syncthreads();
}
#ifndef MK_N_LAUNCHES
#define MK_N_LAUNCHES 1
#endif
#ifndef ATTN_IMPL
#define ATTN_IMPL 0
#endif
#ifndef HGRN_IMPL
#define HGRN_IMPL 0
#endif
constexpr int NWAVES = 8;
constexpr int N_PHASES = 12;

constexpr int DM = 1024, SEQ = 8192, NBP = 4, NBS = 32, DSEQ = 64, MP = NBP * SEQ, MS = NBS * DSEQ, M = MP + MS;
constexpr int INW = 6912, DFF = 2816, NMOD = NBP + NBS;
constexpr float LN_EPS = 1e-5f, RMS_EPS = 1e-6f;
constexpr float ALPHA = 1.189207115002721f;
static_assert(M % 256 == 0 && INW % 256 == 0 && (2 * DFF) % 256 == 0, "tile shapes");

constexpr size_t MiB = 1u << 20, HMiB = 1u << 19;
constexpr size_t WS_CTL = 0, WS_MOD = 1 * MiB, CTL_ZERO_BYTES = 2 * MiB;
constexpr size_t WS_WIN = 2 * MiB, WS_WBA = 31 * HMiB, WS_WBH = 33 * HMiB, WS_WOUT = 37 * HMiB, WS_WUP = 41 * HMiB, WS_WDN = 63 * HMiB;
constexpr size_t WS_H = 37 * MiB, WS_QB = 105 * MiB, WS_KB = 139 * MiB, WS_VB = 295 * HMiB, WS_HQ = 156 * MiB, WS_HZ = 224 * MiB, WS_HV = 292 * MiB, WS_HG = 360 * MiB;
constexpr size_t WS_U = 428 * MiB, WS_D = 492 * MiB, WS_END = 985 * HMiB;
constexpr size_t WS_YH = WS_H, WS_T1 = WS_HQ, WS_MERGED = WS_HZ, WS_Z1 = WS_HV, WS_X1 = WS_HQ, WS_ACT = WS_HV;
static_assert(WS_WIN + (size_t)INW * DM * 2 == WS_WBA && WS_WBA + 512 * 1024 * 2 == WS_WBH && WS_WBH + 1024 * 1024 * 2 == WS_WOUT && WS_WOUT + 1024 * 1024 * 2 == WS_WUP &&
              WS_WUP + (size_t)2 * DFF * DM * 2 == WS_WDN && WS_WDN + (size_t)DM * DFF * 2 == WS_H && WS_H + (size_t)M * DM * 2 == WS_QB && WS_QB + (size_t)M * 512 * 2 == WS_KB &&
              WS_KB + (size_t)M * 128 * 2 == WS_VB && WS_VB + (size_t)M * 128 * 2 == WS_HQ && WS_HQ + (size_t)M * DM * 2 == WS_HZ && WS_HG + (size_t)M * DM * 2 == WS_U &&
              WS_ACT + (size_t)M * DFF * 2 <= WS_D && WS_END <= 512 * MiB, "d_ws map");
constexpr int CW_BAR = 4096;

constexpr int RING_BYTES = 131072, LDSCTL_OFF = RING_BYTES, MISC_OFF = LDSCTL_OFF + 320, LDS_BYTES = 147456;

typedef unsigned short bf16_t;
typedef unsigned u32x4 __attribute__((ext_vector_type(4)));
typedef unsigned u32x2 __attribute__((ext_vector_type(2)));
using pg8::bf2f; using pg8::fsigmoid; using pg8::fsilu; using pg8::mod_row;
using pg8::OFF_NKP; using pg8::OFF_NVP; using pg8::OFF_NSP; using pg8::OFF_NKS; using pg8::OFF_NVS; using pg8::OFF_NSS;

struct Frame {
    LAS unsigned char* lds;
    int tid, lane, wave, vcu, G;
    const float* in[22]; float* out; unsigned char* ws;
};
#define IN_XP 0
#define IN_XS 1
#define IN_CK 2
#define IN_CV 3
#define IN_ST 4
#define IN_CP 5
#define IN_CS 6
#define IN_WADA 7
#define IN_BADA 8
#define IN_WIN 9
#define IN_SINK 10
#define IN_LBL 11
#define IN_NORMW 12
#define IN_WBA 13
#define IN_WBH 14
#define IN_WOUT 15
#define IN_LNMG 16
#define IN_LNMB 17
#define IN_WUP 18
#define IN_WDN 19
#define IN_LNFG 20
#define IN_LNFB 21

__device__ __forceinline__ float wave_sum(float v) {
#pragma unroll
    for (int o = 1; o < 64; o <<= 1) v += __shfl_xor(v, o);
    return v;
}
template <class RMap>
__device__ __forceinline__ void transpose_item(const float* W, int K, int N, bf16_t* WT, LAS float* scr, int item, int lane, RMap rmap) {
    const int nblk = N / 32, kb = item / nblk, nb = item % nblk, k0 = 64 * kb, n0 = 32 * nb;
#pragma unroll 8
    for (int i = 0; i < 32; ++i) { const int kk = 2 * i + (lane >> 5); scr[kk * 33 + (lane & 31)] = W[(size_t)(k0 + kk) * N + n0 + (lane & 31)]; }
    LDS_WAIT(); asm volatile("" ::: "memory");
    const int c = lane & 7; const int nd0 = rmap(n0);
#pragma unroll
    for (int j = 0; j < 4; ++j) { const int n = (lane >> 3) + 8 * j; const LAS float* s = scr + (8 * c) * 33 + n;
        v4u o; o.x = pk2(s[0 * 33], s[1 * 33]); o.y = pk2(s[2 * 33], s[3 * 33]); o.z = pk2(s[4 * 33], s[5 * 33]); o.w = pk2(s[6 * 33], s[7 * 33]);
        *(GAS v4u*)(WT + (size_t)(nd0 + n) * K + k0 + 8 * c) = o; }
    LDS_WAIT(); asm volatile("" ::: "memory");
}
struct RMapId { __device__ __forceinline__ int operator()(int n0) const { return n0; } };
struct RMapUp { __device__ __forceinline__ int operator()(int n0) const { return n0 < DFF ? 256 * (n0 >> 7) + (n0 & 127) : 256 * ((n0 - DFF) >> 7) + 128 + ((n0 - DFF) & 127); } };

__device__ __forceinline__ void p0_prologue(Frame& F) {
    if (F.vcu < 192) {
        const int kc = F.vcu / 12, ec = F.vcu % 12, k0 = kc * 64, col = ec * 512 + F.tid;
        LAS float* sc = (LAS float*)F.lds;
        for (int i = F.tid; i < 64 * NMOD; i += 512) { const int kk = i / NMOD, mb = i % NMOD;
            const float cv = mb < NBP ? F.in[IN_CP][mb * DM + k0 + kk] : F.in[IN_CS][(mb - NBP) * DM + k0 + kk]; sc[kk * NMOD + mb] = fsilu(cv); }
        __syncthreads();
        float acc[NMOD];
#pragma unroll
        for (int i = 0; i < NMOD; ++i) acc[i] = 0.f;
        const float* wp = F.in[IN_WADA] + (size_t)k0 * 6144 + col;
#pragma unroll 4
        for (int kk = 0; kk < 64; ++kk) { const float w = wp[(size_t)kk * 6144];
#pragma unroll
            for (int i = 0; i < NMOD; ++i) acc[i] += sc[kk * NMOD + i] * w; }
        const float bias = kc == 0 ? F.in[IN_BADA][col] : 0.f;
        float* mod = (float*)(F.ws + WS_MOD);
#pragma unroll
        for (int i = 0; i < NMOD; ++i) atomicAdd(mod + i * 6144 + col, acc[i] + bias);
        __syncthreads();
    }
    LAS float* scr = (LAS float*)(F.lds + F.wave * 16384);
    const int gw = F.vcu * NWAVES + F.wave, NGW = F.G * NWAVES;
    constexpr int I_IN = (DM / 64) * (INW / 32), I_BA = (512 / 64) * (DM / 32), I_BH = (DM / 64) * (DM / 32), I_OUT = I_BH, I_UP = (DM / 64) * (2 * DFF / 32), I_DN = (DFF / 64) * (DM / 32);
    constexpr int NITEMS = I_IN + I_BA + I_BH + I_OUT + I_UP + I_DN;
    for (int it = gw; it < NITEMS; it += NGW) {
        int r = it;
        if (r < I_IN) { transpose_item(F.in[IN_WIN], DM, INW, (bf16_t*)(F.ws + WS_WIN), scr, r, F.lane, RMapId()); continue; } r -= I_IN;
        if (r < I_BA) { transpose_item(F.in[IN_WBA], 512, DM, (bf16_t*)(F.ws + WS_WBA), scr, r, F.lane, RMapId()); continue; } r -= I_BA;
        if (r < I_BH) { transpose_item(F.in[IN_WBH], DM, DM, (bf16_t*)(F.ws + WS_WBH), scr, r, F.lane, RMapId()); continue; } r -= I_BH;
        if (r < I_OUT) { transpose_item(F.in[IN_WOUT], DM, DM, (bf16_t*)(F.ws + WS_WOUT), scr, r, F.lane, RMapId()); continue; } r -= I_OUT;
        if (r < I_UP) { transpose_item(F.in[IN_WUP], DM, 2 * DFF, (bf16_t*)(F.ws + WS_WUP), scr, r, F.lane, RMapUp()); continue; } r -= I_UP;
        transpose_item(F.in[IN_WDN], DFF, DM, (bf16_t*)(F.ws + WS_WDN), scr, r, F.lane, RMapId());
    }
    const int gt = F.vcu * 512 + F.tid, NGT = F.G * 512;
    for (int i = gt; i < 2 * NBS * 64 * 32; i += NGT) {
        const int kv = i / (NBS * 64 * 32), r = i % (NBS * 64 * 32), b = r / (64 * 32), q = r % (64 * 32);
        const f32x4 v = *(const f32x4*)(F.in[kv ? IN_CV : IN_CK] + (size_t)b * 128 * 128 + 64 * 128 + q * 4);
        *(f32x4*)(F.out + (kv ? OFF_NVS : OFF_NKS) + (size_t)b * 128 * 128 + q * 4) = v;
    }
}

__device__ __forceinline__ void ln_norm(f32x4 (&v)[4]) {
    float s = 0.f;
#pragma unroll
    for (int j = 0; j < 4; ++j) s += (v[j][0] + v[j][1]) + (v[j][2] + v[j][3]);
    const float mean = wave_sum(s) * (1.f / DM); float s2 = 0.f;
#pragma unroll
    for (int j = 0; j < 4; ++j) { v[j] = v[j] - mean; s2 += (v[j][0] * v[j][0] + v[j][1] * v[j][1]) + (v[j][2] * v[j][2] + v[j][3] * v[j][3]); }
    const float rstd = 1.f / sqrtf(wave_sum(s2) * (1.f / DM) + LN_EPS);
#pragma unroll
    for (int j = 0; j < 4; ++j) v[j] = v[j] * rstd;
}
__device__ __forceinline__ void store_row_bf16(bf16_t* orow, int lane, const f32x4 (&v)[4]) {
#pragma unroll
    for (int j = 0; j < 4; ++j) { u32x2 w; w.x = pk2(v[j][0], v[j][1]); w.y = pk2(v[j][2], v[j][3]); *(u32x2*)(orow + 4 * lane + 256 * j) = w; }
}
__device__ __forceinline__ void p1_ln_mod(Frame& F) {
    const int gw = F.vcu * NWAVES + F.wave, NGW = F.G * NWAVES; const float* mod = (const float*)(F.ws + WS_MOD); bf16_t* H = (bf16_t*)(F.ws + WS_H);
    for (int row = gw; row < M; row += NGW) {
        const float* xr = row < MP ? F.in[IN_XP] + (size_t)row * DM : F.in[IN_XS] + (size_t)(row - MP) * DM; const float* mr = mod + (size_t)mod_row(row) * 6144;
        f32x4 v[4];
#pragma unroll
        for (int j = 0; j < 4; ++j) v[j] = *(const f32x4*)(xr + 4 * F.lane + 256 * j);
        ln_norm(v);
#pragma unroll
        for (int j = 0; j < 4; ++j) { const f32x4 sh = *(const f32x4*)(mr + 4 * F.lane + 256 * j), sc = *(const f32x4*)(mr + 1024 + 4 * F.lane + 256 * j); v[j] = v[j] * (sc + 1.0f) + sh; }
        store_row_bf16(H + (size_t)row * DM, F.lane, v);
    }
}
__device__ __forceinline__ void p8_ln_mix(Frame& F) {
    const int gw = F.vcu * NWAVES + F.wave, NGW = F.G * NWAVES; const float* mod = (const float*)(F.ws + WS_MOD); bf16_t* H = (bf16_t*)(F.ws + WS_H);
    const float* Z1 = (const float*)(F.ws + WS_Z1); float* X1 = (float*)(F.ws + WS_X1);
    f32x4 gg[4], bb[4];
#pragma unroll
    for (int j = 0; j < 4; ++j) { gg[j] = *(const f32x4*)(F.in[IN_LNMG] + 4 * F.lane + 256 * j); bb[j] = *(const f32x4*)(F.in[IN_LNMB] + 4 * F.lane + 256 * j); }
    for (int row = gw; row < M; row += NGW) {
        const float* mr = mod + (size_t)mod_row(row) * 6144;
        f32x4 v[4];
#pragma unroll
        for (int j = 0; j < 4; ++j) v[j] = *(const f32x4*)(Z1 + (size_t)row * DM + 4 * F.lane + 256 * j);
        ln_norm(v);
#pragma unroll
        for (int j = 0; j < 4; ++j) { v[j] = v[j] * gg[j] + bb[j]; *(f32x4*)(X1 + (size_t)row * DM + 4 * F.lane + 256 * j) = v[j]; }
        ln_norm(v);
#pragma unroll
        for (int j = 0; j < 4; ++j) { const f32x4 sh = *(const f32x4*)(mr + 3072 + 4 * F.lane + 256 * j), sc = *(const f32x4*)(mr + 4096 + 4 * F.lane + 256 * j); v[j] = v[j] * (sc + 1.0f) + sh; }
        store_row_bf16(H + (size_t)row * DM, F.lane, v);
    }
}
__device__ __forceinline__ void p11_ln_out(Frame& F) {
    const int gw = F.vcu * NWAVES + F.wave, NGW = F.G * NWAVES;
    f32x4 gg[4], bb[4];
#pragma unroll
    for (int j = 0; j < 4; ++j) { gg[j] = *(const f32x4*)(F.in[IN_LNFG] + 4 * F.lane + 256 * j); bb[j] = *(const f32x4*)(F.in[IN_LNFB] + 4 * F.lane + 256 * j); }
    for (int row = gw; row < M; row += NGW) {
        float* zr = F.out + (size_t)row * DM;
        f32x4 v[4];
#pragma unroll
        for (int j = 0; j < 4; ++j) v[j] = *(const f32x4*)(zr + 4 * F.lane + 256 * j);
        ln_norm(v);
#pragma unroll
        for (int j = 0; j < 4; ++j) *(f32x4*)(zr + 4 * F.lane + 256 * j) = v[j] * gg[j] + bb[j];
    }
}

__device__ __forceinline__ void attn_simple(Frame& F) {
    bf16_t* QB = (bf16_t*)(F.ws + WS_QB); const bf16_t* KB = (const bf16_t*)(F.ws + WS_KB); const bf16_t* VB = (const bf16_t*)(F.ws + WS_VB);
    LAS bf16_t* Ks = (LAS bf16_t*)F.lds; LAS bf16_t* Vs = (LAS bf16_t*)(F.lds + 192 * 64 * 2);
    for (int unit = F.vcu; unit < 544 * 2; unit += F.G) {
        const int ci = unit >> 1, j = unit & 1; const bool samp = ci >= 512;
        const int row0 = samp ? MP + (ci - 512) * DSEQ : (ci >> 7) * SEQ + (ci & 127) * 64; const int c = ci & 127;
        for (int idx = F.tid; idx < 192 * 8 * 2; idx += 512) { const int kv = idx / (192 * 8), r = idx % (192 * 8), i = r >> 3, ch = r & 7;
            u32x4 w = (u32x4){0u, 0u, 0u, 0u};
            if (samp && i < 128) { const float* src = F.in[kv ? IN_CV : IN_CK] + ((size_t)((ci - 512) * 128 + i) * 2 + j) * 64 + ch * 8;
                const f32x4 a = *(const f32x4*)src, b = *(const f32x4*)(src + 4); w.x = pk2(a[0], a[1]); w.y = pk2(a[2], a[3]); w.z = pk2(b[0], b[1]); w.w = pk2(b[2], b[3]); }
            else if (samp || c * 64 - 128 + i >= 0) { const size_t krow = (size_t)(row0 - 128 + i); w = *(const u32x4*)((kv ? VB : KB) + krow * 128 + j * 64 + ch * 8); }
            *(LAS u32x4*)((kv ? Vs : Ks) + i * 64 + ch * 8) = w; }
        __syncthreads();
        if (F.tid < 256) {
            const int g = F.tid >> 6, t = F.tid & 63, hq = 4 * j + g; bf16_t* qp = QB + (size_t)(row0 + t) * 512 + hq * 64;
            float q[64], o[64];
#pragma unroll
            for (int ch = 0; ch < 8; ++ch) { const u32x4 w = *(const u32x4*)(qp + ch * 8);
                q[ch * 8 + 0] = __uint_as_float(w.x << 16); q[ch * 8 + 1] = __uint_as_float(w.x & 0xffff0000u); q[ch * 8 + 2] = __uint_as_float(w.y << 16); q[ch * 8 + 3] = __uint_as_float(w.y & 0xffff0000u);
                q[ch * 8 + 4] = __uint_as_float(w.z << 16); q[ch * 8 + 5] = __uint_as_float(w.z & 0xffff0000u); q[ch * 8 + 6] = __uint_as_float(w.w << 16); q[ch * 8 + 7] = __uint_as_float(w.w & 0xffff0000u); }
#pragma unroll
            for (int d = 0; d < 64; ++d) o[d] = 0.f;
            const float slope = exp2f(-(float)(hq + 1)); float mx = F.in[IN_SINK][hq], l = 1.f;
            const int i0 = samp ? 0 : (128 - c * 64 > 0 ? 128 - c * 64 : 0);
            for (int i = i0; i < 192; ++i) {
                float s = 0.f;
#pragma unroll
                for (int d2 = 0; d2 < 32; ++d2) { const unsigned kw = *(LAS unsigned*)(Ks + i * 64 + 2 * d2); s += q[2 * d2] * __uint_as_float(kw << 16) + q[2 * d2 + 1] * __uint_as_float(kw & 0xffff0000u); }
                s -= slope * fabsf((float)(128 + t - i));
                const float mn = fmaxf(mx, s), sc = __expf(mx - mn), p = __expf(s - mn); l = l * sc + p; mx = mn;
#pragma unroll
                for (int d2 = 0; d2 < 32; ++d2) { const unsigned vw = *(LAS unsigned*)(Vs + i * 64 + 2 * d2);
                    o[2 * d2] = o[2 * d2] * sc + p * __uint_as_float(vw << 16); o[2 * d2 + 1] = o[2 * d2 + 1] * sc + p * __uint_as_float(vw & 0xffff0000u); }
            }
            const float rl = 1.f / l;
#pragma unroll
            for (int ch = 0; ch < 8; ++ch) { u32x4 w; w.x = pk2(o[ch * 8] * rl, o[ch * 8 + 1] * rl); w.y = pk2(o[ch * 8 + 2] * rl, o[ch * 8 + 3] * rl); w.z = pk2(o[ch * 8 + 4] * rl, o[ch * 8 + 5] * rl); w.w = pk2(o[ch * 8 + 6] * rl, o[ch * 8 + 7] * rl);
                *(u32x4*)(qp + ch * 8) = w; }
        }
        __syncthreads();
    }
}

__device__ __forceinline__ void hgrn_simple(Frame& F) {
    const bf16_t* HQ = (const bf16_t*)(F.ws + WS_HQ); const bf16_t* HZ = (const bf16_t*)(F.ws + WS_HZ); const bf16_t* HV = (const bf16_t*)(F.ws + WS_HV); const bf16_t* HG = (const bf16_t*)(F.ws + WS_HG);
    bf16_t* YH = (bf16_t*)(F.ws + WS_YH);
    LAS float* fs = (LAS float*)F.lds; LAS float* ks = fs + 128; LAS float* qs = fs + 256; LAS float* vs = fs + 384; LAS float* op = fs + 512; LAS float* red = fs + 1024;
    const int e = F.tid & 127, dq = F.tid >> 7;
    for (int unit = F.vcu; unit < NMOD * 8; unit += F.G) {
        const int sidx = unit < 32 ? unit >> 3 : 4 + ((unit - 32) >> 3), h = unit & 7;
        const int T = sidx < NBP ? SEQ : DSEQ, rbase = sidx < NBP ? sidx * SEQ : MP + (sidx - NBP) * DSEQ, col = h * 128;
        float S[32];
#pragma unroll
        for (int i = 0; i < 32; ++i) S[i] = sidx < NBP ? 0.f : F.in[IN_ST][((size_t)((sidx - NBP) * 8 + h) * 128 + 32 * dq + i) * 128 + e];
        float lb = 0.f, nw = 0.f;
        if (F.tid < 128) { const float l0 = F.in[IN_LBL][col + F.tid], l1 = F.in[IN_LBL][1024 + col + F.tid]; lb = 1.f / (1.f + __expf(l1 - l0)); nw = F.in[IN_NORMW][col + F.tid]; }
        for (int t = 0; t < T; ++t) {
            const size_t ro = (size_t)(rbase + t) * DM + col;
            if (F.tid < 128) { const float z = bf2f(HZ[ro + F.tid]), sg = 1.f / (1.f + __expf(-z)); fs[F.tid] = lb + (1.f - lb) * sg; ks[F.tid] = (1.f - lb) * (1.f - sg); qs[F.tid] = bf2f(HQ[ro + F.tid]); }
            else if (F.tid < 256) vs[F.tid - 128] = bf2f(HV[ro + F.tid - 128]);
            __syncthreads();
            const float v = vs[e]; float part = 0.f;
#pragma unroll
            for (int i = 0; i < 32; ++i) { const int d = 32 * dq + i; S[i] = fs[d] * S[i] + ks[d] * v; part += S[i] * qs[d]; }
            op[dq * 128 + e] = part;
            __syncthreads();
            float o = 0.f;
            if (F.tid < 128) { o = (op[e] + op[128 + e]) + (op[256 + e] + op[384 + e]); const float ss = wave_sum(o * o); if (F.lane == 0) red[F.wave] = ss; }
            __syncthreads();
            if (F.tid < 128) { const float r = 1.f / sqrtf((red[0] + red[1]) * (1.f / 128.f) + RMS_EPS); YH[ro + e] = (bf16_t)f2bf(o * r * nw * bf2f(HG[ro + e])); }
        }
        float* so = F.out + (sidx < NBP ? OFF_NSP + (size_t)(sidx * 8 + h) * 16384 : OFF_NSS + (size_t)((sidx - NBP) * 8 + h) * 16384);
#pragma unroll
        for (int i = 0; i < 32; ++i) so[(size_t)(32 * dq + i) * 128 + e] = S[i];
        __syncthreads();
    }
}
typedef float f32x16 __attribute__((ext_vector_type(16)));
typedef short s16x4 __attribute__((ext_vector_type(4)));
__device__ __forceinline__ bf16x8 cat8(u32x2 lo, u32x2 hi) { u32x4 w; w.x = lo.x; w.y = lo.y; w.z = hi.x; w.w = hi.y; return __builtin_bit_cast(bf16x8, w); }
__device__ __forceinline__ unsigned cvtpk(float lo, float hi) { return pg8::cvt_pk_bf16(lo, hi); }

constexpr int AL_K = 0, AL_KROW = 144, AL_VT = 192 * 144, AL_VROW = 392, AL_LINV = AL_VT + 64 * AL_VROW, AL_END = AL_LINV + 8 * 32 * 4;
__device__ __forceinline__ void attn_fast(Frame& F) {
    bf16_t* QB = (bf16_t*)(F.ws + WS_QB); const bf16_t* KB = (const bf16_t*)(F.ws + WS_KB); const bf16_t* VB = (const bf16_t*)(F.ws + WS_VB);
    const int lane = F.lane, w = F.wave, r31 = lane & 31, hi = lane >> 5;
    constexpr float LOG2E = 1.4426950408889634f;
    for (int unit = F.vcu; unit < 544 * 2; unit += F.G) {
        const int ci = unit >> 1, j = unit & 1; const bool samp = ci >= 512;
        const int row0 = samp ? MP + (ci - 512) * DSEQ : (ci >> 7) * SEQ + (ci & 127) * 64; const int c = ci & 127;
        const int i0 = samp ? 0 : (128 - c * 64 > 0 ? 128 - c * 64 : 0);
        for (int idx = F.tid; idx < 192 * 8 * 2; idx += 512) { const int kv = idx / (192 * 8), r = idx % (192 * 8), i = r >> 3, ch = r & 7;
            u32x4 wv = (u32x4){0u, 0u, 0u, 0u};
            if (samp && i < 128) { const float* src = F.in[kv ? IN_CV : IN_CK] + ((size_t)((ci - 512) * 128 + i) * 2 + j) * 64 + ch * 8;
                const f32x4 a = *(const f32x4*)src, b = *(const f32x4*)(src + 4); wv.x = pk2(a[0], a[1]); wv.y = pk2(a[2], a[3]); wv.z = pk2(b[0], b[1]); wv.w = pk2(b[2], b[3]); }
            else if (i >= i0) { const size_t krow = (size_t)(row0 - 128 + i); wv = *(const u32x4*)((kv ? VB : KB) + krow * 128 + j * 64 + ch * 8); }
            if (kv == 0) *(LAS u32x4*)(F.lds + AL_K + i * AL_KROW + ch * 16) = wv;
            else { LAS bf16_t* vt = (LAS bf16_t*)(F.lds + AL_VT + (8 * ch) * AL_VROW + i * 2);
                vt[0] = (bf16_t)(wv.x & 0xffffu); vt[AL_VROW / 2] = (bf16_t)(wv.x >> 16); vt[2 * (AL_VROW / 2)] = (bf16_t)(wv.y & 0xffffu); vt[3 * (AL_VROW / 2)] = (bf16_t)(wv.y >> 16);
                vt[4 * (AL_VROW / 2)] = (bf16_t)(wv.z & 0xffffu); vt[5 * (AL_VROW / 2)] = (bf16_t)(wv.z >> 16); vt[6 * (AL_VROW / 2)] = (bf16_t)(wv.w & 0xffffu); vt[7 * (AL_VROW / 2)] = (bf16_t)(wv.w >> 16); } }
        const int g = w >> 1, th = w & 1, hq = 4 * j + g, t = 32 * th + r31;
        bf16_t* qp = QB + (size_t)(row0 + t) * 512 + hq * 64;
        bf16x8 qf[4];
#pragma unroll
        for (int kap = 0; kap < 4; ++kap) qf[kap] = *(const bf16x8*)(qp + 16 * kap + 8 * hi);
        __syncthreads();
        f32x16 st[6];
#pragma unroll
        for (int kt = 0; kt < 6; ++kt) { st[kt] = (f32x16){0.f, 0.f, 0.f, 0.f, 0.f, 0.f, 0.f, 0.f, 0.f, 0.f, 0.f, 0.f, 0.f, 0.f, 0.f, 0.f};
#pragma unroll
            for (int kap = 0; kap < 4; ++kap) { const bf16x8 a = *(const LAS bf16x8*)(F.lds + AL_K + (32 * kt + r31) * AL_KROW + (16 * kap + 8 * hi) * 2);
                st[kt] = __builtin_amdgcn_mfma_f32_32x32x16_bf16(a, qf[kap], st[kt], 0, 0, 0); }
            __builtin_amdgcn_sched_barrier(0); }
        const float slope2 = exp2f(-(float)(hq + 1)) * LOG2E, sink2 = F.in[IN_SINK][hq] * LOG2E;
        float mx = sink2;
        int dbase = 128 + t - 4 * hi, kbase = i0 - 4 * hi; asm volatile("" : "+v"(dbase), "+v"(kbase));
#pragma unroll
        for (int kt = 0; kt < 6; ++kt)
#pragma unroll
            for (int r = 0; r < 16; ++r) { const int kc = 32 * kt + (r & 3) + 8 * (r >> 2);
                float v = st[kt][r] * LOG2E - slope2 * fabsf((float)(dbase - kc)); v = kc < kbase ? -1e30f : v; st[kt][r] = v; mx = fmaxf(mx, v); }
        mx = fmaxf(mx, __shfl_xor(mx, 32));
        __builtin_amdgcn_sched_barrier(0);
        float l = 0.f;
        u32x4 pw[12];
#pragma unroll
        for (int kt = 0; kt < 6; ++kt) {
#pragma unroll
            for (int r = 0; r < 16; ++r) { const float p = __builtin_amdgcn_exp2f(st[kt][r] - mx); st[kt][r] = p; l += p; }
#pragma unroll
            for (int hs = 0; hs < 2; ++hs) { pw[2 * kt + hs].x = cvtpk(st[kt][8 * hs + 0], st[kt][8 * hs + 1]); pw[2 * kt + hs].y = cvtpk(st[kt][8 * hs + 2], st[kt][8 * hs + 3]);
                pw[2 * kt + hs].z = cvtpk(st[kt][8 * hs + 4], st[kt][8 * hs + 5]); pw[2 * kt + hs].w = cvtpk(st[kt][8 * hs + 6], st[kt][8 * hs + 7]); }
            __builtin_amdgcn_sched_barrier(0);
        }
        l += __shfl_xor(l, 32); l += __builtin_amdgcn_exp2f(sink2 - mx);
        LAS float* linv = (LAS float*)(F.lds + AL_LINV) + w * 32;
        if (hi == 0) linv[r31] = 1.0f / l;
        f32x16 o[2];
        o[0] = (f32x16){0.f, 0.f, 0.f, 0.f, 0.f, 0.f, 0.f, 0.f, 0.f, 0.f, 0.f, 0.f, 0.f, 0.f, 0.f, 0.f}; o[1] = o[0];
        __builtin_amdgcn_sched_barrier(0);
#pragma unroll
        for (int s16 = 0; s16 < 12; ++s16) {
            const bf16x8 pa = __builtin_bit_cast(bf16x8, pw[s16]);
#pragma unroll
            for (int dt = 0; dt < 2; ++dt) { const LAS unsigned char* vp = F.lds + AL_VT + (32 * dt + r31) * AL_VROW + (16 * s16 + 4 * hi) * 2;
                const bf16x8 b = cat8(*(const LAS u32x2*)vp, *(const LAS u32x2*)(vp + 16));
                o[dt] = __builtin_amdgcn_mfma_f32_32x32x16_bf16(pa, b, o[dt], 0, 0, 0); }
            if (s16 & 1) __builtin_amdgcn_sched_barrier(0);
        }
        asm volatile("s_waitcnt lgkmcnt(0)" ::: "memory");
        int hio = 4 * hi; asm volatile("" : "+v"(hio));
        bf16_t* op = QB + (size_t)(row0 + 32 * th + hio) * 512 + hq * 64 + r31; const LAS float* lq = linv + hio;
#pragma unroll
        for (int r = 0; r < 16; ++r) { const int qq = (r & 3) + 8 * (r >> 2); const float li = lq[qq];
            op[(size_t)qq * 512] = (bf16_t)f2bf(o[0][r] * li); op[(size_t)qq * 512 + 32] = (bf16_t)f2bf(o[1][r] * li); }
        __syncthreads();
    }
}

constexpr int HL_QE = 0, HL_QROW = 272, HL_KE = 32 * 272, HL_KDT = 2 * 32 * 272, HL_TROW = 80, HL_VT = HL_KDT + 128 * 80, HL_EM = HL_VT + 128 * 80, HL_DEC = HL_EM + 512, HL_PART = HL_DEC + 512,
              HL_O = HL_PART + 2048, HL_OROW = 528, HL_END = HL_O + 32 * 528;
static_assert(HL_END <= RING_BYTES && AL_END <= RING_BYTES, "phase scratch inside the ring region");

template <bool FULL>
__device__ __forceinline__ void hgrn_prep(Frame& F, size_t rowoff  , float lb, float& btot) {
    const bf16_t* HQ = (const bf16_t*)(F.ws + WS_HQ); const bf16_t* HZ = (const bf16_t*)(F.ws + WS_HZ); const bf16_t* HV = (const bf16_t*)(F.ws + WS_HV);
    const int d = F.tid & 127, p = F.tid >> 7;
    float z[8], qv[8]; unsigned short vr[8];
#pragma unroll
    for (int i = 0; i < 8; ++i) { const size_t o = rowoff + (size_t)(8 * p + i) * DM + d; z[i] = bf2f(HZ[o]); vr[i] = HV[o]; qv[i] = FULL ? bf2f(HQ[o]) : 0.f; }
    { u32x4 wv; wv.x = vr[0] | ((unsigned)vr[1] << 16); wv.y = vr[2] | ((unsigned)vr[3] << 16); wv.z = vr[4] | ((unsigned)vr[5] << 16); wv.w = vr[6] | ((unsigned)vr[7] << 16);
      *(LAS u32x4*)(F.lds + HL_VT + d * HL_TROW + p * 16) = wv; }
    float kk[8], cs[8]; float run = 0.f;
#pragma unroll
    for (int i = 0; i < 8; ++i) { const float ez = __expf(-fmaxf(z[i], -60.f)), sg = __builtin_amdgcn_rcpf(1.f + ez); const float f = lb + (1.f - lb) * sg; kk[i] = (1.f - lb) * (ez * sg); run += __logf(f); cs[i] = run; }
    LAS float* part = (LAS float*)(F.lds + HL_PART);
    part[p * 128 + d] = run;
    __syncthreads();
    const float p0 = part[d], p1 = part[128 + d], p2 = part[256 + d], p3 = part[384 + d];
    const float m = p0 + p1, bl = (p0 + p1) + (p2 + p3), pre = (p >= 1 ? p0 : 0.f) + (p >= 2 ? p1 : 0.f) + (p >= 3 ? p2 : 0.f);
    float kd[8];
#pragma unroll
    for (int i = 0; i < 8; ++i) { const float b = pre + cs[i];
        if (FULL) { const float up = __expf(b - m), dn = __expf(m - b);
            *(LAS bf16_t*)(F.lds + HL_QE + (8 * p + i) * HL_QROW + d * 2) = (bf16_t)f2bf(qv[i] * up); *(LAS bf16_t*)(F.lds + HL_KE + (8 * p + i) * HL_QROW + d * 2) = (bf16_t)f2bf(kk[i] * dn); }
        kd[i] = kk[i] * __expf(bl - b); }
    { u32x4 wv; wv.x = pk2(kd[0], kd[1]); wv.y = pk2(kd[2], kd[3]); wv.z = pk2(kd[4], kd[5]); wv.w = pk2(kd[6], kd[7]); *(LAS u32x4*)(F.lds + HL_KDT + d * HL_TROW + p * 16) = wv; }
    if (p == 0) { if (FULL) ((LAS float*)(F.lds + HL_EM))[d] = __expf(m); ((LAS float*)(F.lds + HL_DEC))[d] = __expf(bl); btot += bl; }
    __syncthreads();
}
template <bool FULL>
__device__ __forceinline__ void hgrn_mma(Frame& F, f32x4 (&S)[8]) {
    const int lane = F.lane, w = F.wave, r15 = lane & 15, g = lane >> 4;
    const LAS unsigned char* L = F.lds;
    const LAS unsigned char* vrow = L + HL_VT + (16 * w + r15) * HL_TROW;
    const bf16x8 vn = *(const LAS bf16x8*)(vrow + 16 * g);
    if (FULL) {
        bf16x8 qe[2][4], ke[2][4];
#pragma unroll
        for (int tau = 0; tau < 2; ++tau)
#pragma unroll
            for (int kap = 0; kap < 4; ++kap) { const int off = (16 * tau + r15) * HL_QROW + (32 * kap + 4 * g) * 2;
                qe[tau][kap] = cat8(*(const LAS u32x2*)(L + HL_QE + off), *(const LAS u32x2*)(L + HL_QE + off + 32));
                ke[tau][kap] = cat8(*(const LAS u32x2*)(L + HL_KE + off), *(const LAS u32x2*)(L + HL_KE + off + 32)); }
        f32x4 at00 = (f32x4){0.f, 0.f, 0.f, 0.f}, at01 = at00, at11 = at00;
#pragma unroll
        for (int kap = 0; kap < 4; ++kap) { at00 = __builtin_amdgcn_mfma_f32_16x16x32_bf16(ke[0][kap], qe[0][kap], at00, 0, 0, 0);
            at01 = __builtin_amdgcn_mfma_f32_16x16x32_bf16(ke[0][kap], qe[1][kap], at01, 0, 0, 0); at11 = __builtin_amdgcn_mfma_f32_16x16x32_bf16(ke[1][kap], qe[1][kap], at11, 0, 0, 0); }
#pragma unroll
        for (int r = 0; r < 4; ++r) { const bool dead = (4 * g + r) > r15; at00[r] = dead ? 0.f : at00[r]; at11[r] = dead ? 0.f : at11[r]; }
        u32x4 a0, a1; a0.x = cvtpk(at00[0], at00[1]); a0.y = cvtpk(at00[2], at00[3]); a0.z = 0u; a0.w = 0u;
        a1.x = cvtpk(at01[0], at01[1]); a1.y = cvtpk(at01[2], at01[3]); a1.z = cvtpk(at11[0], at11[1]); a1.w = cvtpk(at11[2], at11[3]);
        const bf16x8 vp = cat8(*(const LAS u32x2*)(vrow + 8 * g), *(const LAS u32x2*)(vrow + 32 + 8 * g));
        f32x4 o0 = __builtin_amdgcn_mfma_f32_16x16x32_bf16(__builtin_bit_cast(bf16x8, a0), vp, (f32x4){0.f, 0.f, 0.f, 0.f}, 0, 0, 0);
        f32x4 o1 = __builtin_amdgcn_mfma_f32_16x16x32_bf16(__builtin_bit_cast(bf16x8, a1), vp, (f32x4){0.f, 0.f, 0.f, 0.f}, 0, 0, 0);
#pragma unroll
        for (int kap = 0; kap < 4; ++kap) { const f32x4 e0 = *(const LAS f32x4*)(L + HL_EM + (32 * kap + 4 * g) * 4), e1 = *(const LAS f32x4*)(L + HL_EM + (32 * kap + 16 + 4 * g) * 4);
            const f32x4 s0 = S[2 * kap] * e0, s1 = S[2 * kap + 1] * e1;
            u32x4 sw; sw.x = cvtpk(s0[0], s0[1]); sw.y = cvtpk(s0[2], s0[3]); sw.z = cvtpk(s1[0], s1[1]); sw.w = cvtpk(s1[2], s1[3]); const bf16x8 sp = __builtin_bit_cast(bf16x8, sw);
            o0 = __builtin_amdgcn_mfma_f32_16x16x32_bf16(qe[0][kap], sp, o0, 0, 0, 0); o1 = __builtin_amdgcn_mfma_f32_16x16x32_bf16(qe[1][kap], sp, o1, 0, 0, 0); }
        LAS float* ot = (LAS float*)(F.lds + HL_O) + 16 * w + r15;
#pragma unroll
        for (int r = 0; r < 4; ++r) { ot[(4 * g + r) * (HL_OROW / 4)] = o0[r]; ot[(16 + 4 * g + r) * (HL_OROW / 4)] = o1[r]; }
    }
#pragma unroll
    for (int dl = 0; dl < 8; ++dl) { const f32x4 dc = *(const LAS f32x4*)(L + HL_DEC + (16 * dl + 4 * g) * 4);
        const bf16x8 a = *(const LAS bf16x8*)(L + HL_KDT + (16 * dl + r15) * HL_TROW + 16 * g);
        S[dl] = __builtin_amdgcn_mfma_f32_16x16x32_bf16(a, vn, S[dl] * dc, 0, 0, 0); }
}
__device__ __forceinline__ void hgrn_norm(Frame& F, size_t rowoff) {
    const bf16_t* HG = (const bf16_t*)(F.ws + WS_HG); bf16_t* YH = (bf16_t*)(F.ws + WS_YH);
    const int t = F.tid >> 4, sub = F.tid & 15;
    const LAS float* op = (const LAS float*)(F.lds + HL_O + t * HL_OROW) + 8 * sub;
    const f32x4 a = *(const LAS f32x4*)op, b = *(const LAS f32x4*)(op + 4);
    float ss = (a[0] * a[0] + a[1] * a[1]) + (a[2] * a[2] + a[3] * a[3]) + (b[0] * b[0] + b[1] * b[1]) + (b[2] * b[2] + b[3] * b[3]);
    ss += __shfl_xor(ss, 1); ss += __shfl_xor(ss, 2); ss += __shfl_xor(ss, 4); ss += __shfl_xor(ss, 8);
    const float r = 1.f / sqrtf(ss * (1.f / 128.f) + RMS_EPS);
    const size_t o = rowoff + (size_t)t * DM + 8 * sub; const int hc = (int)(rowoff & 1023) + 8 * sub;
    const u32x4 gq = *(const u32x4*)(HG + o); const f32x4 n0 = *(const f32x4*)(F.in[IN_NORMW] + hc), n1 = *(const f32x4*)(F.in[IN_NORMW] + hc + 4);
    u32x4 wv;
    wv.x = pk2(a[0] * r * n0[0] * __uint_as_float(gq.x << 16), a[1] * r * n0[1] * __uint_as_float(gq.x & 0xffff0000u));
    wv.y = pk2(a[2] * r * n0[2] * __uint_as_float(gq.y << 16), a[3] * r * n0[3] * __uint_as_float(gq.y & 0xffff0000u));
    wv.z = pk2(b[0] * r * n1[0] * __uint_as_float(gq.z << 16), b[1] * r * n1[1] * __uint_as_float(gq.z & 0xffff0000u));
    wv.w = pk2(b[2] * r * n1[2] * __uint_as_float(gq.w << 16), b[3] * r * n1[3] * __uint_as_float(gq.w & 0xffff0000u));
    *(u32x4*)(YH + o) = wv;
}
__device__ __forceinline__ float hgrn_lb(Frame& F, int h) { const int c = h * 128 + (F.tid & 127); const float l0 = F.in[IN_LBL][c], l1 = F.in[IN_LBL][1024 + c]; return 1.f / (1.f + __expf(l1 - l0)); }
__device__ __forceinline__ void hgrn_state_load(Frame& F, const float* base, f32x4 (&S)[8]) {
    const int r15 = F.lane & 15, g = F.lane >> 4; const float* p = base + (size_t)(4 * g) * 128 + 16 * F.wave + r15;
#pragma unroll
    for (int dl = 0; dl < 8; ++dl)
#pragma unroll
        for (int r = 0; r < 4; ++r) S[dl][r] = p[(size_t)(16 * dl + r) * 128];
}
__device__ __forceinline__ void hgrn_state_store(Frame& F, float* base, const f32x4 (&S)[8]) {
    const int r15 = F.lane & 15, g = F.lane >> 4; float* p = base + (size_t)(4 * g) * 128 + 16 * F.wave + r15;
#pragma unroll
    for (int dl = 0; dl < 8; ++dl)
#pragma unroll
        for (int r = 0; r < 4; ++r) p[(size_t)(16 * dl + r) * 128] = S[dl][r];
}
__device__ __forceinline__ void hgrn_pass_a(Frame& F) {
    float* U = (float*)(F.ws + WS_U); float* D = (float*)(F.ws + WS_D);
    for (int unit = F.vcu; unit < 128 * 8; unit += F.G) {
        const int n = unit >> 3, h = unit & 7; const float lb = hgrn_lb(F, h); float btot = 0.f;
        f32x4 S[8];
#pragma unroll
        for (int dl = 0; dl < 8; ++dl) S[dl] = (f32x4){0.f, 0.f, 0.f, 0.f};
        for (int blk = 0; blk < 8; ++blk) { hgrn_prep<false>(F, (size_t)(n * 256 + blk * 32) * DM + h * 128, lb, btot); hgrn_mma<false>(F, S); __syncthreads(); }
        hgrn_state_store(F, U + (size_t)unit * 16384, S);
        if (F.tid < 128) D[unit * 128 + F.tid] = __expf(btot);
    }
}
__device__ __forceinline__ void hgrn_scan(Frame& F) {
    float* U = (float*)(F.ws + WS_U); const float* D = (const float*)(F.ws + WS_D);
    for (int gid = F.vcu * 512 + F.tid; gid < NBP * 8 * 128 * 32; gid += F.G * 512) {
        const int e4 = gid & 31, d = (gid >> 5) & 127, h = (gid >> 12) & 7, b = gid >> 15;
        f32x4 S = (f32x4){0.f, 0.f, 0.f, 0.f};
        for (int n0 = 0; n0 < 32; n0 += 8) {
            f32x4 u[8]; float dc[8];
#pragma unroll
            for (int i = 0; i < 8; ++i) { const size_t unit = (size_t)((b * 32 + n0 + i) * 8 + h); u[i] = *(const f32x4*)(U + unit * 16384 + d * 128 + e4 * 4); dc[i] = D[unit * 128 + d]; }
#pragma unroll
            for (int i = 0; i < 8; ++i) { const size_t unit = (size_t)((b * 32 + n0 + i) * 8 + h); *(f32x4*)(U + unit * 16384 + d * 128 + e4 * 4) = S; S = S * dc[i] + u[i]; }
        }
        *(f32x4*)(F.out + OFF_NSP + (size_t)(b * 8 + h) * 16384 + d * 128 + e4 * 4) = S;
    }
}
__device__ __forceinline__ void hgrn_pass_b(Frame& F) {
    const float* U = (const float*)(F.ws + WS_U);
    for (int unit = F.vcu; unit < 128 * 8 + NBS * 8; unit += F.G) {
        const bool samp = unit >= 1024; const int su = unit - 1024;
        const int h = unit & 7, nblk = samp ? 2 : 8; const size_t row0 = samp ? (size_t)MP + (size_t)(su >> 3) * DSEQ : (size_t)(unit >> 3) * 256;
        const float lb = hgrn_lb(F, h); float btot = 0.f;
        f32x4 S[8];
        hgrn_state_load(F, samp ? F.in[IN_ST] + (size_t)su * 16384 : U + (size_t)unit * 16384, S);
        for (int blk = 0; blk < nblk; ++blk) { const size_t ro = (row0 + blk * 32) * DM + h * 128;
            hgrn_prep<true>(F, ro, lb, btot); hgrn_mma<true>(F, S); __syncthreads(); hgrn_norm(F, ro); }
        if (samp) hgrn_state_store(F, F.out + OFF_NSS + (size_t)su * 16384, S);
        __syncthreads();
    }
}
struct Args { const float* in[22]; float* out; unsigned char* ws; int ph_lo, ph_hi; };
__global__ void __launch_bounds__(NWAVES * 64, 2) fwd(Args args) {
    extern __shared__ __attribute__((aligned(16))) unsigned char lds[];
    Frame F;
    F.lds = (LAS unsigned char*)lds;
    F.tid = threadIdx.x; F.lane = F.tid & 63; F.wave = __builtin_amdgcn_readfirstlane(F.tid >> 6);
    F.G = gridDim.x; { const int bx = blockIdx.x; F.vcu = (F.G % 8 == 0) ? (bx % 8) * (F.G / 8) + bx / 8 : bx; }
#pragma unroll
    for (int i = 0; i < 22; ++i) F.in[i] = args.in[i];
    F.out = args.out; F.ws = args.ws;
    cooperative_groups::grid_group grid = cooperative_groups::this_grid();
    const int lo = args.ph_lo, hi = args.ph_hi;
    for (int u = F.tid; u < (LDS_BYTES - LDSCTL_OFF) / 4; u += NWAVES * 64) ((LAS unsigned*)(F.lds + LDSCTL_OFF))[u] = 0u;
    __syncthreads();
    XcdBarrier bar; bar.bar = (unsigned*)(args.ws + WS_CTL) + CW_BAR; bar.x = 0; bar.st = nullptr;
#if MK_N_LAUNCHES == 1
    bar = xcd_barrier_post((unsigned*)(args.ws + WS_CTL) + CW_BAR, (volatile LAS unsigned*)(F.lds + MISC_OFF) + 8);
#endif
#define IN(k) (lo <= (k) && (k) < hi)
#define SEAM(k) do { if (IN(k) && IN((k) + 1)) { if ((k) == 0) grid.sync(); else xcd_barrier(bar); } } while (0)
    unsigned char* ws = args.ws;
    bf16_t* H = (bf16_t*)(ws + WS_H);

    if (IN(0)) { p0_prologue(F); }
    SEAM(0);
    if (IN(1)) { p1_ln_mod(F); }
    SEAM(1);
    if (IN(2)) {
        pg8::Gemm g{H, (const bf16_t*)(ws + WS_WIN), M, INW, DM}; pg8::StaticOrder S; S.init(M, INW, F.G, (int)blockIdx.x);
        pg8::EpiProj E{(bf16_t*)(ws + WS_QB), (bf16_t*)(ws + WS_KB), (bf16_t*)(ws + WS_VB), (bf16_t*)(ws + WS_HQ), (bf16_t*)(ws + WS_HZ), (bf16_t*)(ws + WS_HV), (bf16_t*)(ws + WS_HG), (bf16_t*)F.out, F.out};
        pg8::gemm_phase<pg8::EpiProj, pg8::StaticOrder, true, true>(F.lds, g, S, E);
    }
    SEAM(2);
    if (IN(3)) {
#if ATTN_IMPL
        attn_fast(F);
#else
        attn_simple(F);
#endif
#if HGRN_IMPL
        hgrn_pass_a(F);
#else
        hgrn_simple(F);
#endif
    }
    SEAM(3);
#if HGRN_IMPL
    if (IN(4)) { hgrn_scan(F); }
    SEAM(4);
    if (IN(5)) { hgrn_pass_b(F); }
    SEAM(5);
#endif
    if (IN(6)) {
        { pg8::Gemm g{(const bf16_t*)(ws + WS_QB), (const bf16_t*)(ws + WS_WBA), M, DM, 512}; pg8::StaticOrder S; S.init(M, DM, F.G, (int)blockIdx.x);
          pg8::EpiMerge<true> E{(const bf16_t*)F.out, nullptr, (bf16_t*)(ws + WS_T1)};
          pg8::gemm_phase<pg8::EpiMerge<true>, pg8::StaticOrder, true, true>(F.lds, g, S, E); }
        __syncthreads();
        { pg8::Gemm g{(const bf16_t*)(ws + WS_YH), (const bf16_t*)(ws + WS_WBH), M, DM, DM}; pg8::StaticOrder S; S.init(M, DM, F.G, (int)blockIdx.x);
          pg8::EpiMerge<false> E{(const bf16_t*)F.out, (const bf16_t*)(ws + WS_T1), (bf16_t*)(ws + WS_MERGED)};
          pg8::gemm_phase<pg8::EpiMerge<false>, pg8::StaticOrder, true, true>(F.lds, g, S, E); }
    }
    SEAM(6);
    if (IN(7)) {
        pg8::Gemm g{(const bf16_t*)(ws + WS_MERGED), (const bf16_t*)(ws + WS_WOUT), M, DM, DM}; pg8::StaticOrder S; S.init(M, DM, F.G, (int)blockIdx.x);
        pg8::EpiResid E{F.in[IN_XP], F.in[IN_XS], (const float*)(ws + WS_MOD) + 2048, (float*)(ws + WS_Z1), ALPHA};
        pg8::gemm_phase<pg8::EpiResid, pg8::StaticOrder, true, true>(F.lds, g, S, E);
    }
    SEAM(7);
    if (IN(8)) { p8_ln_mix(F); }
    SEAM(8);
    if (IN(9)) {
        pg8::Gemm g{H, (const bf16_t*)(ws + WS_WUP), M, 2 * DFF, DM}; pg8::StaticOrder S; S.init(M, 2 * DFF, F.G, (int)blockIdx.x);
        pg8::EpiSwiGLU E{(bf16_t*)(ws + WS_ACT)};
        pg8::gemm_phase<pg8::EpiSwiGLU, pg8::StaticOrder, true, true>(F.lds, g, S, E);
    }
    SEAM(9);
    if (IN(10)) {
        pg8::Gemm g{(const bf16_t*)(ws + WS_ACT), (const bf16_t*)(ws + WS_WDN), M, DM, DFF}; pg8::StaticOrder S; S.init(M, DM, F.G, (int)blockIdx.x);
        const float* X1 = (const float*)(ws + WS_X1);
        pg8::EpiResid E{X1, X1 + (size_t)MP * DM, (const float*)(ws + WS_MOD) + 5120, F.out, ALPHA};
        pg8::gemm_phase<pg8::EpiResid, pg8::StaticOrder, true, true>(F.lds, g, S, E);
    }
    SEAM(10);
    if (IN(11)) { p11_ln_out(F); }
#undef IN
#undef SEAM
}

extern "C" void kernel_launch(void* const* d_in, const int* in_sizes, int n_in, void* d_out, int out_size, void* d_ws, size_t ws_size, hipStream_t stream) {
    static int grid = 0;
    if (grid == 0) {
        if (n_in != 22 || out_size != 41549824 || ws_size < WS_END) { fprintf(stderr, "kernel_launch: unexpected problem (n_in %d, out %d, ws %zu)\n", n_in, out_size, ws_size); grid = -1; return; }
        int dev = 0, cus = 0, per_cu = 0;
        if (hipGetDevice(&dev) != hipSuccess || hipDeviceGetAttribute(&cus, hipDeviceAttributeMultiprocessorCount, dev) != hipSuccess) { grid = -1; return; }
        if (hipFuncSetAttribute((const void*)fwd, hipFuncAttributeMaxDynamicSharedMemorySize, LDS_BYTES) != hipSuccess) { fprintf(stderr, "kernel_launch: hipFuncSetAttribute failed\n"); grid = -1; return; }
        if (hipOccupancyMaxActiveBlocksPerMultiprocessor(&per_cu, (const void*)fwd, NWAVES * 64, LDS_BYTES) != hipSuccess || per_cu < 1) { fprintf(stderr, "kernel_launch: occupancy query says %d\n", per_cu); (void)hipGetLastError(); grid = -1; return; }
        grid = cus;
    }
    if (grid < 0) return;
    (void)hipMemsetAsync((char*)d_ws + WS_CTL, 0, CTL_ZERO_BYTES, stream);
    Args a{};
    for (int i = 0; i < 22; ++i) a.in[i] = (const float*)d_in[i];
    a.out = (float*)d_out; a.ws = (unsigned char*)d_ws;
#if MK_N_LAUNCHES == 1
    a.ph_lo = 0; a.ph_hi = N_PHASES;
    void* kargs[] = {&a};
    hipError_t e = hipLaunchCooperativeKernel((const void*)fwd, dim3(grid), dim3(NWAVES * 64), kargs, LDS_BYTES, stream);
    if (e != hipSuccess) fprintf(stderr, "kernel_launch: cooperative launch failed: %s\n", hipGetErrorString(e));
#else
    for (int p = 0; p < N_PHASES; ++p) {
        if (p == 4 || p == 5) { if (!HGRN_IMPL) continue; }
        a.ph_lo = p; a.ph_hi = p + 1;
        hipLaunchKernelGGL(fwd, dim3(grid), dim3(NWAVES * 64), LDS_BYTES, stream, a);
    }
#endif
}
```

```cpp
#define MK_N_LAUNCHES 1
#define ATTN_IMPL 1
#define HGRN_IMPL 1
#include <hip/hip_runtime.h>
#include <hip/hip_cooperative_groups.h>
#include <cstdio>
#include <cstdint>
namespace pg8 {
#define PG8_LAS __attribute__((address_space(3)))
typedef unsigned short bf16_t;
typedef short bf16x8 __attribute__((ext_vector_type(8)));
typedef float f32x4 __attribute__((ext_vector_type(4)));
typedef unsigned u32x4 __attribute__((ext_vector_type(4)));
constexpr int BM = 256, BK = 64, HALF = 128, HTB = HALF * BK * 2  , STAGE_BYTES = 8 * HTB, NXCD = 8, WGM = 8;

__host__ __device__ __forceinline__ int lds_byte(int r, int c) { const int st = (r >> 4) * 2 + (c >> 5), rr = r & 15, cc = c & 31, ob = rr * 64 + cc * 2; return st * 1024 + (ob ^ (((ob >> 9) & 1) << 5)); }
__host__ __device__ __forceinline__ void stage_rc(int b, int& R, int& C) { const int st = b / 1024, sb = b % 1024, swz = sb ^ (((sb >> 9) & 1) << 5); R = (st >> 1) * 16 + swz / 64; C = (st & 1) * 32 + (swz % 64) / 2; }
__host__ __device__ __forceinline__ int perm32(int rho) { const int n = rho >> 4, i = rho & 15; return 8 * (i >> 2) + 4 * n + (i & 3); }

struct Unit { int pm, pn; };
struct Gemm { const bf16_t* A; const bf16_t* Bt; int M, N, K; };

struct StaticOrder {
    int nM, nN, nwg, G, c;
    __host__ __device__ void init(int M, int N, int G_, int c_) { nM = M / BM; nN = N / BM; nwg = nM * nN; G = G_; c = c_; }
    __host__ __device__ bool next(int i, Unit& u) const {
        const long L = (long)i * G + c; if (L >= nwg) return false;
        int wgid = (int)L; { const int q = nwg / NXCD, r = nwg % NXCD, xcd = wgid % NXCD, off = wgid / NXCD; wgid = (xcd < r ? xcd * (q + 1) : r * (q + 1) + (xcd - r) * q) + off; }
        const int nig = WGM * nN, gid = wgid / nig, fm = gid * WGM, gsz = (nM - fm) < WGM ? (nM - fm) : WGM;
        u.pm = fm + ((wgid % nig) % gsz); u.pn = (wgid % nig) / gsz; return true;
    }
    __device__ __forceinline__ void a_ready(const Unit&) const {}
    __device__ __forceinline__ void done(const Unit&) const {}
};

__device__ __forceinline__ unsigned cvt_pk_bf16(float lo, float hi) { unsigned r; asm volatile("v_cvt_pk_bf16_f32 %0, %1, %2" : "=v"(r) : "v"(lo), "v"(hi)); return r; }
typedef float f32x2 __attribute__((ext_vector_type(2)));
__device__ __forceinline__ float bf2f(unsigned short b) { return __uint_as_float(((unsigned)b) << 16); }
__device__ __forceinline__ float fsigmoid(float x) { return __builtin_amdgcn_rcpf(1.0f + __expf(-x)); }
__device__ __forceinline__ float fsilu(float x) { return x * fsigmoid(x); }
__device__ __forceinline__ int mod_row(int row) { return row < 32768 ? (row >> 13) : 4 + ((row - 32768) >> 6); }
constexpr int OFF_NKP = 35651584, OFF_NVP = 35717120, OFF_NSP = 35782656, OFF_NKS = 36306944, OFF_NVS = 36831232, OFF_NSS = 37355520;

struct EpiProj {
    static constexpr bool PERM = true, AFTER_DRAIN = false;
    bf16_t *QB, *KB, *VB, *HQ, *HZ, *HV, *HG, *GT; float* dout;
    __device__ __forceinline__ void operator()(const f32x4 (&acc)[2][2][4][2], const Unit& u, int wr, int wc, int fr, int fq) const {
        const int pn = u.pn, row0 = u.pm * BM + wr * 64 + fr, cl = wc * 32 + 8 * fq;
        if (pn == 2) {
#pragma unroll
            for (int ai = 0; ai < 2; ++ai)
#pragma unroll
                for (int m = 0; m < 4; ++m) { const int row = row0 + ai * HALF + m * 16;
                    float* wdst = nullptr;
                    if (row < 32768) { const int t = row & 8191; if (t >= 8064) wdst = dout + OFF_NKP + (size_t)(((row >> 13) * 128 + (t - 8064)) * 128 + cl); }
                    else { const int r2 = row - 32768; wdst = dout + OFF_NKS + (size_t)(((r2 >> 6) * 128 + 64 + (r2 & 63)) * 128 + cl); }
#pragma unroll
                    for (int bj = 0; bj < 2; ++bj) { const f32x4 v0 = acc[ai][bj][m][0], v1 = acc[ai][bj][m][1];
                        u32x4 w; w.x = cvt_pk_bf16(v0[0], v0[1]); w.y = cvt_pk_bf16(v0[2], v0[3]); w.z = cvt_pk_bf16(v1[0], v1[1]); w.w = cvt_pk_bf16(v1[2], v1[3]);
                        *(u32x4*)((bj == 0 ? KB : VB) + (size_t)row * 128 + cl) = w;
                        if (wdst) { float* d = wdst + (bj == 0 ? 0 : (row < 32768 ? (OFF_NVP - OFF_NKP) : (OFF_NVS - OFF_NKS))); *(f32x4*)d = v0; *(f32x4*)(d + 4) = v1; } } }
            return;
        }
        int mode; bf16_t* base; int ldc, cb;
        if (pn < 2)       { mode = 0; base = QB; ldc = 512;  cb = pn * 256; }
        else if (pn < 7)  { mode = 1; base = HQ; ldc = 1024; cb = (pn - 3) * 256; }
        else if (pn < 11) { mode = 3; base = HZ; ldc = 1024; cb = (pn - 7) * 256; }
        else if (pn < 15) { mode = 3; base = HV; ldc = 1024; cb = (pn - 11) * 256; }
        else if (pn < 19) { mode = 1; base = HG; ldc = 1024; cb = (pn - 15) * 256; }
        else              { mode = 2; base = GT; ldc = 2048; cb = (pn - 19) * 256; }
#pragma unroll
        for (int ai = 0; ai < 2; ++ai)
#pragma unroll
            for (int m = 0; m < 4; ++m) { bf16_t* rowp = base + (size_t)(row0 + ai * HALF + m * 16) * ldc + cb + cl;
#pragma unroll
                for (int bj = 0; bj < 2; ++bj) { f32x4 v0 = acc[ai][bj][m][0], v1 = acc[ai][bj][m][1];
                    if (mode == 0) { v0 = v0 * 0.125f; v1 = v1 * 0.125f; }
                    else if (mode == 1) {
#pragma unroll
                        for (int i = 0; i < 4; ++i) { v0[i] = fsilu(v0[i]); v1[i] = fsilu(v1[i]); } }
                    else if (mode == 2) {
#pragma unroll
                        for (int i = 0; i < 4; ++i) { v0[i] = fsigmoid(v0[i]); v1[i] = fsigmoid(v1[i]); } }
                    u32x4 w; w.x = cvt_pk_bf16(v0[0], v0[1]); w.y = cvt_pk_bf16(v0[2], v0[3]); w.z = cvt_pk_bf16(v1[0], v1[1]); w.w = cvt_pk_bf16(v1[2], v1[3]);
                    *(u32x4*)(rowp + bj * HALF) = w; } }
    }
};
struct EpiSwiGLU {
    static constexpr bool PERM = true, AFTER_DRAIN = false;
    bf16_t* O;
    __device__ __forceinline__ void operator()(const f32x4 (&acc)[2][2][4][2], const Unit& u, int wr, int wc, int fr, int fq) const {
        const int row0 = u.pm * BM + wr * 64 + fr, col = u.pn * 128 + wc * 32 + 8 * fq;
#pragma unroll
        for (int ai = 0; ai < 2; ++ai)
#pragma unroll
            for (int m = 0; m < 4; ++m) { f32x4 v0, v1;
#pragma unroll
                for (int i = 0; i < 4; ++i) { v0[i] = fsilu(acc[ai][1][m][0][i]) * acc[ai][0][m][0][i]; v1[i] = fsilu(acc[ai][1][m][1][i]) * acc[ai][0][m][1][i]; }
                u32x4 w; w.x = cvt_pk_bf16(v0[0], v0[1]); w.y = cvt_pk_bf16(v0[2], v0[3]); w.z = cvt_pk_bf16(v1[0], v1[1]); w.w = cvt_pk_bf16(v1[2], v1[3]);
                *(u32x4*)(O + (size_t)(row0 + ai * HALF + m * 16) * 2816 + col) = w; }
    }
};
template <bool FIRST> struct EpiMerge {
    static constexpr bool PERM = true, AFTER_DRAIN = false;
    const bf16_t* GT; const bf16_t* T1in; bf16_t* O;
    __device__ __forceinline__ void operator()(const f32x4 (&acc)[2][2][4][2], const Unit& u, int wr, int wc, int fr, int fq) const {
        const int row0 = u.pm * BM + wr * 64 + fr, col0 = u.pn * BM + wc * 32 + 8 * fq;
#pragma unroll
        for (int ai = 0; ai < 2; ++ai)
#pragma unroll
            for (int m = 0; m < 4; ++m) { const size_t row = (size_t)(row0 + ai * HALF + m * 16);
#pragma unroll
                for (int bj = 0; bj < 2; ++bj) { const int col = col0 + bj * HALF;
                    const u32x4 g = *(const u32x4*)(GT + row * 2048 + (FIRST ? 0 : 1024) + col);
                    f32x4 v0 = acc[ai][bj][m][0], v1 = acc[ai][bj][m][1];
                    v0[0] *= __uint_as_float(g.x << 16); v0[1] *= __uint_as_float(g.x & 0xffff0000u); v0[2] *= __uint_as_float(g.y << 16); v0[3] *= __uint_as_float(g.y & 0xffff0000u);
                    v1[0] *= __uint_as_float(g.z << 16); v1[1] *= __uint_as_float(g.z & 0xffff0000u); v1[2] *= __uint_as_float(g.w << 16); v1[3] *= __uint_as_float(g.w & 0xffff0000u);
                    if (!FIRST) { const u32x4 t = *(const u32x4*)(T1in + row * 1024 + col);
                        v0[0] += __uint_as_float(t.x << 16); v0[1] += __uint_as_float(t.x & 0xffff0000u); v0[2] += __uint_as_float(t.y << 16); v0[3] += __uint_as_float(t.y & 0xffff0000u);
                        v1[0] += __uint_as_float(t.z << 16); v1[1] += __uint_as_float(t.z & 0xffff0000u); v1[2] += __uint_as_float(t.w << 16); v1[3] += __uint_as_float(t.w & 0xffff0000u); }
                    u32x4 w; w.x = cvt_pk_bf16(v0[0], v0[1]); w.y = cvt_pk_bf16(v0[2], v0[3]); w.z = cvt_pk_bf16(v1[0], v1[1]); w.w = cvt_pk_bf16(v1[2], v1[3]);
                    *(u32x4*)(O + row * 1024 + col) = w; } }
    }
};
struct EpiResid {
    static constexpr bool PERM = false, AFTER_DRAIN = false;
    const float* xa; const float* xb; const float* gate;
    float* out; float alpha;
    __device__ __forceinline__ void operator()(const f32x4 (&acc)[2][2][4][2], const Unit& u, int wr, int wc, int fr, int fq) const {
        const int row0 = u.pm * BM + wr * 64 + fr, col0 = u.pn * BM + wc * 32 + 4 * fq;
#pragma unroll
        for (int ai = 0; ai < 2; ++ai)
#pragma unroll
            for (int m = 0; m < 4; ++m) { const int row = row0 + ai * HALF + m * 16;
                const float* xr = row < 32768 ? xa + (size_t)row * 1024 : xb + (size_t)(row - 32768) * 1024;
                const float* gr = gate + (size_t)mod_row(row) * 6144; float* orow = out + (size_t)row * 1024;
#pragma unroll
                for (int bj = 0; bj < 2; ++bj)
#pragma unroll
                    for (int n = 0; n < 2; ++n) { const int c = col0 + bj * HALF + n * 16;
                        const f32x4 xv = *(const f32x4*)(xr + c), gv = *(const f32x4*)(gr + c);
                        *(f32x4*)(orow + c) = xv * alpha + gv * acc[ai][bj][m][n]; } }
    }
};
template <class Epi, class Sched, bool ALIGN_EPI = false, bool SP2 = false>
__device__ __forceinline__ void gemm_phase(PG8_LAS unsigned char* lds, const Gemm g, const Sched& S, const Epi& E) {
    const int tid = threadIdx.x, wid = __builtin_amdgcn_readfirstlane(tid >> 6), lane = tid & 63, wr = wid >> 2, wc = wid & 3, fr = lane & 15, fq = lane >> 4;
    const int K = g.K, nt = K / BK;
    unsigned voffA[2], voffB[2];
#pragma unroll
    for (int i = 0; i < 2; ++i) { int R, C; stage_rc(tid * 16 + i * 8192, R, C); const int Rb = Epi::PERM ? ((R & ~31) + perm32(R & 31)) : R;
        voffA[i] = (unsigned)(R * K + C) * 2u; voffB[i] = (unsigned)(Rb * K + C) * 2u; }
    const size_t kstep = (size_t)(BK * 2);
    const size_t hstep = (size_t)HALF * K * 2;
    const size_t tstep = 2 * hstep;
    const unsigned ldsw = (unsigned)wid * 1024u;
    const int aoff = lds_byte(wr * 64 + fr, fq * 8), boff = lds_byte(wc * 32 + fr, fq * 8);
#define PG8_SA(b, h) (((b) * 2 + (h)) * HTB)
#define PG8_SB(b, h) ((4 + (b) * 2 + (h)) * HTB)
#define PG8_STAGE(bufoff, gbase, voff) do { _Pragma("unroll") for (int _i = 0; _i < 2; ++_i) \
        __builtin_amdgcn_global_load_lds((const unsigned*)((const char*)(gbase) + (voff)[_i]), (PG8_LAS unsigned*)(lds + (bufoff) + ldsw + _i * 8192), 16, 0, 0); } while (0)
#define PG8_LDA(dst, b, h) do { _Pragma("unroll") for (int m = 0; m < 4; ++m) _Pragma("unroll") for (int k = 0; k < 2; ++k) dst[m][k] = *(const PG8_LAS bf16x8*)(lds + PG8_SA(b, h) + aoff + m * 2048 + k * 1024); } while (0)
#define PG8_LDB(dst, b, h) do { _Pragma("unroll") for (int n = 0; n < 2; ++n) _Pragma("unroll") for (int k = 0; k < 2; ++k) dst[n][k] = *(const PG8_LAS bf16x8*)(lds + PG8_SB(b, h) + boff + n * 2048 + k * 1024); } while (0)
#define PG8_MMA(ai, bj, At, Bt) do { __builtin_amdgcn_s_setprio(1); _Pragma("unroll") for (int m = 0; m < 4; ++m) _Pragma("unroll") for (int n = 0; n < 2; ++n) _Pragma("unroll") for (int k = 0; k < 2; ++k) \
        acc[ai][bj][m][n] = __builtin_amdgcn_mfma_f32_16x16x32_bf16(Bt[n][k], At[m][k], acc[ai][bj][m][n], 0, 0, 0); __builtin_amdgcn_s_setprio(0); } while (0)
#define PG8_WAIT_V(n) asm volatile("s_waitcnt vmcnt(" #n ")" ::: "memory")
#define PG8_WAIT_L(n) asm volatile("s_waitcnt lgkmcnt(" #n ")" ::: "memory")
#define PG8_BAR __builtin_amdgcn_s_barrier()
#define PG8_SCHED __builtin_amdgcn_sched_barrier(0)
    Unit cur, nxt; int ui = 0;
    if (!S.next(0, cur)) return;
    f32x4 acc[2][2][4][2];
#pragma unroll
    for (int a = 0; a < 2; ++a)
#pragma unroll
        for (int b = 0; b < 2; ++b)
#pragma unroll
            for (int m = 0; m < 4; ++m)
#pragma unroll
                for (int n = 0; n < 2; ++n) acc[a][b][m][n] = (f32x4){0.f, 0.f, 0.f, 0.f};
    bf16x8 At[4][2], B0[2][2], B1[2][2];
    const char* cA = (const char*)g.A + (size_t)cur.pm * tstep; const char* cB = (const char*)g.Bt + (size_t)cur.pn * tstep;
    S.a_ready(cur);
    if constexpr (SP2) {
        PG8_STAGE(PG8_SB(0, 0), cB, voffB); PG8_STAGE(PG8_SB(0, 1), cB + hstep, voffB); PG8_STAGE(PG8_SA(0, 0), cA, voffA); PG8_STAGE(PG8_SA(0, 1), cA + hstep, voffA);
        if (wr == 1) PG8_BAR;
        PG8_WAIT_V(2); PG8_BAR;
        PG8_STAGE(PG8_SB(1, 0), cB + kstep, voffB); PG8_STAGE(PG8_SA(1, 0), cA + kstep, voffA); PG8_STAGE(PG8_SB(1, 1), cB + hstep + kstep, voffB);
        PG8_WAIT_V(6); PG8_BAR;
    } else {
        PG8_STAGE(PG8_SB(0, 0), cB, voffB); PG8_STAGE(PG8_SA(0, 0), cA, voffA); PG8_STAGE(PG8_SB(0, 1), cB + hstep, voffB); PG8_STAGE(PG8_SA(0, 1), cA + hstep, voffA);
        if (wr == 1) PG8_BAR;
        PG8_WAIT_V(4); PG8_BAR;
        PG8_STAGE(PG8_SB(1, 0), cB + kstep, voffB); PG8_STAGE(PG8_SA(1, 0), cA + kstep, voffA); PG8_STAGE(PG8_SB(1, 1), cB + hstep + kstep, voffB);
        PG8_WAIT_V(6); PG8_BAR;
    }
    for (;;) {
        const bool has_next = S.next(ui + 1, nxt);
        const char* nA = has_next ? (const char*)g.A + (size_t)nxt.pm * tstep : cA; const char* nB = has_next ? (const char*)g.Bt + (size_t)nxt.pn * tstep : cB;
        for (int t = 0; t < nt; t += 2) {
            const bool last = (t == nt - 2);
            const char* a1 = cA + (size_t)(t + 1) * kstep;
            const char* a2 = last ? nA : cA + (size_t)(t + 2) * kstep; const char* b2 = last ? nB : cB + (size_t)(t + 2) * kstep;
            const char* a3 = a2 + kstep; const char* b3 = b2 + kstep;
            if (last && has_next) S.a_ready(nxt);
            if constexpr (SP2) {
            PG8_LDB(B0, 0, 0); PG8_LDB(B1, 0, 1); PG8_SCHED; PG8_LDA(At, 0, 0); PG8_STAGE(PG8_SA(1, 1), a1 + hstep, voffA);
            PG8_WAIT_V(8); PG8_WAIT_L(0); PG8_BAR; PG8_MMA(0, 0, At, B0); PG8_MMA(0, 1, At, B1); PG8_BAR; PG8_SCHED;
            PG8_LDA(At, 0, 1); PG8_STAGE(PG8_SB(0, 0), b2, voffB); PG8_STAGE(PG8_SB(0, 1), b2 + hstep, voffB); PG8_STAGE(PG8_SA(0, 0), a2, voffA);
            PG8_WAIT_V(8); PG8_WAIT_L(0); PG8_BAR; PG8_MMA(1, 0, At, B0); PG8_MMA(1, 1, At, B1); PG8_BAR; PG8_SCHED;
            PG8_LDB(B0, 1, 0); PG8_LDB(B1, 1, 1); PG8_SCHED; PG8_LDA(At, 1, 0); PG8_STAGE(PG8_SA(0, 1), a2 + hstep, voffA);
            PG8_WAIT_V(8); PG8_WAIT_L(0); PG8_BAR; PG8_MMA(0, 0, At, B0); PG8_MMA(0, 1, At, B1); PG8_BAR; PG8_SCHED;
            PG8_LDA(At, 1, 1); PG8_STAGE(PG8_SB(1, 0), b3, voffB); PG8_STAGE(PG8_SB(1, 1), b3 + hstep, voffB); PG8_STAGE(PG8_SA(1, 0), a3, voffA);
            PG8_WAIT_V(8); PG8_WAIT_L(0); PG8_BAR; PG8_MMA(1, 0, At, B0); PG8_MMA(1, 1, At, B1); PG8_BAR; PG8_SCHED;
            } else {
            PG8_LDB(B0, 0, 0); PG8_SCHED; PG8_LDA(At, 0, 0); PG8_STAGE(PG8_SA(1, 1), a1 + hstep, voffA);
            PG8_WAIT_L(8); PG8_BAR; PG8_WAIT_L(0); PG8_MMA(0, 0, At, B0); PG8_BAR; PG8_SCHED;
            PG8_LDB(B1, 0, 1); PG8_STAGE(PG8_SB(0, 0), b2, voffB);
            PG8_BAR; PG8_WAIT_L(0); PG8_MMA(0, 1, At, B1); PG8_BAR;
            PG8_LDA(At, 0, 1); PG8_STAGE(PG8_SA(0, 0), a2, voffA);
            PG8_BAR; PG8_WAIT_L(0); PG8_MMA(1, 0, At, B0); PG8_BAR; PG8_SCHED;
            PG8_STAGE(PG8_SB(0, 1), b2 + hstep, voffB);
            PG8_WAIT_V(6); PG8_BAR; PG8_MMA(1, 1, At, B1); PG8_BAR;
            PG8_LDB(B0, 1, 0); PG8_SCHED; PG8_LDA(At, 1, 0); PG8_STAGE(PG8_SA(0, 1), a2 + hstep, voffA);
            PG8_WAIT_L(8); PG8_BAR; PG8_WAIT_L(0); PG8_MMA(0, 0, At, B0); PG8_BAR; PG8_SCHED;
            PG8_LDB(B1, 1, 1); PG8_STAGE(PG8_SB(1, 0), b3, voffB);
            PG8_BAR; PG8_WAIT_L(0); PG8_MMA(0, 1, At, B1); PG8_BAR;
            PG8_LDA(At, 1, 1); PG8_STAGE(PG8_SA(1, 0), a3, voffA);
            PG8_BAR; PG8_WAIT_L(0); PG8_MMA(1, 0, At, B0); PG8_BAR; PG8_SCHED;
            PG8_STAGE(PG8_SB(1, 1), b3 + hstep, voffB);
            PG8_WAIT_V(6); PG8_BAR; PG8_MMA(1, 1, At, B1); PG8_BAR;
            }
        }
        if constexpr (ALIGN_EPI) { if (wr == 0) PG8_BAR; }
        if constexpr (!Epi::AFTER_DRAIN) { E(acc, cur, wr, wc, fr, fq); S.done(cur); }
        if (!has_next) break;
#pragma unroll
        for (int a = 0; a < 2; ++a)
#pragma unroll
            for (int b = 0; b < 2; ++b)
#pragma unroll
                for (int m = 0; m < 4; ++m)
#pragma unroll
                    for (int n = 0; n < 2; ++n) acc[a][b][m][n] = (f32x4){0.f, 0.f, 0.f, 0.f};
        cur = nxt; cA = nA; cB = nB; ++ui;
        if constexpr (ALIGN_EPI) { if (wr == 1) PG8_BAR; }
    }
    PG8_WAIT_V(0);
    if constexpr (!ALIGN_EPI) { if (wr == 0) PG8_BAR; }
    PG8_BAR;
    if constexpr (Epi::AFTER_DRAIN) { E.fused(acc, cur, wr, wc, fr, fq, lds, wid, lane); S.done(cur); }
#undef PG8_SA
#undef PG8_SB
#undef PG8_STAGE
#undef PG8_LDA
#undef PG8_LDB
#undef PG8_MMA
#undef PG8_WAIT_V
#undef PG8_WAIT_L
#undef PG8_BAR
#undef PG8_SCHED
}
}
#define GAS __attribute__((address_space(1)))
#define LAS __attribute__((address_space(3)))
typedef unsigned short bf16;
typedef unsigned v4u __attribute__((ext_vector_type(4)));
typedef float f32x4 __attribute__((ext_vector_type(4)));
typedef short bf16x8 __attribute__((ext_vector_type(8)));
typedef GAS unsigned gu32;
typedef GAS unsigned long long gu64;
#define RLX_AGENT __ATOMIC_RELAXED, __HIP_MEMORY_SCOPE_AGENT
#define LDS_WAIT() asm volatile("s_waitcnt lgkmcnt(0)" ::: "memory")
#define VM_WAIT() asm volatile("s_waitcnt vmcnt(0)" ::: "memory")
__device__ __forceinline__ unsigned long long rt() { return __builtin_amdgcn_s_memrealtime(); }
__device__ __forceinline__ unsigned f2bf(float f) { unsigned u = __builtin_bit_cast(unsigned, f); return (u + 0x7fffu + ((u >> 16) & 1u)) >> 16; }
__device__ __forceinline__ unsigned pk2(float lo, float hi) { return f2bf(lo) | (f2bf(hi) << 16); }
#define XB_TMO      128
#define XB_XCNT(j)  (256  + 64 * (j))
#define XB_XSUB(j)  (1280 + 64 * (j))
#define XB_XGEN(j)  (2304 + 64 * (j))
#define XB_TOP      3328
#define XB_TOPGEN   3392
#define XCD_BAR_WORDS 3456
#define XB_SPIN_CAP (1u << 18)

__device__ __forceinline__ unsigned xb_ld(unsigned* p)              { return __hip_atomic_load(p, __ATOMIC_RELAXED, __HIP_MEMORY_SCOPE_AGENT); }
__device__ __forceinline__ unsigned xb_add(unsigned* p, unsigned v) { return __hip_atomic_fetch_add(p, v, __ATOMIC_RELAXED, __HIP_MEMORY_SCOPE_AGENT); }
__device__ __forceinline__ unsigned xb_xcc_id() { return (unsigned)__builtin_amdgcn_s_getreg((3 << 11) | 20) & 0xFu; }
#define XB_SPIN(cond, bar) do { unsigned _sp = 0; while (cond) { __builtin_amdgcn_s_sleep(1); \
    if ((++_sp & 255u) == 0u) { if (xb_ld(&(bar)[XB_TMO])) break; if (_sp > XB_SPIN_CAP) { atomicAdd(&(bar)[XB_TMO], 1u); break; } } } } while (0)

struct XcdBarrier {
    unsigned* bar; unsigned x;
    volatile LAS unsigned* st;
};

__device__ __forceinline__ XcdBarrier xcd_barrier_post(unsigned* bar, volatile LAS unsigned* st) {
    XcdBarrier b; b.bar = bar; b.x = xb_xcc_id(); b.st = st;
    if (threadIdx.x == 0) (void)xb_add(&bar[XB_XCNT(b.x)], 1u);
    return b;
}
__device__ __forceinline__ void xcd_barrier_complete(unsigned* bar, unsigned x, unsigned& nloc, unsigned& nx) {
    const unsigned G = gridDim.x * gridDim.y * gridDim.z;
    unsigned sum, cnt, mine, sp = 0u;
    for (;;) {
        sum = 0u; cnt = 0u; mine = 0u;
#pragma unroll
        for (unsigned j = 0; j < 16; ++j) { const unsigned c = xb_ld(&bar[XB_XCNT(j)]); sum += c; cnt += (c > 0u) ? 1u : 0u; mine = (j == x) ? c : mine; }
        if (sum == G) break;
        __builtin_amdgcn_s_sleep(1);
        if ((++sp & 255u) == 0u) { if (xb_ld(&bar[XB_TMO])) break; if (sp > XB_SPIN_CAP) { atomicAdd(&bar[XB_TMO], 1u); break; } }
    }
    nloc = mine > 0u ? mine : 1u; nx = cnt > 0u ? cnt : 1u;
}

__device__ __forceinline__ void xcd_barrier(const XcdBarrier& b) {
    asm volatile("s_waitcnt vmcnt(0)" ::: "memory");
    __syncthreads();
    if (threadIdx.x == 0) {
        unsigned* bar = b.bar;
        __builtin_amdgcn_s_waitcnt(0);
        unsigned nloc = b.st[0], nx = b.st[1];
        if (nloc == 0u) { xcd_barrier_complete(bar, b.x, nloc, nx); b.st[0] = nloc; b.st[1] = nx; }
        const unsigned old = xb_add(&bar[XB_XSUB(b.x)], 1u);
        const unsigned gen = old / nloc;
        if (old + 1u == (gen + 1u) * nloc) {
            __builtin_amdgcn_fence(__ATOMIC_RELEASE, "agent");
            asm volatile("s_waitcnt vmcnt(0)" ::: "memory");
            const unsigned og = xb_add(&bar[XB_TOP], 1u);
            const unsigned tg = og / nx;
            if (og + 1u == (tg + 1u) * nx) xb_add(&bar[XB_TOPGEN], 1u);
            else XB_SPIN(xb_ld(&bar[XB_TOPGEN]) == tg, bar);
            __builtin_amdgcn_fence(__ATOMIC_ACQUIRE, "agent");
            xb_add(&bar[XB_XGEN(b.x)], 1u);
            asm volatile("s_waitcnt vmcnt(0)" ::: "memory");
        } else {
            XB_SPIN(xb_ld(&bar[XB_XGEN(b.x)]) == gen, bar);
            __builtin_amdgcn_fence(__ATOMIC_ACQUIRE, "agent");
            asm volatile("s_waitcnt vmcnt(0)" ::: "memory");
        }
    }
    __syncthreads();
}
#ifndef MK_N_LAUNCHES
#define MK_N_LAUNCHES 1
#endif
#ifndef ATTN_IMPL
#define ATTN_IMPL 0
#endif
#ifndef HGRN_IMPL
#define HGRN_IMPL 0
#endif
constexpr int NWAVES = 8;
constexpr int N_PHASES = 12;

constexpr int DM = 1024, SEQ = 8192, NBP = 4, NBS = 32, DSEQ = 64, MP = NBP * SEQ, MS = NBS * DSEQ, M = MP + MS;
constexpr int INW = 6912, DFF = 2816, NMOD = NBP + NBS;
constexpr float LN_EPS = 1e-5f, RMS_EPS = 1e-6f;
constexpr float ALPHA = 1.189207115002721f;
static_assert(M % 256 == 0 && INW % 256 == 0 && (2 * DFF) % 256 == 0, "tile shapes");

constexpr size_t MiB = 1u << 20, HMiB = 1u << 19;
constexpr size_t WS_CTL = 0, WS_MOD = 1 * MiB, CTL_ZERO_BYTES = 2 * MiB;
constexpr size_t WS_WIN = 2 * MiB, WS_WBA = 31 * HMiB, WS_WBH = 33 * HMiB, WS_WOUT = 37 * HMiB, WS_WUP = 41 * HMiB, WS_WDN = 63 * HMiB;
constexpr size_t WS_H = 37 * MiB, WS_QB = 105 * MiB, WS_KB = 139 * MiB, WS_VB = 295 * HMiB, WS_HQ = 156 * MiB, WS_HZ = 224 * MiB, WS_HV = 292 * MiB, WS_HG = 360 * MiB;
constexpr size_t WS_U = 428 * MiB, WS_D = 492 * MiB, WS_END = 985 * HMiB;
constexpr size_t WS_YH = WS_H, WS_T1 = WS_HQ, WS_MERGED = WS_HZ, WS_Z1 = WS_HV, WS_X1 = WS_HQ, WS_ACT = WS_HV;
static_assert(WS_WIN + (size_t)INW * DM * 2 == WS_WBA && WS_WBA + 512 * 1024 * 2 == WS_WBH && WS_WBH + 1024 * 1024 * 2 == WS_WOUT && WS_WOUT + 1024 * 1024 * 2 == WS_WUP &&
              WS_WUP + (size_t)2 * DFF * DM * 2 == WS_WDN && WS_WDN + (size_t)DM * DFF * 2 == WS_H && WS_H + (size_t)M * DM * 2 == WS_QB && WS_QB + (size_t)M * 512 * 2 == WS_KB &&
              WS_KB + (size_t)M * 128 * 2 == WS_VB && WS_VB + (size_t)M * 128 * 2 == WS_HQ && WS_HQ + (size_t)M * DM * 2 == WS_HZ && WS_HG + (size_t)M * DM * 2 == WS_U &&
              WS_ACT + (size_t)M * DFF * 2 <= WS_D && WS_END <= 512 * MiB, "d_ws map");
constexpr int CW_BAR = 4096;

constexpr int RING_BYTES = 131072, LDSCTL_OFF = RING_BYTES, MISC_OFF = LDSCTL_OFF + 320, LDS_BYTES = 147456;

typedef unsigned short bf16_t;
typedef unsigned u32x4 __attribute__((ext_vector_type(4)));
typedef unsigned u32x2 __attribute__((ext_vector_type(2)));
using pg8::bf2f; using pg8::fsigmoid; using pg8::fsilu; using pg8::mod_row;
using pg8::OFF_NKP; using pg8::OFF_NVP; using pg8::OFF_NSP; using pg8::OFF_NKS; using pg8::OFF_NVS; using pg8::OFF_NSS;

struct Frame {
    LAS unsigned char* lds;
    int tid, lane, wave, vcu, G;
    const float* in[22]; float* out; unsigned char* ws;
};
#define IN_XP 0
#define IN_XS 1
#define IN_CK 2
#define IN_CV 3
#define IN_ST 4
#define IN_CP 5
#define IN_CS 6
#define IN_WADA 7
#define IN_BADA 8
#define IN_WIN 9
#define IN_SINK 10
#define IN_LBL 11
#define IN_NORMW 12
#define IN_WBA 13
#define IN_WBH 14
#define IN_WOUT 15
#define IN_LNMG 16
#define IN_LNMB 17
#define IN_WUP 18
#define IN_WDN 19
#define IN_LNFG 20
#define IN_LNFB 21

__device__ __forceinline__ float wave_sum(float v) {
#pragma unroll
    for (int o = 1; o < 64; o <<= 1) v += __shfl_xor(v, o);
    return v;
}
template <class RMap>
__device__ __forceinline__ void transpose_item(const float* W, int K, int N, bf16_t* WT, LAS float* scr, int item, int lane, RMap rmap) {
    const int nblk = N / 32, kb = item / nblk, nb = item % nblk, k0 = 64 * kb, n0 = 32 * nb;
#pragma unroll 8
    for (int i = 0; i < 32; ++i) { const int kk = 2 * i + (lane >> 5); scr[kk * 33 + (lane & 31)] = W[(size_t)(k0 + kk) * N + n0 + (lane & 31)]; }
    LDS_WAIT(); asm volatile("" ::: "memory");
    const int c = lane & 7; const int nd0 = rmap(n0);
#pragma unroll
    for (int j = 0; j < 4; ++j) { const int n = (lane >> 3) + 8 * j; const LAS float* s = scr + (8 * c) * 33 + n;
        v4u o; o.x = pk2(s[0 * 33], s[1 * 33]); o.y = pk2(s[2 * 33], s[3 * 33]); o.z = pk2(s[4 * 33], s[5 * 33]); o.w = pk2(s[6 * 33], s[7 * 33]);
        *(GAS v4u*)(WT + (size_t)(nd0 + n) * K + k0 + 8 * c) = o; }
    LDS_WAIT(); asm volatile("" ::: "memory");
}
struct RMapId { __device__ __forceinline__ int operator()(int n0) const { return n0; } };
struct RMapUp { __device__ __forceinline__ int operator()(int n0) const { return n0 < DFF ? 256 * (n0 >> 7) + (n0 & 127) : 256 * ((n0 - DFF) >> 7) + 128 + ((n0 - DFF) & 127); } };

__device__ __forceinline__ void p0_prologue(Frame& F) {
    if (F.vcu < 192) {
        const int kc = F.vcu / 12, ec = F.vcu % 12, k0 = kc * 64, col = ec * 512 + F.tid;
        LAS float* sc = (LAS float*)F.lds;
        for (int i = F.tid; i < 64 * NMOD; i += 512) { const int kk = i / NMOD, mb = i % NMOD;
            const float cv = mb < NBP ? F.in[IN_CP][mb * DM + k0 + kk] : F.in[IN_CS][(mb - NBP) * DM + k0 + kk]; sc[kk * NMOD + mb] = fsilu(cv); }
        __syncthreads();
        float acc[NMOD];
#pragma unroll
        for (int i = 0; i < NMOD; ++i) acc[i] = 0.f;
        const float* wp = F.in[IN_WADA] + (size_t)k0 * 6144 + col;
#pragma unroll 4
        for (int kk = 0; kk < 64; ++kk) { const float w = wp[(size_t)kk * 6144];
#pragma unroll
            for (int i = 0; i < NMOD; ++i) acc[i] += sc[kk * NMOD + i] * w; }
        const float bias = kc == 0 ? F.in[IN_BADA][col] : 0.f;
        float* mod = (float*)(F.ws + WS_MOD);
#pragma unroll
        for (int i = 0; i < NMOD; ++i) atomicAdd(mod + i * 6144 + col, acc[i] + bias);
        __syncthreads();
    }
    LAS float* scr = (LAS float*)(F.lds + F.wave * 16384);
    const int gw = F.vcu * NWAVES + F.wave, NGW = F.G * NWAVES;
    constexpr int I_IN = (DM / 64) * (INW / 32), I_BA = (512 / 64) * (DM / 32), I_BH = (DM / 64) * (DM / 32), I_OUT = I_BH, I_UP = (DM / 64) * (2 * DFF / 32), I_DN = (DFF / 64) * (DM / 32);
    constexpr int NITEMS = I_IN + I_BA + I_BH + I_OUT + I_UP + I_DN;
    for (int it = gw; it < NITEMS; it += NGW) {
        int r = it;
        if (r < I_IN) { transpose_item(F.in[IN_WIN], DM, INW, (bf16_t*)(F.ws + WS_WIN), scr, r, F.lane, RMapId()); continue; } r -= I_IN;
        if (r < I_BA) { transpose_item(F.in[IN_WBA], 512, DM, (bf16_t*)(F.ws + WS_WBA), scr, r, F.lane, RMapId()); continue; } r -= I_BA;
        if (r < I_BH) { transpose_item(F.in[IN_WBH], DM, DM, (bf16_t*)(F.ws + WS_WBH), scr, r, F.lane, RMapId()); continue; } r -= I_BH;
        if (r < I_OUT) { transpose_item(F.in[IN_WOUT], DM, DM, (bf16_t*)(F.ws + WS_WOUT), scr, r, F.lane, RMapId()); continue; } r -= I_OUT;
        if (r < I_UP) { transpose_item(F.in[IN_WUP], DM, 2 * DFF, (bf16_t*)(F.ws + WS_WUP), scr, r, F.lane, RMapUp()); continue; } r -= I_UP;
        transpose_item(F.in[IN_WDN], DFF, DM, (bf16_t*)(F.ws + WS_WDN), scr, r, F.lane, RMapId());
    }
    const int gt = F.vcu * 512 + F.tid, NGT = F.G * 512;
    for (int i = gt; i < 2 * NBS * 64 * 32; i += NGT) {
        const int kv = i / (NBS * 64 * 32), r = i % (NBS * 64 * 32), b = r / (64 * 32), q = r % (64 * 32);
        const f32x4 v = *(const f32x4*)(F.in[kv ? IN_CV : IN_CK] + (size_t)b * 128 * 128 + 64 * 128 + q * 4);
        *(f32x4*)(F.out + (kv ? OFF_NVS : OFF_NKS) + (size_t)b * 128 * 128 + q * 4) = v;
    }
}

__device__ __forceinline__ void ln_norm(f32x4 (&v)[4]) {
    float s = 0.f;
#pragma unroll
    for (int j = 0; j < 4; ++j) s += (v[j][0] + v[j][1]) + (v[j][2] + v[j][3]);
    const float mean = wave_sum(s) * (1.f / DM); float s2 = 0.f;
#pragma unroll
    for (int j = 0; j < 4; ++j) { v[j] = v[j] - mean; s2 += (v[j][0] * v[j][0] + v[j][1] * v[j][1]) + (v[j][2] * v[j][2] + v[j][3] * v[j][3]); }
    const float rstd = 1.f / sqrtf(wave_sum(s2) * (1.f / DM) + LN_EPS);
#pragma unroll
    for (int j = 0; j < 4; ++j) v[j] = v[j] * rstd;
}
__device__ __forceinline__ void store_row_bf16(bf16_t* orow, int lane, const f32x4 (&v)[4]) {
#pragma unroll
    for (int j = 0; j < 4; ++j) { u32x2 w; w.x = pk2(v[j][0], v[j][1]); w.y = pk2(v[j][2], v[j][3]); *(u32x2*)(orow + 4 * lane + 256 * j) = w; }
}
__device__ __forceinline__ void p1_ln_mod(Frame& F) {
    const int gw = F.vcu * NWAVES + F.wave, NGW = F.G * NWAVES; const float* mod = (const float*)(F.ws + WS_MOD); bf16_t* H = (bf16_t*)(F.ws + WS_H);
    for (int row = gw; row < M; row += NGW) {
        const float* xr = row < MP ? F.in[IN_XP] + (size_t)row * DM : F.in[IN_XS] + (size_t)(row - MP) * DM; const float* mr = mod + (size_t)mod_row(row) * 6144;
        f32x4 v[4];
#pragma unroll
        for (int j = 0; j < 4; ++j) v[j] = *(const f32x4*)(xr + 4 * F.lane + 256 * j);
        ln_norm(v);
#pragma unroll
        for (int j = 0; j < 4; ++j) { const f32x4 sh = *(const f32x4*)(mr + 4 * F.lane + 256 * j), sc = *(const f32x4*)(mr + 1024 + 4 * F.lane + 256 * j); v[j] = v[j] * (sc + 1.0f) + sh; }
        store_row_bf16(H + (size_t)row * DM, F.lane, v);
    }
}
__device__ __forceinline__ void p8_ln_mix(Frame& F) {
    const int gw = F.vcu * NWAVES + F.wave, NGW = F.G * NWAVES; const float* mod = (const float*)(F.ws + WS_MOD); bf16_t* H = (bf16_t*)(F.ws + WS_H);
    const float* Z1 = (const float*)(F.ws + WS_Z1); float* X1 = (float*)(F.ws + WS_X1);
    f32x4 gg[4], bb[4];
#pragma unroll
    for (int j = 0; j < 4; ++j) { gg[j] = *(const f32x4*)(F.in[IN_LNMG] + 4 * F.lane + 256 * j); bb[j] = *(const f32x4*)(F.in[IN_LNMB] + 4 * F.lane + 256 * j); }
    for (int row = gw; row < M; row += NGW) {
        const float* mr = mod + (size_t)mod_row(row) * 6144;
        f32x4 v[4];
#pragma unroll
        for (int j = 0; j < 4; ++j) v[j] = *(const f32x4*)(Z1 + (size_t)row * DM + 4 * F.lane + 256 * j);
        ln_norm(v);
#pragma unroll
        for (int j = 0; j < 4; ++j) { v[j] = v[j] * gg[j] + bb[j]; *(f32x4*)(X1 + (size_t)row * DM + 4 * F.lane + 256 * j) = v[j]; }
        ln_norm(v);
#pragma unroll
        for (int j = 0; j < 4; ++j) { const f32x4 sh = *(const f32x4*)(mr + 3072 + 4 * F.lane + 256 * j), sc = *(const f32x4*)(mr + 4096 + 4 * F.lane + 256 * j); v[j] = v[j] * (sc + 1.0f) + sh; }
        store_row_bf16(H + (size_t)row * DM, F.lane, v);
    }
}
__device__ __forceinline__ void p11_ln_out(Frame& F) {
    const int gw = F.vcu * NWAVES + F.wave, NGW = F.G * NWAVES;
    f32x4 gg[4], bb[4];
#pragma unroll
    for (int j = 0; j < 4; ++j) { gg[j] = *(const f32x4*)(F.in[IN_LNFG] + 4 * F.lane + 256 * j); bb[j] = *(const f32x4*)(F.in[IN_LNFB] + 4 * F.lane + 256 * j); }
    for (int row = gw; row < M; row += NGW) {
        float* zr = F.out + (size_t)row * DM;
        f32x4 v[4];
#pragma unroll
        for (int j = 0; j < 4; ++j) v[j] = *(const f32x4*)(zr + 4 * F.lane + 256 * j);
        ln_norm(v);
#pragma unroll
        for (int j = 0; j < 4; ++j) *(f32x4*)(zr + 4 * F.lane + 256 * j) = v[j] * gg[j] + bb[j];
    }
}

__device__ __forceinline__ void attn_simple(Frame& F) {
    bf16_t* QB = (bf16_t*)(F.ws + WS_QB); const bf16_t* KB = (const bf16_t*)(F.ws + WS_KB); const bf16_t* VB = (const bf16_t*)(F.ws + WS_VB);
    LAS bf16_t* Ks = (LAS bf16_t*)F.lds; LAS bf16_t* Vs = (LAS bf16_t*)(F.lds + 192 * 64 * 2);
    for (int unit = F.vcu; unit < 544 * 2; unit += F.G) {
        const int ci = unit >> 1, j = unit & 1; const bool samp = ci >= 512;
        const int row0 = samp ? MP + (ci - 512) * DSEQ : (ci >> 7) * SEQ + (ci & 127) * 64; const int c = ci & 127;
        for (int idx = F.tid; idx < 192 * 8 * 2; idx += 512) { const int kv = idx / (192 * 8), r = idx % (192 * 8), i = r >> 3, ch = r & 7;
            u32x4 w = (u32x4){0u, 0u, 0u, 0u};
            if (samp && i < 128) { const float* src = F.in[kv ? IN_CV : IN_CK] + ((size_t)((ci - 512) * 128 + i) * 2 + j) * 64 + ch * 8;
                const f32x4 a = *(const f32x4*)src, b = *(const f32x4*)(src + 4); w.x = pk2(a[0], a[1]); w.y = pk2(a[2], a[3]); w.z = pk2(b[0], b[1]); w.w = pk2(b[2], b[3]); }
            else if (samp || c * 64 - 128 + i >= 0) { const size_t krow = (size_t)(row0 - 128 + i); w = *(const u32x4*)((kv ? VB : KB) + krow * 128 + j * 64 + ch * 8); }
            *(LAS u32x4*)((kv ? Vs : Ks) + i * 64 + ch * 8) = w; }
        __syncthreads();
        if (F.tid < 256) {
            const int g = F.tid >> 6, t = F.tid & 63, hq = 4 * j + g; bf16_t* qp = QB + (size_t)(row0 + t) * 512 + hq * 64;
            float q[64], o[64];
#pragma unroll
            for (int ch = 0; ch < 8; ++ch) { const u32x4 w = *(const u32x4*)(qp + ch * 8);
                q[ch * 8 + 0] = __uint_as_float(w.x << 16); q[ch * 8 + 1] = __uint_as_float(w.x & 0xffff0000u); q[ch * 8 + 2] = __uint_as_float(w.y << 16); q[ch * 8 + 3] = __uint_as_float(w.y & 0xffff0000u);
                q[ch * 8 + 4] = __uint_as_float(w.z << 16); q[ch * 8 + 5] = __uint_as_float(w.z & 0xffff0000u); q[ch * 8 + 6] = __uint_as_float(w.w << 16); q[ch * 8 + 7] = __uint_as_float(w.w & 0xffff0000u); }
#pragma unroll
            for (int d = 0; d < 64; ++d) o[d] = 0.f;
            const float slope = exp2f(-(float)(hq + 1)); float mx = F.in[IN_SINK][hq], l = 1.f;
            const int i0 = samp ? 0 : (128 - c * 64 > 0 ? 128 - c * 64 : 0);
            for (int i = i0; i < 192; ++i) {
                float s = 0.f;
#pragma unroll
                for (int d2 = 0; d2 < 32; ++d2) { const unsigned kw = *(LAS unsigned*)(Ks + i * 64 + 2 * d2); s += q[2 * d2] * __uint_as_float(kw << 16) + q[2 * d2 + 1] * __uint_as_float(kw & 0xffff0000u); }
                s -= slope * fabsf((float)(128 + t - i));
                const float mn = fmaxf(mx, s), sc = __expf(mx - mn), p = __expf(s - mn); l = l * sc + p; mx = mn;
#pragma unroll
                for (int d2 = 0; d2 < 32; ++d2) { const unsigned vw = *(LAS unsigned*)(Vs + i * 64 + 2 * d2);
                    o[2 * d2] = o[2 * d2] * sc + p * __uint_as_float(vw << 16); o[2 * d2 + 1] = o[2 * d2 + 1] * sc + p * __uint_as_float(vw & 0xffff0000u); }
            }
            const float rl = 1.f / l;
#pragma unroll
            for (int ch = 0; ch < 8; ++ch) { u32x4 w; w.x = pk2(o[ch * 8] * rl, o[ch * 8 + 1] * rl); w.y = pk2(o[ch * 8 + 2] * rl, o[ch * 8 + 3] * rl); w.z = pk2(o[ch * 8 + 4] * rl, o[ch * 8 + 5] * rl); w.w = pk2(o[ch * 8 + 6] * rl, o[ch * 8 + 7] * rl);
                *(u32x4*)(qp + ch * 8) = w; }
        }
        __syncthreads();
    }
}

__device__ __forceinline__ void hgrn_simple(Frame& F) {
    const bf16_t* HQ = (const bf16_t*)(F.ws + WS_HQ); const bf16_t* HZ = (const bf16_t*)(F.ws + WS_HZ); const bf16_t* HV = (const bf16_t*)(F.ws + WS_HV); const bf16_t* HG = (const bf16_t*)(F.ws + WS_HG);
    bf16_t* YH = (bf16_t*)(F.ws + WS_YH);
    LAS float* fs = (LAS float*)F.lds; LAS float* ks = fs + 128; LAS float* qs = fs + 256; LAS float* vs = fs + 384; LAS float* op = fs + 512; LAS float* red = fs + 1024;
    const int e = F.tid & 127, dq = F.tid >> 7;
    for (int unit = F.vcu; unit < NMOD * 8; unit += F.G) {
        const int sidx = unit < 32 ? unit >> 3 : 4 + ((unit - 32) >> 3), h = unit & 7;
        const int T = sidx < NBP ? SEQ : DSEQ, rbase = sidx < NBP ? sidx * SEQ : MP + (sidx - NBP) * DSEQ, col = h * 128;
        float S[32];
#pragma unroll
        for (int i = 0; i < 32; ++i) S[i] = sidx < NBP ? 0.f : F.in[IN_ST][((size_t)((sidx - NBP) * 8 + h) * 128 + 32 * dq + i) * 128 + e];
        float lb = 0.f, nw = 0.f;
        if (F.tid < 128) { const float l0 = F.in[IN_LBL][col + F.tid], l1 = F.in[IN_LBL][1024 + col + F.tid]; lb = 1.f / (1.f + __expf(l1 - l0)); nw = F.in[IN_NORMW][col + F.tid]; }
        for (int t = 0; t < T; ++t) {
            const size_t ro = (size_t)(rbase + t) * DM + col;
            if (F.tid < 128) { const float z = bf2f(HZ[ro + F.tid]), sg = 1.f / (1.f + __expf(-z)); fs[F.tid] = lb + (1.f - lb) * sg; ks[F.tid] = (1.f - lb) * (1.f - sg); qs[F.tid] = bf2f(HQ[ro + F.tid]); }
            else if (F.tid < 256) vs[F.tid - 128] = bf2f(HV[ro + F.tid - 128]);
            __syncthreads();
            const float v = vs[e]; float part = 0.f;
#pragma unroll
            for (int i = 0; i < 32; ++i) { const int d = 32 * dq + i; S[i] = fs[d] * S[i] + ks[d] * v; part += S[i] * qs[d]; }
            op[dq * 128 + e] = part;
            __syncthreads();
            float o = 0.f;
            if (F.tid < 128) { o = (op[e] + op[128 + e]) + (op[256 + e] + op[384 + e]); const float ss = wave_sum(o * o); if (F.lane == 0) red[F.wave] = ss; }
            __syncthreads();
            if (F.tid < 128) { const float r = 1.f / sqrtf((red[0] + red[1]) * (1.f / 128.f) + RMS_EPS); YH[ro + e] = (bf16_t)f2bf(o * r * nw * bf2f(HG[ro + e])); }
        }
        float* so = F.out + (sidx < NBP ? OFF_NSP + (size_t)(sidx * 8 + h) * 16384 : OFF_NSS + (size_t)((sidx - NBP) * 8 + h) * 16384);
#pragma unroll
        for (int i = 0; i < 32; ++i) so[(size_t)(32 * dq + i) * 128 + e] = S[i];
        __syncthreads();
    }
}
typedef float f32x16 __attribute__((ext_vector_type(16)));
typedef short s16x4 __attribute__((ext_vector_type(4)));
__device__ __forceinline__ bf16x8 cat8(u32x2 lo, u32x2 hi) { u32x4 w; w.x = lo.x; w.y = lo.y; w.z = hi.x; w.w = hi.y; return __builtin_bit_cast(bf16x8, w); }
__device__ __forceinline__ unsigned cvtpk(float lo, float hi) { return pg8::cvt_pk_bf16(lo, hi); }

constexpr int AL_K = 0, AL_KROW = 144, AL_VT = 192 * 144, AL_VROW = 392, AL_LINV = AL_VT + 64 * AL_VROW, AL_END = AL_LINV + 8 * 32 * 4;
__device__ __forceinline__ void attn_fast(Frame& F) {
    bf16_t* QB = (bf16_t*)(F.ws + WS_QB); const bf16_t* KB = (const bf16_t*)(F.ws + WS_KB); const bf16_t* VB = (const bf16_t*)(F.ws + WS_VB);
    const int lane = F.lane, w = F.wave, r31 = lane & 31, hi = lane >> 5;
    constexpr float LOG2E = 1.4426950408889634f;
    for (int unit = F.vcu; unit < 544 * 2; unit += F.G) {
        const int ci = unit >> 1, j = unit & 1; const bool samp = ci >= 512;
        const int row0 = samp ? MP + (ci - 512) * DSEQ : (ci >> 7) * SEQ + (ci & 127) * 64; const int c = ci & 127;
        const int i0 = samp ? 0 : (128 - c * 64 > 0 ? 128 - c * 64 : 0);
        for (int idx = F.tid; idx < 192 * 8 * 2; idx += 512) { const int kv = idx / (192 * 8), r = idx % (192 * 8), i = r >> 3, ch = r & 7;
            u32x4 wv = (u32x4){0u, 0u, 0u, 0u};
            if (samp && i < 128) { const float* src = F.in[kv ? IN_CV : IN_CK] + ((size_t)((ci - 512) * 128 + i) * 2 + j) * 64 + ch * 8;
                const f32x4 a = *(const f32x4*)src, b = *(const f32x4*)(src + 4); wv.x = pk2(a[0], a[1]); wv.y = pk2(a[2], a[3]); wv.z = pk2(b[0], b[1]); wv.w = pk2(b[2], b[3]); }
            else if (i >= i0) { const size_t krow = (size_t)(row0 - 128 + i); wv = *(const u32x4*)((kv ? VB : KB) + krow * 128 + j * 64 + ch * 8); }
            if (kv == 0) *(LAS u32x4*)(F.lds + AL_K + i * AL_KROW + ch * 16) = wv;
            else { LAS bf16_t* vt = (LAS bf16_t*)(F.lds + AL_VT + (8 * ch) * AL_VROW + i * 2);
                vt[0] = (bf16_t)(wv.x & 0xffffu); vt[AL_VROW / 2] = (bf16_t)(wv.x >> 16); vt[2 * (AL_VROW / 2)] = (bf16_t)(wv.y & 0xffffu); vt[3 * (AL_VROW / 2)] = (bf16_t)(wv.y >> 16);
                vt[4 * (AL_VROW / 2)] = (bf16_t)(wv.z & 0xffffu); vt[5 * (AL_VROW / 2)] = (bf16_t)(wv.z >> 16); vt[6 * (AL_VROW / 2)] = (bf16_t)(wv.w & 0xffffu); vt[7 * (AL_VROW / 2)] = (bf16_t)(wv.w >> 16); } }
        const int g = w >> 1, th = w & 1, hq = 4 * j + g, t = 32 * th + r31;
        bf16_t* qp = QB + (size_t)(row0 + t) * 512 + hq * 64;
        bf16x8 qf[4];
#pragma unroll
        for (int kap = 0; kap < 4; ++kap) qf[kap] = *(const bf16x8*)(qp + 16 * kap + 8 * hi);
        __syncthreads();
        f32x16 st[6];
#pragma unroll
        for (int kt = 0; kt < 6; ++kt) { st[kt] = (f32x16){0.f, 0.f, 0.f, 0.f, 0.f, 0.f, 0.f, 0.f, 0.f, 0.f, 0.f, 0.f, 0.f, 0.f, 0.f, 0.f};
#pragma unroll
            for (int kap = 0; kap < 4; ++kap) { const bf16x8 a = *(const LAS bf16x8*)(F.lds + AL_K + (32 * kt + r31) * AL_KROW + (16 * kap + 8 * hi) * 2);
                st[kt] = __builtin_amdgcn_mfma_f32_32x32x16_bf16(a, qf[kap], st[kt], 0, 0, 0); }
            __builtin_amdgcn_sched_barrier(0); }
        const float slope2 = exp2f(-(float)(hq + 1)) * LOG2E, sink2 = F.in[IN_SINK][hq] * LOG2E;
        float mx = sink2;
        int dbase = 128 + t - 4 * hi, kbase = i0 - 4 * hi; asm volatile("" : "+v"(dbase), "+v"(kbase));
#pragma unroll
        for (int kt = 0; kt < 6; ++kt)
#pragma unroll
            for (int r = 0; r < 16; ++r) { const int kc = 32 * kt + (r & 3) + 8 * (r >> 2);
                float v = st[kt][r] * LOG2E - slope2 * fabsf((float)(dbase - kc)); v = kc < kbase ? -1e30f : v; st[kt][r] = v; mx = fmaxf(mx, v); }
        mx = fmaxf(mx, __shfl_xor(mx, 32));
        __builtin_amdgcn_sched_barrier(0);
        float l = 0.f;
        u32x4 pw[12];
#pragma unroll
        for (int kt = 0; kt < 6; ++kt) {
#pragma unroll
            for (int r = 0; r < 16; ++r) { const float p = __builtin_amdgcn_exp2f(st[kt][r] - mx); st[kt][r] = p; l += p; }
#pragma unroll
            for (int hs = 0; hs < 2; ++hs) { pw[2 * kt + hs].x = cvtpk(st[kt][8 * hs + 0], st[kt][8 * hs + 1]); pw[2 * kt + hs].y = cvtpk(st[kt][8 * hs + 2], st[kt][8 * hs + 3]);
                pw[2 * kt + hs].z = cvtpk(st[kt][8 * hs + 4], st[kt][8 * hs + 5]); pw[2 * kt + hs].w = cvtpk(st[kt][8 * hs + 6], st[kt][8 * hs + 7]); }
            __builtin_amdgcn_sched_barrier(0);
        }
        l += __shfl_xor(l, 32); l += __builtin_amdgcn_exp2f(sink2 - mx);
        LAS float* linv = (LAS float*)(F.lds + AL_LINV) + w * 32;
        if (hi == 0) linv[r31] = 1.0f / l;
        f32x16 o[2];
        o[0] = (f32x16){0.f, 0.f, 0.f, 0.f, 0.f, 0.f, 0.f, 0.f, 0.f, 0.f, 0.f, 0.f, 0.f, 0.f, 0.f, 0.f}; o[1] = o[0];
        __builtin_amdgcn_sched_barrier(0);
#pragma unroll
        for (int s16 = 0; s16 < 12; ++s16) {
            const bf16x8 pa = __builtin_bit_cast(bf16x8, pw[s16]);
#pragma unroll
            for (int dt = 0; dt < 2; ++dt) { const LAS unsigned char* vp = F.lds + AL_VT + (32 * dt + r31) * AL_VROW + (16 * s16 + 4 * hi) * 2;
                const bf16x8 b = cat8(*(const LAS u32x2*)vp, *(const LAS u32x2*)(vp + 16));
                o[dt] = __builtin_amdgcn_mfma_f32_32x32x16_bf16(pa, b, o[dt], 0, 0, 0); }
            if (s16 & 1) __builtin_amdgcn_sched_barrier(0);
        }
        asm volatile("s_waitcnt lgkmcnt(0)" ::: "memory");
        int hio = 4 * hi; asm volatile("" : "+v"(hio));
        bf16_t* op = QB + (size_t)(row0 + 32 * th + hio) * 512 + hq * 64 + r31; const LAS float* lq = linv + hio;
#pragma unroll
        for (int r = 0; r < 16; ++r) { const int qq = (r & 3) + 8 * (r >> 2); const float li = lq[qq];
            op[(size_t)qq * 512] = (bf16_t)f2bf(o[0][r] * li); op[(size_t)qq * 512 + 32] = (bf16_t)f2bf(o[1][r] * li); }
        __syncthreads();
    }
}

constexpr int HL_QE = 0, HL_QROW = 272, HL_KE = 32 * 272, HL_KDT = 2 * 32 * 272, HL_TROW = 80, HL_VT = HL_KDT + 128 * 80, HL_EM = HL_VT + 128 * 80, HL_DEC = HL_EM + 512, HL_PART = HL_DEC + 512,
              HL_O = HL_PART + 4096, HL_OROW = 528, HL_END = HL_O + 32 * 528;
static_assert(HL_END <= RING_BYTES && AL_END <= RING_BYTES, "phase scratch inside the ring region");

struct HgRaw { unsigned z[4], q[4], v[4]; u32x4 hg; };
template <bool FULL>
__device__ __forceinline__ void hgrn_load(Frame& F, size_t rowoff  , HgRaw& R) {
    const bf16_t* HQ = (const bf16_t*)(F.ws + WS_HQ); const bf16_t* HZ = (const bf16_t*)(F.ws + WS_HZ); const bf16_t* HV = (const bf16_t*)(F.ws + WS_HV); const bf16_t* HG = (const bf16_t*)(F.ws + WS_HG);
    const int cp = F.tid & 63, p = F.tid >> 6;
#pragma unroll
    for (int i = 0; i < 4; ++i) { const size_t o = rowoff + (size_t)(4 * p + i) * DM + 2 * cp; R.z[i] = *(const unsigned*)(HZ + o); R.v[i] = *(const unsigned*)(HV + o); if (FULL) R.q[i] = *(const unsigned*)(HQ + o); }
    if (FULL) R.hg = *(const u32x4*)(HG + rowoff + (size_t)(F.tid >> 4) * DM + 8 * (F.tid & 15));
}
template <bool FULL>
__device__ __forceinline__ void hgrn_prep(Frame& F, const HgRaw& R, float lb0, float lb1, float& bt0, float& bt1) {
    const int cp = F.tid & 63, p = F.tid >> 6;
    { u32x2 a, b; a.x = (R.v[0] & 0xffffu) | (R.v[1] << 16); a.y = (R.v[2] & 0xffffu) | (R.v[3] << 16); b.x = (R.v[0] >> 16) | (R.v[1] & 0xffff0000u); b.y = (R.v[2] >> 16) | (R.v[3] & 0xffff0000u);
      *(LAS u32x2*)(F.lds + HL_VT + (2 * cp) * HL_TROW + p * 8) = a; *(LAS u32x2*)(F.lds + HL_VT + (2 * cp + 1) * HL_TROW + p * 8) = b; }
    float kk[2][4], cs[2][4]; float run0 = 0.f, run1 = 0.f;
#pragma unroll
    for (int i = 0; i < 4; ++i) {
        { const float z = __uint_as_float(R.z[i] << 16), ez = __expf(-fmaxf(z, -60.f)), sg = __builtin_amdgcn_rcpf(1.f + ez); kk[0][i] = (1.f - lb0) * (ez * sg); run0 += __logf(lb0 + (1.f - lb0) * sg); cs[0][i] = run0; }
        { const float z = __uint_as_float(R.z[i] & 0xffff0000u), ez = __expf(-fmaxf(z, -60.f)), sg = __builtin_amdgcn_rcpf(1.f + ez); kk[1][i] = (1.f - lb1) * (ez * sg); run1 += __logf(lb1 + (1.f - lb1) * sg); cs[1][i] = run1; }
    }
    typedef float f32x2 __attribute__((ext_vector_type(2)));
    LAS float* part = (LAS float*)(F.lds + HL_PART);
    *(LAS f32x2*)(part + p * 128 + 2 * cp) = (f32x2){run0, run1};
    __syncthreads();
    float pre0 = 0.f, pre1 = 0.f, m0 = 0.f, m1 = 0.f, bl0 = 0.f, bl1 = 0.f;
#pragma unroll
    for (int pp = 0; pp < 8; ++pp) { const f32x2 v = *(const LAS f32x2*)(part + pp * 128 + 2 * cp); if (pp < p) { pre0 += v.x; pre1 += v.y; } if (pp < 4) { m0 += v.x; m1 += v.y; } bl0 += v.x; bl1 += v.y; }
    float kd[2][4];
#pragma unroll
    for (int i = 0; i < 4; ++i) { const float b0 = pre0 + cs[0][i], b1 = pre1 + cs[1][i];
        if (FULL) { const float q0 = __uint_as_float(R.q[i] << 16), q1 = __uint_as_float(R.q[i] & 0xffff0000u);
            *(LAS unsigned*)(F.lds + HL_QE + (4 * p + i) * HL_QROW + cp * 4) = pk2(q0 * __expf(b0 - m0), q1 * __expf(b1 - m1));
            *(LAS unsigned*)(F.lds + HL_KE + (4 * p + i) * HL_QROW + cp * 4) = pk2(kk[0][i] * __expf(m0 - b0), kk[1][i] * __expf(m1 - b1)); }
        kd[0][i] = kk[0][i] * __expf(bl0 - b0); kd[1][i] = kk[1][i] * __expf(bl1 - b1); }
    { u32x2 a, b; a.x = pk2(kd[0][0], kd[0][1]); a.y = pk2(kd[0][2], kd[0][3]); b.x = pk2(kd[1][0], kd[1][1]); b.y = pk2(kd[1][2], kd[1][3]);
      *(LAS u32x2*)(F.lds + HL_KDT + (2 * cp) * HL_TROW + p * 8) = a; *(LAS u32x2*)(F.lds + HL_KDT + (2 * cp + 1) * HL_TROW + p * 8) = b; }
    if (p == 0) { if (FULL) *(LAS f32x2*)(F.lds + HL_EM + cp * 8) = (f32x2){__expf(m0), __expf(m1)}; *(LAS f32x2*)(F.lds + HL_DEC + cp * 8) = (f32x2){__expf(bl0), __expf(bl1)}; bt0 += bl0; bt1 += bl1; }
    __syncthreads();
}
template <bool FULL>
__device__ __forceinline__ void hgrn_mma(Frame& F, f32x4 (&S)[8]) {
    const int lane = F.lane, w = F.wave, r15 = lane & 15, g = lane >> 4;
    const LAS unsigned char* L = F.lds;
    const LAS unsigned char* vrow = L + HL_VT + (16 * w + r15) * HL_TROW;
    const bf16x8 vn = *(const LAS bf16x8*)(vrow + 16 * g);
    if (FULL) {
        bf16x8 qe[2][4], ke[2][4];
#pragma unroll
        for (int tau = 0; tau < 2; ++tau)
#pragma unroll
            for (int kap = 0; kap < 4; ++kap) { const int off = (16 * tau + r15) * HL_QROW + (32 * kap + 4 * g) * 2;
                qe[tau][kap] = cat8(*(const LAS u32x2*)(L + HL_QE + off), *(const LAS u32x2*)(L + HL_QE + off + 32));
                ke[tau][kap] = cat8(*(const LAS u32x2*)(L + HL_KE + off), *(const LAS u32x2*)(L + HL_KE + off + 32)); }
        f32x4 at00 = (f32x4){0.f, 0.f, 0.f, 0.f}, at01 = at00, at11 = at00;
#pragma unroll
        for (int kap = 0; kap < 4; ++kap) { at00 = __builtin_amdgcn_mfma_f32_16x16x32_bf16(ke[0][kap], qe[0][kap], at00, 0, 0, 0);
            at01 = __builtin_amdgcn_mfma_f32_16x16x32_bf16(ke[0][kap], qe[1][kap], at01, 0, 0, 0); at11 = __builtin_amdgcn_mfma_f32_16x16x32_bf16(ke[1][kap], qe[1][kap], at11, 0, 0, 0); }
#pragma unroll
        for (int r = 0; r < 4; ++r) { const bool dead = (4 * g + r) > r15; at00[r] = dead ? 0.f : at00[r]; at11[r] = dead ? 0.f : at11[r]; }
        u32x4 a0, a1; a0.x = cvtpk(at00[0], at00[1]); a0.y = cvtpk(at00[2], at00[3]); a0.z = 0u; a0.w = 0u;
        a1.x = cvtpk(at01[0], at01[1]); a1.y = cvtpk(at01[2], at01[3]); a1.z = cvtpk(at11[0], at11[1]); a1.w = cvtpk(at11[2], at11[3]);
        const bf16x8 vp = cat8(*(const LAS u32x2*)(vrow + 8 * g), *(const LAS u32x2*)(vrow + 32 + 8 * g));
        f32x4 o0 = __builtin_amdgcn_mfma_f32_16x16x32_bf16(__builtin_bit_cast(bf16x8, a0), vp, (f32x4){0.f, 0.f, 0.f, 0.f}, 0, 0, 0);
        f32x4 o1 = __builtin_amdgcn_mfma_f32_16x16x32_bf16(__builtin_bit_cast(bf16x8, a1), vp, (f32x4){0.f, 0.f, 0.f, 0.f}, 0, 0, 0);
#pragma unroll
        for (int kap = 0; kap < 4; ++kap) { const f32x4 e0 = *(const LAS f32x4*)(L + HL_EM + (32 * kap + 4 * g) * 4), e1 = *(const LAS f32x4*)(L + HL_EM + (32 * kap + 16 + 4 * g) * 4);
            const f32x4 s0 = S[2 * kap] * e0, s1 = S[2 * kap + 1] * e1;
            u32x4 sw; sw.x = cvtpk(s0[0], s0[1]); sw.y = cvtpk(s0[2], s0[3]); sw.z = cvtpk(s1[0], s1[1]); sw.w = cvtpk(s1[2], s1[3]); const bf16x8 sp = __builtin_bit_cast(bf16x8, sw);
            o0 = __builtin_amdgcn_mfma_f32_16x16x32_bf16(qe[0][kap], sp, o0, 0, 0, 0); o1 = __builtin_amdgcn_mfma_f32_16x16x32_bf16(qe[1][kap], sp, o1, 0, 0, 0); }
        LAS float* ot = (LAS float*)(F.lds + HL_O) + 16 * w + r15;
#pragma unroll
        for (int r = 0; r < 4; ++r) { ot[(4 * g + r) * (HL_OROW / 4)] = o0[r]; ot[(16 + 4 * g + r) * (HL_OROW / 4)] = o1[r]; }
    }
#pragma unroll
    for (int dl = 0; dl < 8; ++dl) { const f32x4 dc = *(const LAS f32x4*)(L + HL_DEC + (16 * dl + 4 * g) * 4);
        const bf16x8 a = *(const LAS bf16x8*)(L + HL_KDT + (16 * dl + r15) * HL_TROW + 16 * g);
        S[dl] = __builtin_amdgcn_mfma_f32_16x16x32_bf16(a, vn, S[dl] * dc, 0, 0, 0); }
}
__device__ __forceinline__ void hgrn_norm(Frame& F, size_t rowoff, const u32x4 gq, const f32x4 n0, const f32x4 n1) {
    bf16_t* YH = (bf16_t*)(F.ws + WS_YH);
    const int t = F.tid >> 4, sub = F.tid & 15;
    const LAS float* op = (const LAS float*)(F.lds + HL_O + t * HL_OROW) + 8 * sub;
    const f32x4 a = *(const LAS f32x4*)op, b = *(const LAS f32x4*)(op + 4);
    float ss = (a[0] * a[0] + a[1] * a[1]) + (a[2] * a[2] + a[3] * a[3]) + (b[0] * b[0] + b[1] * b[1]) + (b[2] * b[2] + b[3] * b[3]);
    ss += __shfl_xor(ss, 1); ss += __shfl_xor(ss, 2); ss += __shfl_xor(ss, 4); ss += __shfl_xor(ss, 8);
    const float r = 1.f / sqrtf(ss * (1.f / 128.f) + RMS_EPS);
    const size_t o = rowoff + (size_t)t * DM + 8 * sub;
    u32x4 wv;
    wv.x = pk2(a[0] * r * n0[0] * __uint_as_float(gq.x << 16), a[1] * r * n0[1] * __uint_as_float(gq.x & 0xffff0000u));
    wv.y = pk2(a[2] * r * n0[2] * __uint_as_float(gq.y << 16), a[3] * r * n0[3] * __uint_as_float(gq.y & 0xffff0000u));
    wv.z = pk2(b[0] * r * n1[0] * __uint_as_float(gq.z << 16), b[1] * r * n1[1] * __uint_as_float(gq.z & 0xffff0000u));
    wv.w = pk2(b[2] * r * n1[2] * __uint_as_float(gq.w << 16), b[3] * r * n1[3] * __uint_as_float(gq.w & 0xffff0000u));
    *(u32x4*)(YH + o) = wv;
}
__device__ __forceinline__ void hgrn_lb(Frame& F, int h, float& lb0, float& lb1) { const int c = h * 128 + 2 * (F.tid & 63); typedef float f32x2 __attribute__((ext_vector_type(2)));
    const f32x2 l0 = *(const f32x2*)(F.in[IN_LBL] + c), l1 = *(const f32x2*)(F.in[IN_LBL] + 1024 + c); lb0 = 1.f / (1.f + __expf(l1.x - l0.x)); lb1 = 1.f / (1.f + __expf(l1.y - l0.y)); }
__device__ __forceinline__ void hgrn_state_load(Frame& F, const float* base, f32x4 (&S)[8]) {
    const int r15 = F.lane & 15, g = F.lane >> 4; const float* p = base + (size_t)(4 * g) * 128 + 16 * F.wave + r15;
#pragma unroll
    for (int dl = 0; dl < 8; ++dl)
#pragma unroll
        for (int r = 0; r < 4; ++r) S[dl][r] = p[(size_t)(16 * dl + r) * 128];
}
__device__ __forceinline__ void hgrn_state_store(Frame& F, float* base, const f32x4 (&S)[8]) {
    const int r15 = F.lane & 15, g = F.lane >> 4; float* p = base + (size_t)(4 * g) * 128 + 16 * F.wave + r15;
#pragma unroll
    for (int dl = 0; dl < 8; ++dl)
#pragma unroll
        for (int r = 0; r < 4; ++r) p[(size_t)(16 * dl + r) * 128] = S[dl][r];
}
__device__ __forceinline__ void hgrn_pass_a(Frame& F) {
    float* U = (float*)(F.ws + WS_U); float* D = (float*)(F.ws + WS_D);
    HgRaw R;
    if (F.vcu < 128 * 8) hgrn_load<false>(F, (size_t)((F.vcu >> 3) * 256) * DM + (F.vcu & 7) * 128, R);
    for (int unit = F.vcu; unit < 128 * 8; unit += F.G) {
        const int n = unit >> 3, h = unit & 7; float lb0, lb1, bt0 = 0.f, bt1 = 0.f; hgrn_lb(F, h, lb0, lb1);
        f32x4 S[8];
#pragma unroll
        for (int dl = 0; dl < 8; ++dl) S[dl] = (f32x4){0.f, 0.f, 0.f, 0.f};
        for (int blk = 0; blk < 8; ++blk) {
            hgrn_prep<false>(F, R, lb0, lb1, bt0, bt1);
            if (blk < 7) hgrn_load<false>(F, (size_t)(n * 256 + (blk + 1) * 32) * DM + h * 128, R);
            else if (unit + F.G < 128 * 8) hgrn_load<false>(F, (size_t)(((unit + F.G) >> 3) * 256) * DM + ((unit + F.G) & 7) * 128, R);
            hgrn_mma<false>(F, S); __syncthreads(); }
        hgrn_state_store(F, U + (size_t)unit * 16384, S);
        if (F.tid < 64) { typedef float f32x2 __attribute__((ext_vector_type(2))); *(f32x2*)(D + unit * 128 + 2 * F.tid) = (f32x2){__expf(bt0), __expf(bt1)}; }
    }
}
__device__ __forceinline__ void hgrn_scan(Frame& F) {
    float* U = (float*)(F.ws + WS_U); const float* D = (const float*)(F.ws + WS_D);
    for (int gid = F.vcu * 512 + F.tid; gid < NBP * 8 * 128 * 32; gid += F.G * 512) {
        const int e4 = gid & 31, d = (gid >> 5) & 127, h = (gid >> 12) & 7, b = gid >> 15;
        f32x4 S = (f32x4){0.f, 0.f, 0.f, 0.f};
        for (int n0 = 0; n0 < 32; n0 += 8) {
            f32x4 u[8]; float dc[8];
#pragma unroll
            for (int i = 0; i < 8; ++i) { const size_t unit = (size_t)((b * 32 + n0 + i) * 8 + h); u[i] = *(const f32x4*)(U + unit * 16384 + d * 128 + e4 * 4); dc[i] = D[unit * 128 + d]; }
#pragma unroll
            for (int i = 0; i < 8; ++i) { const size_t unit = (size_t)((b * 32 + n0 + i) * 8 + h); *(f32x4*)(U + unit * 16384 + d * 128 + e4 * 4) = S; S = S * dc[i] + u[i]; }
        }
        *(f32x4*)(F.out + OFF_NSP + (size_t)(b * 8 + h) * 16384 + d * 128 + e4 * 4) = S;
    }
}
__device__ __forceinline__ size_t hgrn_b_rowoff(int unit) { const bool samp = unit >= 1024; const int su = unit - 1024; return (samp ? (size_t)MP + (size_t)(su >> 3) * DSEQ : (size_t)(unit >> 3) * 256) * DM + (unit & 7) * 128; }
__device__ __forceinline__ void hgrn_pass_b(Frame& F) {
    const float* U = (const float*)(F.ws + WS_U);
    constexpr int NU = 128 * 8 + NBS * 8;
    HgRaw R;
    if (F.vcu < NU) hgrn_load<true>(F, hgrn_b_rowoff(F.vcu), R);
    for (int unit = F.vcu; unit < NU; unit += F.G) {
        const bool samp = unit >= 1024; const int su = unit - 1024;
        const int h = unit & 7, nblk = samp ? 2 : 8; const size_t ro0 = hgrn_b_rowoff(unit);
        float lb0, lb1, bt0 = 0.f, bt1 = 0.f; hgrn_lb(F, h, lb0, lb1);
        const f32x4 n0 = *(const f32x4*)(F.in[IN_NORMW] + h * 128 + 8 * (F.tid & 15)), n1 = *(const f32x4*)(F.in[IN_NORMW] + h * 128 + 8 * (F.tid & 15) + 4);
        f32x4 S[8];
        hgrn_state_load(F, samp ? F.in[IN_ST] + (size_t)su * 16384 : U + (size_t)unit * 16384, S);
        for (int blk = 0; blk < nblk; ++blk) { const size_t ro = ro0 + (size_t)(blk * 32) * DM;
            hgrn_prep<true>(F, R, lb0, lb1, bt0, bt1);
            const u32x4 hgc = R.hg;
            if (blk + 1 < nblk) hgrn_load<true>(F, ro + (size_t)32 * DM, R);
            else if (unit + F.G < NU) hgrn_load<true>(F, hgrn_b_rowoff(unit + F.G), R);
            hgrn_mma<true>(F, S); __syncthreads(); hgrn_norm(F, ro, hgc, n0, n1); }
        if (samp) hgrn_state_store(F, F.out + OFF_NSS + (size_t)su * 16384, S);
        __syncthreads();
    }
}
#ifndef DUP_PHASE
#define DUP_PHASE -1
#endif
#define REP(k) for (int rep_ = 0; rep_ < ((k) == DUP_PHASE ? 2 : 1); ++rep_)
struct Args { const float* in[22]; float* out; unsigned char* ws; int ph_lo, ph_hi; };
__global__ void __launch_bounds__(NWAVES * 64, 2) fwd(Args args) {
    extern __shared__ __attribute__((aligned(16))) unsigned char lds[];
    Frame F;
    F.lds = (LAS unsigned char*)lds;
    F.tid = threadIdx.x; F.lane = F.tid & 63; F.wave = __builtin_amdgcn_readfirstlane(F.tid >> 6);
    F.G = gridDim.x; { const int bx = blockIdx.x; F.vcu = (F.G % 8 == 0) ? (bx % 8) * (F.G / 8) + bx / 8 : bx; }
#pragma unroll
    for (int i = 0; i < 22; ++i) F.in[i] = args.in[i];
    F.out = args.out; F.ws = args.ws;
    cooperative_groups::grid_group grid = cooperative_groups::this_grid();
    const int lo = args.ph_lo, hi = args.ph_hi;
    for (int u = F.tid; u < (LDS_BYTES - LDSCTL_OFF) / 4; u += NWAVES * 64) ((LAS unsigned*)(F.lds + LDSCTL_OFF))[u] = 0u;
    __syncthreads();
    XcdBarrier bar; bar.bar = (unsigned*)(args.ws + WS_CTL) + CW_BAR; bar.x = 0; bar.st = nullptr;
#if MK_N_LAUNCHES == 1
    bar = xcd_barrier_post((unsigned*)(args.ws + WS_CTL) + CW_BAR, (volatile LAS unsigned*)(F.lds + MISC_OFF) + 8);
#endif
#define IN(k) (lo <= (k) && (k) < hi)
#define SEAM(k) do { if (IN(k) && IN((k) + 1)) { if ((k) == 0) grid.sync(); else xcd_barrier(bar); } } while (0)
    unsigned char* ws = args.ws;
    bf16_t* H = (bf16_t*)(ws + WS_H);

    if (IN(0)) { p0_prologue(F); }
    SEAM(0);
    if (IN(1)) REP(1) { p1_ln_mod(F); }
    SEAM(1);
    if (IN(2)) REP(2) {
        pg8::Gemm g{H, (const bf16_t*)(ws + WS_WIN), M, INW, DM}; pg8::StaticOrder S; S.init(M, INW, F.G, (int)blockIdx.x);
        pg8::EpiProj E{(bf16_t*)(ws + WS_QB), (bf16_t*)(ws + WS_KB), (bf16_t*)(ws + WS_VB), (bf16_t*)(ws + WS_HQ), (bf16_t*)(ws + WS_HZ), (bf16_t*)(ws + WS_HV), (bf16_t*)(ws + WS_HG), (bf16_t*)F.out, F.out};
        pg8::gemm_phase<pg8::EpiProj, pg8::StaticOrder, true, true>(F.lds, g, S, E);
    }
    SEAM(2);
    if (IN(3)) {
#if ATTN_IMPL
        attn_fast(F);
#else
        attn_simple(F);
#endif
#if HGRN_IMPL
        REP(3) hgrn_pass_a(F);
#else
        hgrn_simple(F);
#endif
    }
    SEAM(3);
#if HGRN_IMPL
    if (IN(4)) { hgrn_scan(F); }
    SEAM(4);
    if (IN(5)) REP(5) { hgrn_pass_b(F); }
    SEAM(5);
#endif
    if (IN(6)) REP(6) {
        { pg8::Gemm g{(const bf16_t*)(ws + WS_QB), (const bf16_t*)(ws + WS_WBA), M, DM, 512}; pg8::StaticOrder S; S.init(M, DM, F.G, (int)blockIdx.x);
          pg8::EpiMerge<true> E{(const bf16_t*)F.out, nullptr, (bf16_t*)(ws + WS_T1)};
          pg8::gemm_phase<pg8::EpiMerge<true>, pg8::StaticOrder, true, true>(F.lds, g, S, E); }
        __syncthreads();
        { pg8::Gemm g{(const bf16_t*)(ws + WS_YH), (const bf16_t*)(ws + WS_WBH), M, DM, DM}; pg8::StaticOrder S; S.init(M, DM, F.G, (int)blockIdx.x);
          pg8::EpiMerge<false> E{(const bf16_t*)F.out, (const bf16_t*)(ws + WS_T1), (bf16_t*)(ws + WS_MERGED)};
          pg8::gemm_phase<pg8::EpiMerge<false>, pg8::StaticOrder, true, true>(F.lds, g, S, E); }
    }
    SEAM(6);
    if (IN(7)) REP(7) {
        pg8::Gemm g{(const bf16_t*)(ws + WS_MERGED), (const bf16_t*)(ws + WS_WOUT), M, DM, DM}; pg8::StaticOrder S; S.init(M, DM, F.G, (int)blockIdx.x);
        pg8::EpiResid E{F.in[IN_XP], F.in[IN_XS], (const float*)(ws + WS_MOD) + 2048, (float*)(ws + WS_Z1), ALPHA};
        pg8::gemm_phase<pg8::EpiResid, pg8::StaticOrder, true, true>(F.lds, g, S, E);
    }
    SEAM(7);
    if (IN(8)) REP(8) { p8_ln_mix(F); }
    SEAM(8);
    if (IN(9)) REP(9) {
        pg8::Gemm g{H, (const bf16_t*)(ws + WS_WUP), M, 2 * DFF, DM}; pg8::StaticOrder S; S.init(M, 2 * DFF, F.G, (int)blockIdx.x);
        pg8::EpiSwiGLU E{(bf16_t*)(ws + WS_ACT)};
        pg8::gemm_phase<pg8::EpiSwiGLU, pg8::StaticOrder, true, true>(F.lds, g, S, E);
    }
    SEAM(9);
    if (IN(10)) REP(10) {
        pg8::Gemm g{(const bf16_t*)(ws + WS_ACT), (const bf16_t*)(ws + WS_WDN), M, DM, DFF}; pg8::StaticOrder S; S.init(M, DM, F.G, (int)blockIdx.x);
        const float* X1 = (const float*)(ws + WS_X1);
        pg8::EpiResid E{X1, X1 + (size_t)MP * DM, (const float*)(ws + WS_MOD) + 5120, F.out, ALPHA};
        pg8::gemm_phase<pg8::EpiResid, pg8::StaticOrder, true, true>(F.lds, g, S, E);
    }
    SEAM(10);
    if (IN(11)) { p11_ln_out(F); }
#undef IN
#undef SEAM
}

extern "C" void kernel_launch(void* const* d_in, const int* in_sizes, int n_in, void* d_out, int out_size, void* d_ws, size_t ws_size, hipStream_t stream) {
    static int grid = 0;
    if (grid == 0) {
        if (n_in != 22 || out_size != 41549824 || ws_size < WS_END) { fprintf(stderr, "kernel_launch: unexpected problem (n_in %d, out %d, ws %zu)\n", n_in, out_size, ws_size); grid = -1; return; }
        int dev = 0, cus = 0, per_cu = 0;
        if (hipGetDevice(&dev) != hipSuccess || hipDeviceGetAttribute(&cus, hipDeviceAttributeMultiprocessorCount, dev) != hipSuccess) { grid = -1; return; }
        if (hipFuncSetAttribute((const void*)fwd, hipFuncAttributeMaxDynamicSharedMemorySize, LDS_BYTES) != hipSuccess) { fprintf(stderr, "kernel_launch: hipFuncSetAttribute failed\n"); grid = -1; return; }
        if (hipOccupancyMaxActiveBlocksPerMultiprocessor(&per_cu, (const void*)fwd, NWAVES * 64, LDS_BYTES) != hipSuccess || per_cu < 1) { fprintf(stderr, "kernel_launch: occupancy query says %d\n", per_cu); (void)hipGetLastError(); grid = -1; return; }
        grid = cus;
    }
    if (grid < 0) return;
    (void)hipMemsetAsync((char*)d_ws + WS_CTL, 0, CTL_ZERO_BYTES, stream);
    Args a{};
    for (int i = 0; i < 22; ++i) a.in[i] = (const float*)d_in[i];
    a.out = (float*)d_out; a.ws = (unsigned char*)d_ws;
#if MK_N_LAUNCHES == 1
    a.ph_lo = 0; a.ph_hi = N_PHASES;
    void* kargs[] = {&a};
    hipError_t e = hipLaunchCooperativeKernel((const void*)fwd, dim3(grid), dim3(NWAVES * 64), kargs, LDS_BYTES, stream);
    if (e != hipSuccess) fprintf(stderr, "kernel_launch: cooperative launch failed: %s\n", hipGetErrorString(e));
#else
    for (int p = 0; p < N_PHASES; ++p) {
        if (p == 4 || p == 5) { if (!HGRN_IMPL) continue; }
        a.ph_lo = p; a.ph_hi = p + 1;
        hipLaunchKernelGGL(fwd, dim3(grid), dim3(NWAVES * 64), LDS_BYTES, stream, a);
    }
#endif
}
```

```cpp
#define MK_N_LAUNCHES 1
#define ATTN_IMPL 1
#define HGRN_IMPL 1
#include <hip/hip_runtime.h>
#include <hip/hip_cooperative_groups.h>
#include <cstdio>
#include <cstdint>
namespace pg8 {
#define PG8_LAS __attribute__((address_space(3)))
typedef unsigned short bf16_t;
typedef short bf16x8 __attribute__((ext_vector_type(8)));
typedef float f32x4 __attribute__((ext_vector_type(4)));
typedef unsigned u32x4 __attribute__((ext_vector_type(4)));
constexpr int BM = 256, BK = 64, HALF = 128, HTB = HALF * BK * 2  , STAGE_BYTES = 8 * HTB, NXCD = 8, WGM = 8;

__host__ __device__ __forceinline__ int lds_byte(int r, int c) { const int st = (r >> 4) * 2 + (c >> 5), rr = r & 15, cc = c & 31, ob = rr * 64 + cc * 2; return st * 1024 + (ob ^ (((ob >> 9) & 1) << 5)); }
__host__ __device__ __forceinline__ void stage_rc(int b, int& R, int& C) { const int st = b / 1024, sb = b % 1024, swz = sb ^ (((sb >> 9) & 1) << 5); R = (st >> 1) * 16 + swz / 64; C = (st & 1) * 32 + (swz % 64) / 2; }
__host__ __device__ __forceinline__ int perm32(int rho) { const int n = rho >> 4, i = rho & 15; return 8 * (i >> 2) + 4 * n + (i & 3); }

struct Unit { int pm, pn; };
struct Gemm { const bf16_t* A; const bf16_t* Bt; int M, N, K; };

struct StaticOrder {
    int nM, nN, nwg, G, c;
    __host__ __device__ void init(int M, int N, int G_, int c_) { nM = M / BM; nN = N / BM; nwg = nM * nN; G = G_; c = c_; }
    __host__ __device__ bool next(int i, Unit& u) const {
        const long L = (long)i * G + c; if (L >= nwg) return false;
        int wgid = (int)L; { const int q = nwg / NXCD, r = nwg % NXCD, xcd = wgid % NXCD, off = wgid / NXCD; wgid = (xcd < r ? xcd * (q + 1) : r * (q + 1) + (xcd - r) * q) + off; }
        const int nig = WGM * nN, gid = wgid / nig, fm = gid * WGM, gsz = (nM - fm) < WGM ? (nM - fm) : WGM;
        u.pm = fm + ((wgid % nig) % gsz); u.pn = (wgid % nig) / gsz; return true;
    }
    __device__ __forceinline__ void a_ready(const Unit&) const {}
    __device__ __forceinline__ void done(const Unit&) const {}
};

__device__ __forceinline__ unsigned cvt_pk_bf16(float lo, float hi) { unsigned r; asm volatile("v_cvt_pk_bf16_f32 %0, %1, %2" : "=v"(r) : "v"(lo), "v"(hi)); return r; }
typedef float f32x2 __attribute__((ext_vector_type(2)));
__device__ __forceinline__ float bf2f(unsigned short b) { return __uint_as_float(((unsigned)b) << 16); }
__device__ __forceinline__ float fsigmoid(float x) { return __builtin_amdgcn_rcpf(1.0f + __expf(-x)); }
__device__ __forceinline__ float fsilu(float x) { return x * fsigmoid(x); }
__device__ __forceinline__ int mod_row(int row) { return row < 32768 ? (row >> 13) : 4 + ((row - 32768) >> 6); }
constexpr int OFF_NKP = 35651584, OFF_NVP = 35717120, OFF_NSP = 35782656, OFF_NKS = 36306944, OFF_NVS = 36831232, OFF_NSS = 37355520;

struct EpiProj {
    static constexpr bool PERM = true, AFTER_DRAIN = false;
    bf16_t *QB, *KB, *VB, *HQ, *HZ, *HV, *HG, *GT; float* dout;
    __device__ __forceinline__ void operator()(const f32x4 (&acc)[2][2][4][2], const Unit& u, int wr, int wc, int fr, int fq) const {
        const int pn = u.pn, row0 = u.pm * BM + wr * 64 + fr, cl = wc * 32 + 8 * fq;
        if (pn == 2) {
#pragma unroll
            for (int ai = 0; ai < 2; ++ai)
#pragma unroll
                for (int m = 0; m < 4; ++m) { const int row = row0 + ai * HALF + m * 16;
                    float* wdst = nullptr;
                    if (row < 32768) { const int t = row & 8191; if (t >= 8064) wdst = dout + OFF_NKP + (size_t)(((row >> 13) * 128 + (t - 8064)) * 128 + cl); }
                    else { const int r2 = row - 32768; wdst = dout + OFF_NKS + (size_t)(((r2 >> 6) * 128 + 64 + (r2 & 63)) * 128 + cl); }
#pragma unroll
                    for (int bj = 0; bj < 2; ++bj) { const f32x4 v0 = acc[ai][bj][m][0], v1 = acc[ai][bj][m][1];
                        u32x4 w; w.x = cvt_pk_bf16(v0[0], v0[1]); w.y = cvt_pk_bf16(v0[2], v0[3]); w.z = cvt_pk_bf16(v1[0], v1[1]); w.w = cvt_pk_bf16(v1[2], v1[3]);
                        *(u32x4*)((bj == 0 ? KB : VB) + (size_t)row * 128 + cl) = w;
                        if (wdst) { float* d = wdst + (bj == 0 ? 0 : (row < 32768 ? (OFF_NVP - OFF_NKP) : (OFF_NVS - OFF_NKS))); *(f32x4*)d = v0; *(f32x4*)(d + 4) = v1; } } }
            return;
        }
        int mode; bf16_t* base; int ldc, cb;
        if (pn < 2)       { mode = 0; base = QB; ldc = 512;  cb = pn * 256; }
        else if (pn < 7)  { mode = 1; base = HQ; ldc = 1024; cb = (pn - 3) * 256; }
        else if (pn < 11) { mode = 3; base = HZ; ldc = 1024; cb = (pn - 7) * 256; }
        else if (pn < 15) { mode = 3; base = HV; ldc = 1024; cb = (pn - 11) * 256; }
        else if (pn < 19) { mode = 1; base = HG; ldc = 1024; cb = (pn - 15) * 256; }
        else              { mode = 2; base = GT; ldc = 2048; cb = (pn - 19) * 256; }
#pragma unroll
        for (int ai = 0; ai < 2; ++ai)
#pragma unroll
            for (int m = 0; m < 4; ++m) { bf16_t* rowp = base + (size_t)(row0 + ai * HALF + m * 16) * ldc + cb + cl;
#pragma unroll
                for (int bj = 0; bj < 2; ++bj) { f32x4 v0 = acc[ai][bj][m][0], v1 = acc[ai][bj][m][1];
                    if (mode == 0) { v0 = v0 * 0.125f; v1 = v1 * 0.125f; }
                    else if (mode == 1) {
#pragma unroll
                        for (int i = 0; i < 4; ++i) { v0[i] = fsilu(v0[i]); v1[i] = fsilu(v1[i]); } }
                    else if (mode == 2) {
#pragma unroll
                        for (int i = 0; i < 4; ++i) { v0[i] = fsigmoid(v0[i]); v1[i] = fsigmoid(v1[i]); } }
                    u32x4 w; w.x = cvt_pk_bf16(v0[0], v0[1]); w.y = cvt_pk_bf16(v0[2], v0[3]); w.z = cvt_pk_bf16(v1[0], v1[1]); w.w = cvt_pk_bf16(v1[2], v1[3]);
                    *(u32x4*)(rowp + bj * HALF) = w; } }
    }
};
struct EpiSwiGLU {
    static constexpr bool PERM = true, AFTER_DRAIN = false;
    bf16_t* O;
    __device__ __forceinline__ void operator()(const f32x4 (&acc)[2][2][4][2], const Unit& u, int wr, int wc, int fr, int fq) const {
        const int row0 = u.pm * BM + wr * 64 + fr, col = u.pn * 128 + wc * 32 + 8 * fq;
#pragma unroll
        for (int ai = 0; ai < 2; ++ai)
#pragma unroll
            for (int m = 0; m < 4; ++m) { f32x4 v0, v1;
#pragma unroll
                for (int i = 0; i < 4; ++i) { v0[i] = fsilu(acc[ai][1][m][0][i]) * acc[ai][0][m][0][i]; v1[i] = fsilu(acc[ai][1][m][1][i]) * acc[ai][0][m][1][i]; }
                u32x4 w; w.x = cvt_pk_bf16(v0[0], v0[1]); w.y = cvt_pk_bf16(v0[2], v0[3]); w.z = cvt_pk_bf16(v1[0], v1[1]); w.w = cvt_pk_bf16(v1[2], v1[3]);
                *(u32x4*)(O + (size_t)(row0 + ai * HALF + m * 16) * 2816 + col) = w; }
    }
};
template <bool FIRST> struct EpiMerge {
    static constexpr bool PERM = true, AFTER_DRAIN = false;
    const bf16_t* GT; const bf16_t* T1in; bf16_t* O;
    __device__ __forceinline__ void operator()(const f32x4 (&acc)[2][2][4][2], const Unit& u, int wr, int wc, int fr, int fq) const {
        const int row0 = u.pm * BM + wr * 64 + fr, col0 = u.pn * BM + wc * 32 + 8 * fq;
#pragma unroll
        for (int ai = 0; ai < 2; ++ai)
#pragma unroll
            for (int m = 0; m < 4; ++m) { const size_t row = (size_t)(row0 + ai * HALF + m * 16);
#pragma unroll
                for (int bj = 0; bj < 2; ++bj) { const int col = col0 + bj * HALF;
                    const u32x4 g = *(const u32x4*)(GT + row * 2048 + (FIRST ? 0 : 1024) + col);
                    f32x4 v0 = acc[ai][bj][m][0], v1 = acc[ai][bj][m][1];
                    v0[0] *= __uint_as_float(g.x << 16); v0[1] *= __uint_as_float(g.x & 0xffff0000u); v0[2] *= __uint_as_float(g.y << 16); v0[3] *= __uint_as_float(g.y & 0xffff0000u);
                    v1[0] *= __uint_as_float(g.z << 16); v1[1] *= __uint_as_float(g.z & 0xffff0000u); v1[2] *= __uint_as_float(g.w << 16); v1[3] *= __uint_as_float(g.w & 0xffff0000u);
                    if (!FIRST) { const u32x4 t = *(const u32x4*)(T1in + row * 1024 + col);
                        v0[0] += __uint_as_float(t.x << 16); v0[1] += __uint_as_float(t.x & 0xffff0000u); v0[2] += __uint_as_float(t.y << 16); v0[3] += __uint_as_float(t.y & 0xffff0000u);
                        v1[0] += __uint_as_float(t.z << 16); v1[1] += __uint_as_float(t.z & 0xffff0000u); v1[2] += __uint_as_float(t.w << 16); v1[3] += __uint_as_float(t.w & 0xffff0000u); }
                    u32x4 w; w.x = cvt_pk_bf16(v0[0], v0[1]); w.y = cvt_pk_bf16(v0[2], v0[3]); w.z = cvt_pk_bf16(v1[0], v1[1]); w.w = cvt_pk_bf16(v1[2], v1[3]);
                    *(u32x4*)(O + row * 1024 + col) = w; } }
    }
};
struct EpiResid {
    static constexpr bool PERM = false, AFTER_DRAIN = false;
    const float* xa; const float* xb; const float* gate;
    float* out; float alpha;
    __device__ __forceinline__ void operator()(const f32x4 (&acc)[2][2][4][2], const Unit& u, int wr, int wc, int fr, int fq) const {
        const int row0 = u.pm * BM + wr * 64 + fr, col0 = u.pn * BM + wc * 32 + 4 * fq;
#pragma unroll
        for (int ai = 0; ai < 2; ++ai)
#pragma unroll
            for (int m = 0; m < 4; ++m) { const int row = row0 + ai * HALF + m * 16;
                const float* xr = row < 32768 ? xa + (size_t)row * 1024 : xb + (size_t)(row - 32768) * 1024;
                const float* gr = gate + (size_t)mod_row(row) * 6144; float* orow = out + (size_t)row * 1024;
#pragma unroll
                for (int bj = 0; bj < 2; ++bj)
#pragma unroll
                    for (int n = 0; n < 2; ++n) { const int c = col0 + bj * HALF + n * 16;
                        const f32x4 xv = *(const f32x4*)(xr + c), gv = *(const f32x4*)(gr + c);
                        *(f32x4*)(orow + c) = xv * alpha + gv * acc[ai][bj][m][n]; } }
    }
};
template <class Epi, class Sched, bool ALIGN_EPI = false, bool SP2 = false>
__device__ __forceinline__ void gemm_phase(PG8_LAS unsigned char* lds, const Gemm g, const Sched& S, const Epi& E) {
    const int tid = threadIdx.x, wid = __builtin_amdgcn_readfirstlane(tid >> 6), lane = tid & 63, wr = wid >> 2, wc = wid & 3, fr = lane & 15, fq = lane >> 4;
    const int K = g.K, nt = K / BK;
    unsigned voffA[2], voffB[2];
#pragma unroll
    for (int i = 0; i < 2; ++i) { int R, C; stage_rc(tid * 16 + i * 8192, R, C); const int Rb = Epi::PERM ? ((R & ~31) + perm32(R & 31)) : R;
        voffA[i] = (unsigned)(R * K + C) * 2u; voffB[i] = (unsigned)(Rb * K + C) * 2u; }
    const size_t kstep = (size_t)(BK * 2);
    const size_t hstep = (size_t)HALF * K * 2;
    const size_t tstep = 2 * hstep;
    const unsigned ldsw = (unsigned)wid * 1024u;
    const int aoff = lds_byte(wr * 64 + fr, fq * 8), boff = lds_byte(wc * 32 + fr, fq * 8);
#define PG8_SA(b, h) (((b) * 2 + (h)) * HTB)
#define PG8_SB(b, h) ((4 + (b) * 2 + (h)) * HTB)
#define PG8_STAGE(bufoff, gbase, voff) do { _Pragma("unroll") for (int _i = 0; _i < 2; ++_i) \
        __builtin_amdgcn_global_load_lds((const unsigned*)((const char*)(gbase) + (voff)[_i]), (PG8_LAS unsigned*)(lds + (bufoff) + ldsw + _i * 8192), 16, 0, 0); } while (0)
#define PG8_LDA(dst, b, h) do { _Pragma("unroll") for (int m = 0; m < 4; ++m) _Pragma("unroll") for (int k = 0; k < 2; ++k) dst[m][k] = *(const PG8_LAS bf16x8*)(lds + PG8_SA(b, h) + aoff + m * 2048 + k * 1024); } while (0)
#define PG8_LDB(dst, b, h) do { _Pragma("unroll") for (int n = 0; n < 2; ++n) _Pragma("unroll") for (int k = 0; k < 2; ++k) dst[n][k] = *(const PG8_LAS bf16x8*)(lds + PG8_SB(b, h) + boff + n * 2048 + k * 1024); } while (0)
#define PG8_MMA(ai, bj, At, Bt) do { __builtin_amdgcn_s_setprio(1); _Pragma("unroll") for (int m = 0; m < 4; ++m) _Pragma("unroll") for (int n = 0; n < 2; ++n) _Pragma("unroll") for (int k = 0; k < 2; ++k) \
        acc[ai][bj][m][n] = __builtin_amdgcn_mfma_f32_16x16x32_bf16(Bt[n][k], At[m][k], acc[ai][bj][m][n], 0, 0, 0); __builtin_amdgcn_s_setprio(0); } while (0)
#define PG8_WAIT_V(n) asm volatile("s_waitcnt vmcnt(" #n ")" ::: "memory")
#define PG8_WAIT_L(n) asm volatile("s_waitcnt lgkmcnt(" #n ")" ::: "memory")
#define PG8_BAR __builtin_amdgcn_s_barrier()
#define PG8_SCHED __builtin_amdgcn_sched_barrier(0)
    Unit cur, nxt; int ui = 0;
    if (!S.next(0, cur)) return;
    f32x4 acc[2][2][4][2];
#pragma unroll
    for (int a = 0; a < 2; ++a)
#pragma unroll
        for (int b = 0; b < 2; ++b)
#pragma unroll
            for (int m = 0; m < 4; ++m)
#pragma unroll
                for (int n = 0; n < 2; ++n) acc[a][b][m][n] = (f32x4){0.f, 0.f, 0.f, 0.f};
    bf16x8 At[4][2], B0[2][2], B1[2][2];
    const char* cA = (const char*)g.A + (size_t)cur.pm * tstep; const char* cB = (const char*)g.Bt + (size_t)cur.pn * tstep;
    S.a_ready(cur);
    if constexpr (SP2) {
        PG8_STAGE(PG8_SB(0, 0), cB, voffB); PG8_STAGE(PG8_SB(0, 1), cB + hstep, voffB); PG8_STAGE(PG8_SA(0, 0), cA, voffA); PG8_STAGE(PG8_SA(0, 1), cA + hstep, voffA);
        if (wr == 1) PG8_BAR;
        PG8_WAIT_V(2); PG8_BAR;
        PG8_STAGE(PG8_SB(1, 0), cB + kstep, voffB); PG8_STAGE(PG8_SA(1, 0), cA + kstep, voffA); PG8_STAGE(PG8_SB(1, 1), cB + hstep + kstep, voffB);
        PG8_WAIT_V(6); PG8_BAR;
    } else {
        PG8_STAGE(PG8_SB(0, 0), cB, voffB); PG8_STAGE(PG8_SA(0, 0), cA, voffA); PG8_STAGE(PG8_SB(0, 1), cB + hstep, voffB); PG8_STAGE(PG8_SA(0, 1), cA + hstep, voffA);
        if (wr == 1) PG8_BAR;
        PG8_WAIT_V(4); PG8_BAR;
        PG8_STAGE(PG8_SB(1, 0), cB + kstep, voffB); PG8_STAGE(PG8_SA(1, 0), cA + kstep, voffA); PG8_STAGE(PG8_SB(1, 1), cB + hstep + kstep, voffB);
        PG8_WAIT_V(6); PG8_BAR;
    }
    for (;;) {
        const bool has_next = S.next(ui + 1, nxt);
        const char* nA = has_next ? (const char*)g.A + (size_t)nxt.pm * tstep : cA; const char* nB = has_next ? (const char*)g.Bt + (size_t)nxt.pn * tstep : cB;
        for (int t = 0; t < nt; t += 2) {
            const bool last = (t == nt - 2);
            const char* a1 = cA + (size_t)(t + 1) * kstep;
            const char* a2 = last ? nA : cA + (size_t)(t + 2) * kstep; const char* b2 = last ? nB : cB + (size_t)(t + 2) * kstep;
            const char* a3 = a2 + kstep; const char* b3 = b2 + kstep;
            if (last && has_next) S.a_ready(nxt);
            if constexpr (SP2) {
            PG8_LDB(B0, 0, 0); PG8_LDB(B1, 0, 1); PG8_SCHED; PG8_LDA(At, 0, 0); PG8_STAGE(PG8_SA(1, 1), a1 + hstep, voffA);
            PG8_WAIT_V(8); PG8_WAIT_L(0); PG8_BAR; PG8_MMA(0, 0, At, B0); PG8_MMA(0, 1, At, B1); PG8_BAR; PG8_SCHED;
            PG8_LDA(At, 0, 1); PG8_STAGE(PG8_SB(0, 0), b2, voffB); PG8_STAGE(PG8_SB(0, 1), b2 + hstep, voffB); PG8_STAGE(PG8_SA(0, 0), a2, voffA);
            PG8_WAIT_V(8); PG8_WAIT_L(0); PG8_BAR; PG8_MMA(1, 0, At, B0); PG8_MMA(1, 1, At, B1); PG8_BAR; PG8_SCHED;
            PG8_LDB(B0, 1, 0); PG8_LDB(B1, 1, 1); PG8_SCHED; PG8_LDA(At, 1, 0); PG8_STAGE(PG8_SA(0, 1), a2 + hstep, voffA);
            PG8_WAIT_V(8); PG8_WAIT_L(0); PG8_BAR; PG8_MMA(0, 0, At, B0); PG8_MMA(0, 1, At, B1); PG8_BAR; PG8_SCHED;
            PG8_LDA(At, 1, 1); PG8_STAGE(PG8_SB(1, 0), b3, voffB); PG8_STAGE(PG8_SB(1, 1), b3 + hstep, voffB); PG8_STAGE(PG8_SA(1, 0), a3, voffA);
            PG8_WAIT_V(8); PG8_WAIT_L(0); PG8_BAR; PG8_MMA(1, 0, At, B0); PG8_MMA(1, 1, At, B1); PG8_BAR; PG8_SCHED;
            } else {
            PG8_LDB(B0, 0, 0); PG8_SCHED; PG8_LDA(At, 0, 0); PG8_STAGE(PG8_SA(1, 1), a1 + hstep, voffA);
            PG8_WAIT_L(8); PG8_BAR; PG8_WAIT_L(0); PG8_MMA(0, 0, At, B0); PG8_BAR; PG8_SCHED;
            PG8_LDB(B1, 0, 1); PG8_STAGE(PG8_SB(0, 0), b2, voffB);
            PG8_BAR; PG8_WAIT_L(0); PG8_MMA(0, 1, At, B1); PG8_BAR;
            PG8_LDA(At, 0, 1); PG8_STAGE(PG8_SA(0, 0), a2, voffA);
            PG8_BAR; PG8_WAIT_L(0); PG8_MMA(1, 0, At, B0); PG8_BAR; PG8_SCHED;
            PG8_STAGE(PG8_SB(0, 1), b2 + hstep, voffB);
            PG8_WAIT_V(6); PG8_BAR; PG8_MMA(1, 1, At, B1); PG8_BAR;
            PG8_LDB(B0, 1, 0); PG8_SCHED; PG8_LDA(At, 1, 0); PG8_STAGE(PG8_SA(0, 1), a2 + hstep, voffA);
            PG8_WAIT_L(8); PG8_BAR; PG8_WAIT_L(0); PG8_MMA(0, 0, At, B0); PG8_BAR; PG8_SCHED;
            PG8_LDB(B1, 1, 1); PG8_STAGE(PG8_SB(1, 0), b3, voffB);
            PG8_BAR; PG8_WAIT_L(0); PG8_MMA(0, 1, At, B1); PG8_BAR;
            PG8_LDA(At, 1, 1); PG8_STAGE(PG8_SA(1, 0), a3, voffA);
            PG8_BAR; PG8_WAIT_L(0); PG8_MMA(1, 0, At, B0); PG8_BAR; PG8_SCHED;
            PG8_STAGE(PG8_SB(1, 1), b3 + hstep, voffB);
            PG8_WAIT_V(6); PG8_BAR; PG8_MMA(1, 1, At, B1); PG8_BAR;
            }
        }
        if constexpr (ALIGN_EPI) { if (wr == 0) PG8_BAR; }
        if constexpr (!Epi::AFTER_DRAIN) { E(acc, cur, wr, wc, fr, fq); S.done(cur); }
        if (!has_next) break;
#pragma unroll
        for (int a = 0; a < 2; ++a)
#pragma unroll
            for (int b = 0; b < 2; ++b)
#pragma unroll
                for (int m = 0; m < 4; ++m)
#pragma unroll
                    for (int n = 0; n < 2; ++n) acc[a][b][m][n] = (f32x4){0.f, 0.f, 0.f, 0.f};
        cur = nxt; cA = nA; cB = nB; ++ui;
        if constexpr (ALIGN_EPI) { if (wr == 1) PG8_BAR; }
    }
    PG8_WAIT_V(0);
    if constexpr (!ALIGN_EPI) { if (wr == 0) PG8_BAR; }
    PG8_BAR;
    if constexpr (Epi::AFTER_DRAIN) { E.fused(acc, cur, wr, wc, fr, fq, lds, wid, lane); S.done(cur); }
#undef PG8_SA
#undef PG8_SB
#undef PG8_STAGE
#undef PG8_LDA
#undef PG8_LDB
#undef PG8_MMA
#undef PG8_WAIT_V
#undef PG8_WAIT_L
#undef PG8_BAR
#undef PG8_SCHED
}
}
#define GAS __attribute__((address_space(1)))
#define LAS __attribute__((address_space(3)))
typedef unsigned short bf16;
typedef unsigned v4u __attribute__((ext_vector_type(4)));
typedef float f32x4 __attribute__((ext_vector_type(4)));
typedef short bf16x8 __attribute__((ext_vector_type(8)));
typedef GAS unsigned gu32;
typedef GAS unsigned long long gu64;
#define RLX_AGENT __ATOMIC_RELAXED, __HIP_MEMORY_SCOPE_AGENT
#define LDS_WAIT() asm volatile("s_waitcnt lgkmcnt(0)" ::: "memory")
#define VM_WAIT() asm volatile("s_waitcnt vmcnt(0)" ::: "memory")
__device__ __forceinline__ unsigned long long rt() { return __builtin_amdgcn_s_memrealtime(); }
__device__ __forceinline__ unsigned f2bf(float f) { unsigned u = __builtin_bit_cast(unsigned, f); return (u + 0x7fffu + ((u >> 16) & 1u)) >> 16; }
__device__ __forceinline__ unsigned pk2(float lo, float hi) { return f2bf(lo) | (f2bf(hi) << 16); }
#define XB_TMO      128
#define XB_XCNT(j)  (256  + 64 * (j))
#define XB_XSUB(j)  (1280 + 64 * (j))
#define XB_XGEN(j)  (2304 + 64 * (j))
#define XB_TOP      3328
#define XB_TOPGEN   3392
#define XCD_BAR_WORDS 3456
#define XB_SPIN_CAP (1u << 18)

__device__ __forceinline__ unsigned xb_ld(unsigned* p)              { return __hip_atomic_load(p, __ATOMIC_RELAXED, __HIP_MEMORY_SCOPE_AGENT); }
__device__ __forceinline__ unsigned xb_add(unsigned* p, unsigned v) { return __hip_atomic_fetch_add(p, v, __ATOMIC_RELAXED, __HIP_MEMORY_SCOPE_AGENT); }
__device__ __forceinline__ unsigned xb_xcc_id() { return (unsigned)__builtin_amdgcn_s_getreg((3 << 11) | 20) & 0xFu; }
#define XB_SPIN(cond, bar) do { unsigned _sp = 0; while (cond) { __builtin_amdgcn_s_sleep(1); \
    if ((++_sp & 255u) == 0u) { if (xb_ld(&(bar)[XB_TMO])) break; if (_sp > XB_SPIN_CAP) { atomicAdd(&(bar)[XB_TMO], 1u); break; } } } } while (0)

struct XcdBarrier {
    unsigned* bar; unsigned x;
    volatile LAS unsigned* st;
};

__device__ __forceinline__ XcdBarrier xcd_barrier_post(unsigned* bar, volatile LAS unsigned* st) {
    XcdBarrier b; b.bar = bar; b.x = xb_xcc_id(); b.st = st;
    if (threadIdx.x == 0) (void)xb_add(&bar[XB_XCNT(b.x)], 1u);
    return b;
}
__device__ __forceinline__ void xcd_barrier_complete(unsigned* bar, unsigned x, unsigned& nloc, unsigned& nx) {
    const unsigned G = gridDim.x * gridDim.y * gridDim.z;
    unsigned sum, cnt, mine, sp = 0u;
    for (;;) {
        sum = 0u; cnt = 0u; mine = 0u;
#pragma unroll
        for (unsigned j = 0; j < 16; ++j) { const unsigned c = xb_ld(&bar[XB_XCNT(j)]); sum += c; cnt += (c > 0u) ? 1u : 0u; mine = (j == x) ? c : mine; }
        if (sum == G) break;
        __builtin_amdgcn_s_sleep(1);
        if ((++sp & 255u) == 0u) { if (xb_ld(&bar[XB_TMO])) break; if (sp > XB_SPIN_CAP) { atomicAdd(&bar[XB_TMO], 1u); break; } }
    }
    nloc = mine > 0u ? mine : 1u; nx = cnt > 0u ? cnt : 1u;
}

__device__ __forceinline__ void xcd_barrier(const XcdBarrier& b) {
    asm volatile("s_waitcnt vmcnt(0)" ::: "memory");
    __syncthreads();
    if (threadIdx.x == 0) {
        unsigned* bar = b.bar;
        __builtin_amdgcn_s_waitcnt(0);
        unsigned nloc = b.st[0], nx = b.st[1];
        if (nloc == 0u) { xcd_barrier_complete(bar, b.x, nloc, nx); b.st[0] = nloc; b.st[1] = nx; }
        const unsigned old = xb_add(&bar[XB_XSUB(b.x)], 1u);
        const unsigned gen = old / nloc;
        if (old + 1u == (gen + 1u) * nloc) {
            __builtin_amdgcn_fence(__ATOMIC_RELEASE, "agent");
            asm volatile("s_waitcnt vmcnt(0)" ::: "memory");
            const unsigned og = xb_add(&bar[XB_TOP], 1u);
            const unsigned tg = og / nx;
            if (og + 1u == (tg + 1u) * nx) xb_add(&bar[XB_TOPGEN], 1u);
            else XB_SPIN(xb_ld(&bar[XB_TOPGEN]) == tg, bar);
            __builtin_amdgcn_fence(__ATOMIC_ACQUIRE, "agent");
            xb_add(&bar[XB_XGEN(b.x)], 1u);
            asm volatile("s_waitcnt vmcnt(0)" ::: "memory");
        } else {
            XB_SPIN(xb_ld(&bar[XB_XGEN(b.x)]) == gen, bar);
            __builtin_amdgcn_fence(__ATOMIC_ACQUIRE, "agent");
            asm volatile("s_waitcnt vmcnt(0)" ::: "memory");
        }
    }
    __syncthreads();
}
#ifndef MK_N_LAUNCHES
#define MK_N_LAUNCHES 1
#endif
#ifndef ATTN_IMPL
#define ATTN_IMPL 0
#endif
#ifndef HGRN_IMPL
#define HGRN_IMPL 0
#endif
constexpr int NWAVES = 8;
constexpr int N_PHASES = 12;

constexpr int DM = 1024, SEQ = 8192, NBP = 4, NBS = 32, DSEQ = 64, MP = NBP * SEQ, MS = NBS * DSEQ, M = MP + MS;
constexpr int INW = 6912, DFF = 2816, NMOD = NBP + NBS;
constexpr float LN_EPS = 1e-5f, RMS_EPS = 1e-6f;
constexpr float ALPHA = 1.189207115002721f;
static_assert(M % 256 == 0 && INW % 256 == 0 && (2 * DFF) % 256 == 0, "tile shapes");

constexpr size_t MiB = 1u << 20, HMiB = 1u << 19;
constexpr size_t WS_CTL = 0, WS_MOD = 1 * MiB, CTL_ZERO_BYTES = 2 * MiB;
constexpr size_t WS_WIN = 2 * MiB, WS_WBA = 31 * HMiB, WS_WBH = 33 * HMiB, WS_WOUT = 37 * HMiB, WS_WUP = 41 * HMiB, WS_WDN = 63 * HMiB;
constexpr size_t WS_H = 37 * MiB, WS_QB = 105 * MiB, WS_KB = 139 * MiB, WS_VB = 295 * HMiB, WS_HQ = 156 * MiB, WS_HZ = 224 * MiB, WS_HV = 292 * MiB, WS_HG = 360 * MiB;
constexpr size_t WS_U = 428 * MiB, WS_D = 492 * MiB, WS_END = 985 * HMiB;
constexpr size_t WS_YH = WS_H, WS_T1 = WS_HQ, WS_MERGED = WS_HZ, WS_Z1 = WS_HV, WS_X1 = WS_HQ, WS_ACT = WS_HV;
static_assert(WS_WIN + (size_t)INW * DM * 2 == WS_WBA && WS_WBA + 512 * 1024 * 2 == WS_WBH && WS_WBH + 1024 * 1024 * 2 == WS_WOUT && WS_WOUT + 1024 * 1024 * 2 == WS_WUP &&
              WS_WUP + (size_t)2 * DFF * DM * 2 == WS_WDN && WS_WDN + (size_t)DM * DFF * 2 == WS_H && WS_H + (size_t)M * DM * 2 == WS_QB && WS_QB + (size_t)M * 512 * 2 == WS_KB &&
              WS_KB + (size_t)M * 128 * 2 == WS_VB && WS_VB + (size_t)M * 128 * 2 == WS_HQ && WS_HQ + (size_t)M * DM * 2 == WS_HZ && WS_HG + (size_t)M * DM * 2 == WS_U &&
              WS_ACT + (size_t)M * DFF * 2 <= WS_D && WS_END <= 512 * MiB, "d_ws map");
constexpr int CW_BAR = 4096;

constexpr int RING_BYTES = 131072, LDSCTL_OFF = RING_BYTES, MISC_OFF = LDSCTL_OFF + 320, LDS_BYTES = 147456;

typedef unsigned short bf16_t;
typedef unsigned u32x4 __attribute__((ext_vector_type(4)));
typedef unsigned u32x2 __attribute__((ext_vector_type(2)));
using pg8::bf2f; using pg8::fsigmoid; using pg8::fsilu; using pg8::mod_row;
using pg8::OFF_NKP; using pg8::OFF_NVP; using pg8::OFF_NSP; using pg8::OFF_NKS; using pg8::OFF_NVS; using pg8::OFF_NSS;

struct Frame {
    LAS unsigned char* lds;
    int tid, lane, wave, vcu, G;
    const float* in[22]; float* out; unsigned char* ws;
};
#define IN_XP 0
#define IN_XS 1
#define IN_CK 2
#define IN_CV 3
#define IN_ST 4
#define IN_CP 5
#define IN_CS 6
#define IN_WADA 7
#define IN_BADA 8
#define IN_WIN 9
#define IN_SINK 10
#define IN_LBL 11
#define IN_NORMW 12
#define IN_WBA 13
#define IN_WBH 14
#define IN_WOUT 15
#define IN_LNMG 16
#define IN_LNMB 17
#define IN_WUP 18
#define IN_WDN 19
#define IN_LNFG 20
#define IN_LNFB 21

__device__ __forceinline__ float wave_sum(float v) {
#pragma unroll
    for (int o = 1; o < 64; o <<= 1) v += __shfl_xor(v, o);
    return v;
}
template <class RMap>
__device__ __forceinline__ void transpose_item(const float* W, int K, int N, bf16_t* WT, LAS float* scr, int item, int lane, RMap rmap) {
    const int nblk = N / 32, kb = item / nblk, nb = item % nblk, k0 = 64 * kb, n0 = 32 * nb;
    float wv[32];
#pragma unroll
    for (int i = 0; i < 32; ++i) { const int kk = 2 * i + (lane >> 5); wv[i] = W[(size_t)(k0 + kk) * N + n0 + (lane & 31)]; }
#pragma unroll
    for (int i = 0; i < 32; ++i) { const int kk = 2 * i + (lane >> 5); scr[kk * 33 + (lane & 31)] = wv[i]; }
    LDS_WAIT(); asm volatile("" ::: "memory");
    const int c = lane & 7; const int nd0 = rmap(n0);
#pragma unroll
    for (int j = 0; j < 4; ++j) { const int n = (lane >> 3) + 8 * j; const LAS float* s = scr + (8 * c) * 33 + n;
        v4u o; o.x = pk2(s[0 * 33], s[1 * 33]); o.y = pk2(s[2 * 33], s[3 * 33]); o.z = pk2(s[4 * 33], s[5 * 33]); o.w = pk2(s[6 * 33], s[7 * 33]);
        *(GAS v4u*)(WT + (size_t)(nd0 + n) * K + k0 + 8 * c) = o; }
    LDS_WAIT(); asm volatile("" ::: "memory");
}
struct RMapId { __device__ __forceinline__ int operator()(int n0) const { return n0; } };
struct RMapUp { __device__ __forceinline__ int operator()(int n0) const { return n0 < DFF ? 256 * (n0 >> 7) + (n0 & 127) : 256 * ((n0 - DFF) >> 7) + 128 + ((n0 - DFF) & 127); } };

__device__ __forceinline__ void p0_prologue(Frame& F, bool do_mod) {
    if (do_mod && F.vcu < 192) {
        const int kc = F.vcu / 12, ec = F.vcu % 12, k0 = kc * 64, col = ec * 512 + F.tid;
        LAS float* sc = (LAS float*)F.lds;
        for (int i = F.tid; i < 64 * NMOD; i += 512) { const int kk = i / NMOD, mb = i % NMOD;
            const float cv = mb < NBP ? F.in[IN_CP][mb * DM + k0 + kk] : F.in[IN_CS][(mb - NBP) * DM + k0 + kk]; sc[kk * NMOD + mb] = fsilu(cv); }
        __syncthreads();
        float acc[NMOD];
#pragma unroll
        for (int i = 0; i < NMOD; ++i) acc[i] = 0.f;
        const float* wp = F.in[IN_WADA] + (size_t)k0 * 6144 + col;
#pragma unroll 4
        for (int kk = 0; kk < 64; ++kk) { const float w = wp[(size_t)kk * 6144];
#pragma unroll
            for (int i = 0; i < NMOD; ++i) acc[i] += sc[kk * NMOD + i] * w; }
        const float bias = kc == 0 ? F.in[IN_BADA][col] : 0.f;
        float* mod = (float*)(F.ws + WS_MOD);
#pragma unroll
        for (int i = 0; i < NMOD; ++i) atomicAdd(mod + i * 6144 + col, acc[i] + bias);
        __syncthreads();
    }
    LAS float* scr = (LAS float*)(F.lds + F.wave * 16384);
    const int gw = F.vcu * NWAVES + F.wave, NGW = F.G * NWAVES;
    constexpr int I_IN = (DM / 64) * (INW / 32), I_BA = (512 / 64) * (DM / 32), I_BH = (DM / 64) * (DM / 32), I_OUT = I_BH, I_UP = (DM / 64) * (2 * DFF / 32), I_DN = (DFF / 64) * (DM / 32);
    constexpr int NITEMS = I_IN + I_BA + I_BH + I_OUT + I_UP + I_DN;
    for (int it = gw; it < NITEMS; it += NGW) {
        int r = it;
        if (r < I_IN) { transpose_item(F.in[IN_WIN], DM, INW, (bf16_t*)(F.ws + WS_WIN), scr, r, F.lane, RMapId()); continue; } r -= I_IN;
        if (r < I_BA) { transpose_item(F.in[IN_WBA], 512, DM, (bf16_t*)(F.ws + WS_WBA), scr, r, F.lane, RMapId()); continue; } r -= I_BA;
        if (r < I_BH) { transpose_item(F.in[IN_WBH], DM, DM, (bf16_t*)(F.ws + WS_WBH), scr, r, F.lane, RMapId()); continue; } r -= I_BH;
        if (r < I_OUT) { transpose_item(F.in[IN_WOUT], DM, DM, (bf16_t*)(F.ws + WS_WOUT), scr, r, F.lane, RMapId()); continue; } r -= I_OUT;
        if (r < I_UP) { transpose_item(F.in[IN_WUP], DM, 2 * DFF, (bf16_t*)(F.ws + WS_WUP), scr, r, F.lane, RMapUp()); continue; } r -= I_UP;
        transpose_item(F.in[IN_WDN], DFF, DM, (bf16_t*)(F.ws + WS_WDN), scr, r, F.lane, RMapId());
    }
    const int gt = F.vcu * 512 + F.tid, NGT = F.G * 512;
    for (int i = gt; i < 2 * NBS * 64 * 32; i += NGT) {
        const int kv = i / (NBS * 64 * 32), r = i % (NBS * 64 * 32), b = r / (64 * 32), q = r % (64 * 32);
        const f32x4 v = *(const f32x4*)(F.in[kv ? IN_CV : IN_CK] + (size_t)b * 128 * 128 + 64 * 128 + q * 4);
        *(f32x4*)(F.out + (kv ? OFF_NVS : OFF_NKS) + (size_t)b * 128 * 128 + q * 4) = v;
    }
}

__device__ __forceinline__ void ln_norm(f32x4 (&v)[4]) {
    float s = 0.f;
#pragma unroll
    for (int j = 0; j < 4; ++j) s += (v[j][0] + v[j][1]) + (v[j][2] + v[j][3]);
    const float mean = wave_sum(s) * (1.f / DM); float s2 = 0.f;
#pragma unroll
    for (int j = 0; j < 4; ++j) { v[j] = v[j] - mean; s2 += (v[j][0] * v[j][0] + v[j][1] * v[j][1]) + (v[j][2] * v[j][2] + v[j][3] * v[j][3]); }
    const float rstd = 1.f / sqrtf(wave_sum(s2) * (1.f / DM) + LN_EPS);
#pragma unroll
    for (int j = 0; j < 4; ++j) v[j] = v[j] * rstd;
}
__device__ __forceinline__ void store_row_bf16(bf16_t* orow, int lane, const f32x4 (&v)[4]) {
#pragma unroll
    for (int j = 0; j < 4; ++j) { u32x2 w; w.x = pk2(v[j][0], v[j][1]); w.y = pk2(v[j][2], v[j][3]); *(u32x2*)(orow + 4 * lane + 256 * j) = w; }
}
__device__ __forceinline__ void p1_ln_mod(Frame& F) {
    const int gw = F.vcu * NWAVES + F.wave, NGW = F.G * NWAVES; const float* mod = (const float*)(F.ws + WS_MOD); bf16_t* H = (bf16_t*)(F.ws + WS_H);
    for (int row = gw; row < M; row += NGW) {
        const float* xr = row < MP ? F.in[IN_XP] + (size_t)row * DM : F.in[IN_XS] + (size_t)(row - MP) * DM; const float* mr = mod + (size_t)mod_row(row) * 6144;
        f32x4 v[4];
#pragma unroll
        for (int j = 0; j < 4; ++j) v[j] = *(const f32x4*)(xr + 4 * F.lane + 256 * j);
        ln_norm(v);
#pragma unroll
        for (int j = 0; j < 4; ++j) { const f32x4 sh = *(const f32x4*)(mr + 4 * F.lane + 256 * j), sc = *(const f32x4*)(mr + 1024 + 4 * F.lane + 256 * j); v[j] = v[j] * (sc + 1.0f) + sh; }
        store_row_bf16(H + (size_t)row * DM, F.lane, v);
    }
}
__device__ __forceinline__ void p8_ln_mix(Frame& F) {
    const int gw = F.vcu * NWAVES + F.wave, NGW = F.G * NWAVES; const float* mod = (const float*)(F.ws + WS_MOD); bf16_t* H = (bf16_t*)(F.ws + WS_H);
    const float* Z1 = (const float*)(F.ws + WS_Z1); float* X1 = (float*)(F.ws + WS_X1);
    f32x4 gg[4], bb[4];
#pragma unroll
    for (int j = 0; j < 4; ++j) { gg[j] = *(const f32x4*)(F.in[IN_LNMG] + 4 * F.lane + 256 * j); bb[j] = *(const f32x4*)(F.in[IN_LNMB] + 4 * F.lane + 256 * j); }
    for (int row = gw; row < M; row += NGW) {
        const float* mr = mod + (size_t)mod_row(row) * 6144;
        f32x4 v[4];
#pragma unroll
        for (int j = 0; j < 4; ++j) v[j] = *(const f32x4*)(Z1 + (size_t)row * DM + 4 * F.lane + 256 * j);
        ln_norm(v);
#pragma unroll
        for (int j = 0; j < 4; ++j) { v[j] = v[j] * gg[j] + bb[j]; *(f32x4*)(X1 + (size_t)row * DM + 4 * F.lane + 256 * j) = v[j]; }
        ln_norm(v);
#pragma unroll
        for (int j = 0; j < 4; ++j) { const f32x4 sh = *(const f32x4*)(mr + 3072 + 4 * F.lane + 256 * j), sc = *(const f32x4*)(mr + 4096 + 4 * F.lane + 256 * j); v[j] = v[j] * (sc + 1.0f) + sh; }
        store_row_bf16(H + (size_t)row * DM, F.lane, v);
    }
}
__device__ __forceinline__ void p11_ln_out(Frame& F) {
    const int gw = F.vcu * NWAVES + F.wave, NGW = F.G * NWAVES;
    f32x4 gg[4], bb[4];
#pragma unroll
    for (int j = 0; j < 4; ++j) { gg[j] = *(const f32x4*)(F.in[IN_LNFG] + 4 * F.lane + 256 * j); bb[j] = *(const f32x4*)(F.in[IN_LNFB] + 4 * F.lane + 256 * j); }
    for (int row = gw; row < M; row += NGW) {
        float* zr = F.out + (size_t)row * DM;
        f32x4 v[4];
#pragma unroll
        for (int j = 0; j < 4; ++j) v[j] = *(const f32x4*)(zr + 4 * F.lane + 256 * j);
        ln_norm(v);
#pragma unroll
        for (int j = 0; j < 4; ++j) *(f32x4*)(zr + 4 * F.lane + 256 * j) = v[j] * gg[j] + bb[j];
    }
}

__device__ __forceinline__ void attn_simple(Frame& F) {
    bf16_t* QB = (bf16_t*)(F.ws + WS_QB); const bf16_t* KB = (const bf16_t*)(F.ws + WS_KB); const bf16_t* VB = (const bf16_t*)(F.ws + WS_VB);
    LAS bf16_t* Ks = (LAS bf16_t*)F.lds; LAS bf16_t* Vs = (LAS bf16_t*)(F.lds + 192 * 64 * 2);
    for (int unit = F.vcu; unit < 544 * 2; unit += F.G) {
        const int ci = unit >> 1, j = unit & 1; const bool samp = ci >= 512;
        const int row0 = samp ? MP + (ci - 512) * DSEQ : (ci >> 7) * SEQ + (ci & 127) * 64; const int c = ci & 127;
        for (int idx = F.tid; idx < 192 * 8 * 2; idx += 512) { const int kv = idx / (192 * 8), r = idx % (192 * 8), i = r >> 3, ch = r & 7;
            u32x4 w = (u32x4){0u, 0u, 0u, 0u};
            if (samp && i < 128) { const float* src = F.in[kv ? IN_CV : IN_CK] + ((size_t)((ci - 512) * 128 + i) * 2 + j) * 64 + ch * 8;
                const f32x4 a = *(const f32x4*)src, b = *(const f32x4*)(src + 4); w.x = pk2(a[0], a[1]); w.y = pk2(a[2], a[3]); w.z = pk2(b[0], b[1]); w.w = pk2(b[2], b[3]); }
            else if (samp || c * 64 - 128 + i >= 0) { const size_t krow = (size_t)(row0 - 128 + i); w = *(const u32x4*)((kv ? VB : KB) + krow * 128 + j * 64 + ch * 8); }
            *(LAS u32x4*)((kv ? Vs : Ks) + i * 64 + ch * 8) = w; }
        __syncthreads();
        if (F.tid < 256) {
            const int g = F.tid >> 6, t = F.tid & 63, hq = 4 * j + g; bf16_t* qp = QB + (size_t)(row0 + t) * 512 + hq * 64;
            float q[64], o[64];
#pragma unroll
            for (int ch = 0; ch < 8; ++ch) { const u32x4 w = *(const u32x4*)(qp + ch * 8);
                q[ch * 8 + 0] = __uint_as_float(w.x << 16); q[ch * 8 + 1] = __uint_as_float(w.x & 0xffff0000u); q[ch * 8 + 2] = __uint_as_float(w.y << 16); q[ch * 8 + 3] = __uint_as_float(w.y & 0xffff0000u);
                q[ch * 8 + 4] = __uint_as_float(w.z << 16); q[ch * 8 + 5] = __uint_as_float(w.z & 0xffff0000u); q[ch * 8 + 6] = __uint_as_float(w.w << 16); q[ch * 8 + 7] = __uint_as_float(w.w & 0xffff0000u); }
#pragma unroll
            for (int d = 0; d < 64; ++d) o[d] = 0.f;
            const float slope = exp2f(-(float)(hq + 1)); float mx = F.in[IN_SINK][hq], l = 1.f;
            const int i0 = samp ? 0 : (128 - c * 64 > 0 ? 128 - c * 64 : 0);
            for (int i = i0; i < 192; ++i) {
                float s = 0.f;
#pragma unroll
                for (int d2 = 0; d2 < 32; ++d2) { const unsigned kw = *(LAS unsigned*)(Ks + i * 64 + 2 * d2); s += q[2 * d2] * __uint_as_float(kw << 16) + q[2 * d2 + 1] * __uint_as_float(kw & 0xffff0000u); }
                s -= slope * fabsf((float)(128 + t - i));
                const float mn = fmaxf(mx, s), sc = __expf(mx - mn), p = __expf(s - mn); l = l * sc + p; mx = mn;
#pragma unroll
                for (int d2 = 0; d2 < 32; ++d2) { const unsigned vw = *(LAS unsigned*)(Vs + i * 64 + 2 * d2);
                    o[2 * d2] = o[2 * d2] * sc + p * __uint_as_float(vw << 16); o[2 * d2 + 1] = o[2 * d2 + 1] * sc + p * __uint_as_float(vw & 0xffff0000u); }
            }
            const float rl = 1.f / l;
#pragma unroll
            for (int ch = 0; ch < 8; ++ch) { u32x4 w; w.x = pk2(o[ch * 8] * rl, o[ch * 8 + 1] * rl); w.y = pk2(o[ch * 8 + 2] * rl, o[ch * 8 + 3] * rl); w.z = pk2(o[ch * 8 + 4] * rl, o[ch * 8 + 5] * rl); w.w = pk2(o[ch * 8 + 6] * rl, o[ch * 8 + 7] * rl);
                *(u32x4*)(qp + ch * 8) = w; }
        }
        __syncthreads();
    }
}

__device__ __forceinline__ void hgrn_simple(Frame& F) {
    const bf16_t* HQ = (const bf16_t*)(F.ws + WS_HQ); const bf16_t* HZ = (const bf16_t*)(F.ws + WS_HZ); const bf16_t* HV = (const bf16_t*)(F.ws + WS_HV); const bf16_t* HG = (const bf16_t*)(F.ws + WS_HG);
    bf16_t* YH = (bf16_t*)(F.ws + WS_YH);
    LAS float* fs = (LAS float*)F.lds; LAS float* ks = fs + 128; LAS float* qs = fs + 256; LAS float* vs = fs + 384; LAS float* op = fs + 512; LAS float* red = fs + 1024;
    const int e = F.tid & 127, dq = F.tid >> 7;
    for (int unit = F.vcu; unit < NMOD * 8; unit += F.G) {
        const int sidx = unit < 32 ? unit >> 3 : 4 + ((unit - 32) >> 3), h = unit & 7;
        const int T = sidx < NBP ? SEQ : DSEQ, rbase = sidx < NBP ? sidx * SEQ : MP + (sidx - NBP) * DSEQ, col = h * 128;
        float S[32];
#pragma unroll
        for (int i = 0; i < 32; ++i) S[i] = sidx < NBP ? 0.f : F.in[IN_ST][((size_t)((sidx - NBP) * 8 + h) * 128 + 32 * dq + i) * 128 + e];
        float lb = 0.f, nw = 0.f;
        if (F.tid < 128) { const float l0 = F.in[IN_LBL][col + F.tid], l1 = F.in[IN_LBL][1024 + col + F.tid]; lb = 1.f / (1.f + __expf(l1 - l0)); nw = F.in[IN_NORMW][col + F.tid]; }
        for (int t = 0; t < T; ++t) {
            const size_t ro = (size_t)(rbase + t) * DM + col;
            if (F.tid < 128) { const float z = bf2f(HZ[ro + F.tid]), sg = 1.f / (1.f + __expf(-z)); fs[F.tid] = lb + (1.f - lb) * sg; ks[F.tid] = (1.f - lb) * (1.f - sg); qs[F.tid] = bf2f(HQ[ro + F.tid]); }
            else if (F.tid < 256) vs[F.tid - 128] = bf2f(HV[ro + F.tid - 128]);
            __syncthreads();
            const float v = vs[e]; float part = 0.f;
#pragma unroll
            for (int i = 0; i < 32; ++i) { const int d = 32 * dq + i; S[i] = fs[d] * S[i] + ks[d] * v; part += S[i] * qs[d]; }
            op[dq * 128 + e] = part;
            __syncthreads();
            float o = 0.f;
            if (F.tid < 128) { o = (op[e] + op[128 + e]) + (op[256 + e] + op[384 + e]); const float ss = wave_sum(o * o); if (F.lane == 0) red[F.wave] = ss; }
            __syncthreads();
            if (F.tid < 128) { const float r = 1.f / sqrtf((red[0] + red[1]) * (1.f / 128.f) + RMS_EPS); YH[ro + e] = (bf16_t)f2bf(o * r * nw * bf2f(HG[ro + e])); }
        }
        float* so = F.out + (sidx < NBP ? OFF_NSP + (size_t)(sidx * 8 + h) * 16384 : OFF_NSS + (size_t)((sidx - NBP) * 8 + h) * 16384);
#pragma unroll
        for (int i = 0; i < 32; ++i) so[(size_t)(32 * dq + i) * 128 + e] = S[i];
        __syncthreads();
    }
}
typedef float f32x16 __attribute__((ext_vector_type(16)));
typedef short s16x4 __attribute__((ext_vector_type(4)));
__device__ __forceinline__ bf16x8 cat8(u32x2 lo, u32x2 hi) { u32x4 w; w.x = lo.x; w.y = lo.y; w.z = hi.x; w.w = hi.y; return __builtin_bit_cast(bf16x8, w); }
typedef float f32x2_t __attribute__((ext_vector_type(2))); typedef __bf16 bf16x2_t __attribute__((ext_vector_type(2)));
__device__ __forceinline__ unsigned cvtpk(float lo, float hi) { f32x2_t v = {lo, hi}; bf16x2_t b = __builtin_convertvector(v, bf16x2_t); return __builtin_bit_cast(unsigned, b); }

constexpr int AL_K = 0, AL_KROW = 144, AL_VT = 192 * 144, AL_VROW = 392, AL_LINV = AL_VT + 64 * AL_VROW, AL_END = AL_LINV + 8 * 32 * 4;
__device__ __forceinline__ void attn_fast(Frame& F, bool dostore) {
    bf16_t* QB = (bf16_t*)(F.ws + WS_QB); const bf16_t* KB = (const bf16_t*)(F.ws + WS_KB); const bf16_t* VB = (const bf16_t*)(F.ws + WS_VB);
    const int lane = F.lane, w = F.wave, r31 = lane & 31, hi = lane >> 5;
    constexpr float LOG2E = 1.4426950408889634f;
    for (int unit = F.vcu; unit < 544 * 2; unit += F.G) {
        const int ci = unit >> 1, j = unit & 1; const bool samp = ci >= 512;
        const int row0 = samp ? MP + (ci - 512) * DSEQ : (ci >> 7) * SEQ + (ci & 127) * 64; const int c = ci & 127;
        const int i0 = samp ? 0 : (128 - c * 64 > 0 ? 128 - c * 64 : 0);
        for (int idx = F.tid; idx < 192 * 8 * 2; idx += 512) { const int kv = idx / (192 * 8), r = idx % (192 * 8), i = r >> 3, ch = r & 7;
            u32x4 wv = (u32x4){0u, 0u, 0u, 0u};
            if (samp && i < 128) { const float* src = F.in[kv ? IN_CV : IN_CK] + ((size_t)((ci - 512) * 128 + i) * 2 + j) * 64 + ch * 8;
                const f32x4 a = *(const f32x4*)src, b = *(const f32x4*)(src + 4); wv.x = pk2(a[0], a[1]); wv.y = pk2(a[2], a[3]); wv.z = pk2(b[0], b[1]); wv.w = pk2(b[2], b[3]); }
            else if (i >= i0) { const size_t krow = (size_t)(row0 - 128 + i); wv = *(const u32x4*)((kv ? VB : KB) + krow * 128 + j * 64 + ch * 8); }
            if (kv == 0) *(LAS u32x4*)(F.lds + AL_K + i * AL_KROW + ch * 16) = wv;
            else { LAS bf16_t* vt = (LAS bf16_t*)(F.lds + AL_VT + (8 * ch) * AL_VROW + i * 2);
                vt[0] = (bf16_t)(wv.x & 0xffffu); vt[AL_VROW / 2] = (bf16_t)(wv.x >> 16); vt[2 * (AL_VROW / 2)] = (bf16_t)(wv.y & 0xffffu); vt[3 * (AL_VROW / 2)] = (bf16_t)(wv.y >> 16);
                vt[4 * (AL_VROW / 2)] = (bf16_t)(wv.z & 0xffffu); vt[5 * (AL_VROW / 2)] = (bf16_t)(wv.z >> 16); vt[6 * (AL_VROW / 2)] = (bf16_t)(wv.w & 0xffffu); vt[7 * (AL_VROW / 2)] = (bf16_t)(wv.w >> 16); } }
        const int g = w >> 1, th = w & 1, hq = 4 * j + g, t = 32 * th + r31;
        bf16_t* qp = QB + (size_t)(row0 + t) * 512 + hq * 64;
        bf16x8 qf[4];
#pragma unroll
        for (int kap = 0; kap < 4; ++kap) qf[kap] = *(const bf16x8*)(qp + 16 * kap + 8 * hi);
        __syncthreads();
        f32x16 st[6];
#pragma unroll
        for (int kt = 0; kt < 6; ++kt) { st[kt] = (f32x16){0.f, 0.f, 0.f, 0.f, 0.f, 0.f, 0.f, 0.f, 0.f, 0.f, 0.f, 0.f, 0.f, 0.f, 0.f, 0.f};
#pragma unroll
            for (int kap = 0; kap < 4; ++kap) { const bf16x8 a = *(const LAS bf16x8*)(F.lds + AL_K + (32 * kt + r31) * AL_KROW + (16 * kap + 8 * hi) * 2);
                st[kt] = __builtin_amdgcn_mfma_f32_32x32x16_bf16(a, qf[kap], st[kt], 0, 0, 0); }
            __builtin_amdgcn_sched_barrier(0); }
        const float slope2 = exp2f(-(float)(hq + 1)) * LOG2E, sink2 = F.in[IN_SINK][hq] * LOG2E;
        float mx = sink2;
        int dbase = 128 + t - 4 * hi, kbase = i0 - 4 * hi; asm volatile("" : "+v"(dbase), "+v"(kbase));
#pragma unroll
        for (int kt = 0; kt < 6; ++kt)
#pragma unroll
            for (int r = 0; r < 16; ++r) { const int kc = 32 * kt + (r & 3) + 8 * (r >> 2);
                float v = st[kt][r] * LOG2E - slope2 * fabsf((float)(dbase - kc)); v = kc < kbase ? -1e30f : v; st[kt][r] = v; mx = fmaxf(mx, v); }
        mx = fmaxf(mx, __shfl_xor(mx, 32));
        __builtin_amdgcn_sched_barrier(0);
        float l = 0.f;
        u32x4 pw[12];
#pragma unroll
        for (int kt = 0; kt < 6; ++kt) {
#pragma unroll
            for (int r = 0; r < 16; ++r) { const float p = __builtin_amdgcn_exp2f(st[kt][r] - mx); st[kt][r] = p; l += p; }
#pragma unroll
            for (int hs = 0; hs < 2; ++hs) { pw[2 * kt + hs].x = cvtpk(st[kt][8 * hs + 0], st[kt][8 * hs + 1]); pw[2 * kt + hs].y = cvtpk(st[kt][8 * hs + 2], st[kt][8 * hs + 3]);
                pw[2 * kt + hs].z = cvtpk(st[kt][8 * hs + 4], st[kt][8 * hs + 5]); pw[2 * kt + hs].w = cvtpk(st[kt][8 * hs + 6], st[kt][8 * hs + 7]); }
            __builtin_amdgcn_sched_barrier(0);
        }
        l += __shfl_xor(l, 32); l += __builtin_amdgcn_exp2f(sink2 - mx);
        LAS float* linv = (LAS float*)(F.lds + AL_LINV) + w * 32;
        if (hi == 0) linv[r31] = 1.0f / l;
        f32x16 o[2];
        o[0] = (f32x16){0.f, 0.f, 0.f, 0.f, 0.f, 0.f, 0.f, 0.f, 0.f, 0.f, 0.f, 0.f, 0.f, 0.f, 0.f, 0.f}; o[1] = o[0];
        __builtin_amdgcn_sched_barrier(0);
#pragma unroll
        for (int s16 = 0; s16 < 12; ++s16) {
            const bf16x8 pa = __builtin_bit_cast(bf16x8, pw[s16]);
#pragma unroll
            for (int dt = 0; dt < 2; ++dt) { const LAS unsigned char* vp = F.lds + AL_VT + (32 * dt + r31) * AL_VROW + (16 * s16 + 4 * hi) * 2;
                const bf16x8 b = cat8(*(const LAS u32x2*)vp, *(const LAS u32x2*)(vp + 16));
                o[dt] = __builtin_amdgcn_mfma_f32_32x32x16_bf16(pa, b, o[dt], 0, 0, 0); }
            if (s16 & 1) __builtin_amdgcn_sched_barrier(0);
        }
        asm volatile("s_waitcnt lgkmcnt(0)" ::: "memory");
        int hio = 4 * hi; asm volatile("" : "+v"(hio));
        bf16_t* op = QB + (size_t)(row0 + 32 * th + hio) * 512 + hq * 64 + r31; const LAS float* lq = linv + hio;
#pragma unroll
        for (int r = 0; r < 16; ++r) { const int qq = (r & 3) + 8 * (r >> 2); const float li = lq[qq];
            const unsigned pk = cvtpk(o[0][r] * li, o[1][r] * li); if (dostore) { op[(size_t)qq * 512] = (bf16_t)(pk & 0xffffu); op[(size_t)qq * 512 + 32] = (bf16_t)(pk >> 16); } }
        __syncthreads();
    }
}

constexpr int HL_QE = 0, HL_QROW = 272, HL_KE = 32 * 272, HL_KDT = 2 * 32 * 272, HL_TROW = 80, HL_VT = HL_KDT + 128 * 80, HL_EM = HL_VT + 128 * 80, HL_DEC = HL_EM + 512, HL_PART = HL_DEC + 512,
              HL_O = HL_PART + 4096, HL_OROW = 528, HL_END = HL_O + 32 * 528;
static_assert(HL_END <= RING_BYTES && AL_END <= RING_BYTES, "phase scratch inside the ring region");

struct HgRaw { unsigned z[4], q[4], v[4]; u32x4 hg; };
template <bool FULL>
__device__ __forceinline__ void hgrn_load(Frame& F, size_t rowoff  , HgRaw& R) {
    const bf16_t* HQ = (const bf16_t*)(F.ws + WS_HQ); const bf16_t* HZ = (const bf16_t*)(F.ws + WS_HZ); const bf16_t* HV = (const bf16_t*)(F.ws + WS_HV); const bf16_t* HG = (const bf16_t*)(F.ws + WS_HG);
    const int cp = F.tid & 63, p = F.tid >> 6;
#pragma unroll
    for (int i = 0; i < 4; ++i) { const size_t o = rowoff + (size_t)(4 * p + i) * DM + 2 * cp; R.z[i] = *(const unsigned*)(HZ + o); R.v[i] = *(const unsigned*)(HV + o); if (FULL) R.q[i] = *(const unsigned*)(HQ + o); }
    if (FULL) R.hg = *(const u32x4*)(HG + rowoff + (size_t)(F.tid >> 4) * DM + 8 * (F.tid & 15));
}
template <bool FULL>
__device__ __forceinline__ void hgrn_prep(Frame& F, const HgRaw& R, float lb0, float lb1, float& bt0, float& bt1) {
    const int cp = F.tid & 63, p = F.tid >> 6;
    { u32x2 a, b; a.x = (R.v[0] & 0xffffu) | (R.v[1] << 16); a.y = (R.v[2] & 0xffffu) | (R.v[3] << 16); b.x = (R.v[0] >> 16) | (R.v[1] & 0xffff0000u); b.y = (R.v[2] >> 16) | (R.v[3] & 0xffff0000u);
      *(LAS u32x2*)(F.lds + HL_VT + (2 * cp) * HL_TROW + p * 8) = a; *(LAS u32x2*)(F.lds + HL_VT + (2 * cp + 1) * HL_TROW + p * 8) = b; }
    float kk[2][4], cs[2][4]; float run0 = 0.f, run1 = 0.f;
    constexpr float L2E = 1.4426950408889634f;
#pragma unroll
    for (int i = 0; i < 4; ++i) {
        { const float z = __uint_as_float(R.z[i] << 16), ez = __builtin_amdgcn_exp2f(fminf(z * -L2E, 80.f)), sg = __builtin_amdgcn_rcpf(1.f + ez); kk[0][i] = (1.f - lb0) * (ez * sg); run0 += __builtin_amdgcn_logf(lb0 + (1.f - lb0) * sg); cs[0][i] = run0; }
        { const float z = __uint_as_float(R.z[i] & 0xffff0000u), ez = __builtin_amdgcn_exp2f(fminf(z * -L2E, 80.f)), sg = __builtin_amdgcn_rcpf(1.f + ez); kk[1][i] = (1.f - lb1) * (ez * sg); run1 += __builtin_amdgcn_logf(lb1 + (1.f - lb1) * sg); cs[1][i] = run1; }
    }
    typedef float f32x2 __attribute__((ext_vector_type(2)));
    LAS float* part = (LAS float*)(F.lds + HL_PART);
    *(LAS f32x2*)(part + p * 128 + 2 * cp) = (f32x2){run0, run1};
    __syncthreads();
    float pre0 = 0.f, pre1 = 0.f, m0 = 0.f, m1 = 0.f, bl0 = 0.f, bl1 = 0.f;
#pragma unroll
    for (int pp = 0; pp < 8; ++pp) { const f32x2 v = *(const LAS f32x2*)(part + pp * 128 + 2 * cp); if (pp < p) { pre0 += v.x; pre1 += v.y; } if (pp < 4) { m0 += v.x; m1 += v.y; } bl0 += v.x; bl1 += v.y; }
    const float c0 = __builtin_amdgcn_exp2f(bl0 - m0), c1 = __builtin_amdgcn_exp2f(bl1 - m1);
    float kd[2][4];
#pragma unroll
    for (int i = 0; i < 4; ++i) { const float b0 = pre0 + cs[0][i], b1 = pre1 + cs[1][i];
        if (FULL) { const float q0 = __uint_as_float(R.q[i] << 16), q1 = __uint_as_float(R.q[i] & 0xffff0000u);
            const float up0 = __builtin_amdgcn_exp2f(b0 - m0), up1 = __builtin_amdgcn_exp2f(b1 - m1), ke0 = kk[0][i] * __builtin_amdgcn_rcpf(up0), ke1 = kk[1][i] * __builtin_amdgcn_rcpf(up1);
            *(LAS unsigned*)(F.lds + HL_QE + (4 * p + i) * HL_QROW + cp * 4) = cvtpk(q0 * up0, q1 * up1);
            *(LAS unsigned*)(F.lds + HL_KE + (4 * p + i) * HL_QROW + cp * 4) = cvtpk(ke0, ke1);
            kd[0][i] = ke0 * c0; kd[1][i] = ke1 * c1; }
        else { kd[0][i] = kk[0][i] * __builtin_amdgcn_exp2f(bl0 - b0); kd[1][i] = kk[1][i] * __builtin_amdgcn_exp2f(bl1 - b1); } }
    { u32x2 a, b; a.x = cvtpk(kd[0][0], kd[0][1]); a.y = cvtpk(kd[0][2], kd[0][3]); b.x = cvtpk(kd[1][0], kd[1][1]); b.y = cvtpk(kd[1][2], kd[1][3]);
      *(LAS u32x2*)(F.lds + HL_KDT + (2 * cp) * HL_TROW + p * 8) = a; *(LAS u32x2*)(F.lds + HL_KDT + (2 * cp + 1) * HL_TROW + p * 8) = b; }
    if (p == 0) { if (FULL) *(LAS f32x2*)(F.lds + HL_EM + cp * 8) = (f32x2){__builtin_amdgcn_exp2f(m0), __builtin_amdgcn_exp2f(m1)}; *(LAS f32x2*)(F.lds + HL_DEC + cp * 8) = (f32x2){__builtin_amdgcn_exp2f(bl0), __builtin_amdgcn_exp2f(bl1)}; bt0 += bl0; bt1 += bl1; }
    __syncthreads();
}
template <bool FULL>
__device__ __forceinline__ void hgrn_mma(Frame& F, f32x4 (&S)[8]) {
    const int lane = F.lane, w = F.wave, r15 = lane & 15, g = lane >> 4;
    const LAS unsigned char* L = F.lds;
    const LAS unsigned char* vrow = L + HL_VT + (16 * w + r15) * HL_TROW;
    const bf16x8 vn = *(const LAS bf16x8*)(vrow + 16 * g);
    if (FULL) {
        bf16x8 qe[2][4], ke[2][4];
#pragma unroll
        for (int tau = 0; tau < 2; ++tau)
#pragma unroll
            for (int kap = 0; kap < 4; ++kap) { const int off = (16 * tau + r15) * HL_QROW + (32 * kap + 4 * g) * 2;
                qe[tau][kap] = cat8(*(const LAS u32x2*)(L + HL_QE + off), *(const LAS u32x2*)(L + HL_QE + off + 32));
                ke[tau][kap] = cat8(*(const LAS u32x2*)(L + HL_KE + off), *(const LAS u32x2*)(L + HL_KE + off + 32)); }
        f32x4 at00 = (f32x4){0.f, 0.f, 0.f, 0.f}, at01 = at00, at11 = at00;
#pragma unroll
        for (int kap = 0; kap < 4; ++kap) { at00 = __builtin_amdgcn_mfma_f32_16x16x32_bf16(ke[0][kap], qe[0][kap], at00, 0, 0, 0);
            at01 = __builtin_amdgcn_mfma_f32_16x16x32_bf16(ke[0][kap], qe[1][kap], at01, 0, 0, 0); at11 = __builtin_amdgcn_mfma_f32_16x16x32_bf16(ke[1][kap], qe[1][kap], at11, 0, 0, 0); }
#pragma unroll
        for (int r = 0; r < 4; ++r) { const bool dead = (4 * g + r) > r15; at00[r] = dead ? 0.f : at00[r]; at11[r] = dead ? 0.f : at11[r]; }
        u32x4 a0, a1; a0.x = cvtpk(at00[0], at00[1]); a0.y = cvtpk(at00[2], at00[3]); a0.z = 0u; a0.w = 0u;
        a1.x = cvtpk(at01[0], at01[1]); a1.y = cvtpk(at01[2], at01[3]); a1.z = cvtpk(at11[0], at11[1]); a1.w = cvtpk(at11[2], at11[3]);
        const bf16x8 vp = cat8(*(const LAS u32x2*)(vrow + 8 * g), *(const LAS u32x2*)(vrow + 32 + 8 * g));
        f32x4 o0 = __builtin_amdgcn_mfma_f32_16x16x32_bf16(__builtin_bit_cast(bf16x8, a0), vp, (f32x4){0.f, 0.f, 0.f, 0.f}, 0, 0, 0);
        f32x4 o1 = __builtin_amdgcn_mfma_f32_16x16x32_bf16(__builtin_bit_cast(bf16x8, a1), vp, (f32x4){0.f, 0.f, 0.f, 0.f}, 0, 0, 0);
#pragma unroll
        for (int kap = 0; kap < 4; ++kap) { const f32x4 e0 = *(const LAS f32x4*)(L + HL_EM + (32 * kap + 4 * g) * 4), e1 = *(const LAS f32x4*)(L + HL_EM + (32 * kap + 16 + 4 * g) * 4);
            const f32x4 s0 = S[2 * kap] * e0, s1 = S[2 * kap + 1] * e1;
            u32x4 sw; sw.x = cvtpk(s0[0], s0[1]); sw.y = cvtpk(s0[2], s0[3]); sw.z = cvtpk(s1[0], s1[1]); sw.w = cvtpk(s1[2], s1[3]); const bf16x8 sp = __builtin_bit_cast(bf16x8, sw);
            o0 = __builtin_amdgcn_mfma_f32_16x16x32_bf16(qe[0][kap], sp, o0, 0, 0, 0); o1 = __builtin_amdgcn_mfma_f32_16x16x32_bf16(qe[1][kap], sp, o1, 0, 0, 0); }
        LAS float* ot = (LAS float*)(F.lds + HL_O) + 16 * w + r15;
#pragma unroll
        for (int r = 0; r < 4; ++r) { ot[(4 * g + r) * (HL_OROW / 4)] = o0[r]; ot[(16 + 4 * g + r) * (HL_OROW / 4)] = o1[r]; }
    }
#pragma unroll
    for (int dl = 0; dl < 8; ++dl) { const f32x4 dc = *(const LAS f32x4*)(L + HL_DEC + (16 * dl + 4 * g) * 4);
        const bf16x8 a = *(const LAS bf16x8*)(L + HL_KDT + (16 * dl + r15) * HL_TROW + 16 * g);
        S[dl] = __builtin_amdgcn_mfma_f32_16x16x32_bf16(a, vn, S[dl] * dc, 0, 0, 0); }
}
__device__ __forceinline__ void hgrn_norm(Frame& F, size_t rowoff, const u32x4 gq, const f32x4 n0, const f32x4 n1) {
    bf16_t* YH = (bf16_t*)(F.ws + WS_YH);
    const int t = F.tid >> 4, sub = F.tid & 15;
    const LAS float* op = (const LAS float*)(F.lds + HL_O + t * HL_OROW) + 8 * sub;
    const f32x4 a = *(const LAS f32x4*)op, b = *(const LAS f32x4*)(op + 4);
    float ss = (a[0] * a[0] + a[1] * a[1]) + (a[2] * a[2] + a[3] * a[3]) + (b[0] * b[0] + b[1] * b[1]) + (b[2] * b[2] + b[3] * b[3]);
    ss += __shfl_xor(ss, 1); ss += __shfl_xor(ss, 2); ss += __shfl_xor(ss, 4); ss += __shfl_xor(ss, 8);
    const float r = __builtin_amdgcn_rsqf(ss * (1.f / 128.f) + RMS_EPS);
    const size_t o = rowoff + (size_t)t * DM + 8 * sub;
    u32x4 wv;
    wv.x = cvtpk(a[0] * r * n0[0] * __uint_as_float(gq.x << 16), a[1] * r * n0[1] * __uint_as_float(gq.x & 0xffff0000u));
    wv.y = cvtpk(a[2] * r * n0[2] * __uint_as_float(gq.y << 16), a[3] * r * n0[3] * __uint_as_float(gq.y & 0xffff0000u));
    wv.z = cvtpk(b[0] * r * n1[0] * __uint_as_float(gq.z << 16), b[1] * r * n1[1] * __uint_as_float(gq.z & 0xffff0000u));
    wv.w = cvtpk(b[2] * r * n1[2] * __uint_as_float(gq.w << 16), b[3] * r * n1[3] * __uint_as_float(gq.w & 0xffff0000u));
    *(u32x4*)(YH + o) = wv;
}
__device__ __forceinline__ void hgrn_lb(Frame& F, int h, float& lb0, float& lb1) { const int c = h * 128 + 2 * (F.tid & 63); typedef float f32x2 __attribute__((ext_vector_type(2)));
    const f32x2 l0 = *(const f32x2*)(F.in[IN_LBL] + c), l1 = *(const f32x2*)(F.in[IN_LBL] + 1024 + c); lb0 = 1.f / (1.f + __expf(l1.x - l0.x)); lb1 = 1.f / (1.f + __expf(l1.y - l0.y)); }
__device__ __forceinline__ void hgrn_state_load(Frame& F, const float* base, f32x4 (&S)[8]) {
    const int r15 = F.lane & 15, g = F.lane >> 4; const float* p = base + (size_t)(4 * g) * 128 + 16 * F.wave + r15;
#pragma unroll
    for (int dl = 0; dl < 8; ++dl)
#pragma unroll
        for (int r = 0; r < 4; ++r) S[dl][r] = p[(size_t)(16 * dl + r) * 128];
}
__device__ __forceinline__ void hgrn_state_store(Frame& F, float* base, const f32x4 (&S)[8]) {
    const int r15 = F.lane & 15, g = F.lane >> 4; float* p = base + (size_t)(4 * g) * 128 + 16 * F.wave + r15;
#pragma unroll
    for (int dl = 0; dl < 8; ++dl)
#pragma unroll
        for (int r = 0; r < 4; ++r) p[(size_t)(16 * dl + r) * 128] = S[dl][r];
}
__device__ __forceinline__ void hgrn_pass_a(Frame& F) {
    float* U = (float*)(F.ws + WS_U); float* D = (float*)(F.ws + WS_D);
    HgRaw R;
    if (F.vcu < 128 * 8) hgrn_load<false>(F, (size_t)((F.vcu >> 3) * 256) * DM + (F.vcu & 7) * 128, R);
    for (int unit = F.vcu; unit < 128 * 8; unit += F.G) {
        const int n = unit >> 3, h = unit & 7; float lb0, lb1, bt0 = 0.f, bt1 = 0.f; hgrn_lb(F, h, lb0, lb1);
        f32x4 S[8];
#pragma unroll
        for (int dl = 0; dl < 8; ++dl) S[dl] = (f32x4){0.f, 0.f, 0.f, 0.f};
        for (int blk = 0; blk < 8; ++blk) {
            hgrn_prep<false>(F, R, lb0, lb1, bt0, bt1);
            if (blk < 7) hgrn_load<false>(F, (size_t)(n * 256 + (blk + 1) * 32) * DM + h * 128, R);
            else if (unit + F.G < 128 * 8) hgrn_load<false>(F, (size_t)(((unit + F.G) >> 3) * 256) * DM + ((unit + F.G) & 7) * 128, R);
            hgrn_mma<false>(F, S); __syncthreads(); }
        hgrn_state_store(F, U + (size_t)unit * 16384, S);
        if (F.tid < 64) { typedef float f32x2 __attribute__((ext_vector_type(2))); *(f32x2*)(D + unit * 128 + 2 * F.tid) = (f32x2){__builtin_amdgcn_exp2f(bt0), __builtin_amdgcn_exp2f(bt1)}; }
    }
}
__device__ __forceinline__ void hgrn_scan(Frame& F) {
    float* U = (float*)(F.ws + WS_U); const float* D = (const float*)(F.ws + WS_D);
    for (int gid = F.vcu * 512 + F.tid; gid < NBP * 8 * 128 * 32; gid += F.G * 512) {
        const int e4 = gid & 31, d = (gid >> 5) & 127, h = (gid >> 12) & 7, b = gid >> 15;
        f32x4 S = (f32x4){0.f, 0.f, 0.f, 0.f};
        for (int n0 = 0; n0 < 32; n0 += 8) {
            f32x4 u[8]; float dc[8];
#pragma unroll
            for (int i = 0; i < 8; ++i) { const size_t unit = (size_t)((b * 32 + n0 + i) * 8 + h); u[i] = *(const f32x4*)(U + unit * 16384 + d * 128 + e4 * 4); dc[i] = D[unit * 128 + d]; }
#pragma unroll
            for (int i = 0; i < 8; ++i) { const size_t unit = (size_t)((b * 32 + n0 + i) * 8 + h); *(f32x4*)(U + unit * 16384 + d * 128 + e4 * 4) = S; S = S * dc[i] + u[i]; }
        }
        *(f32x4*)(F.out + OFF_NSP + (size_t)(b * 8 + h) * 16384 + d * 128 + e4 * 4) = S;
    }
}
__device__ __forceinline__ size_t hgrn_b_rowoff(int unit) { const bool samp = unit >= 1024; const int su = unit - 1024; return (samp ? (size_t)MP + (size_t)(su >> 3) * DSEQ : (size_t)(unit >> 3) * 256) * DM + (unit & 7) * 128; }
__device__ __forceinline__ void hgrn_pass_b(Frame& F) {
    const float* U = (const float*)(F.ws + WS_U);
    constexpr int NU = 128 * 8 + NBS * 8;
    HgRaw R;
    if (F.vcu < NU) hgrn_load<true>(F, hgrn_b_rowoff(F.vcu), R);
    for (int unit = F.vcu; unit < NU; unit += F.G) {
        const bool samp = unit >= 1024; const int su = unit - 1024;
        const int h = unit & 7, nblk = samp ? 2 : 8; const size_t ro0 = hgrn_b_rowoff(unit);
        float lb0, lb1, bt0 = 0.f, bt1 = 0.f; hgrn_lb(F, h, lb0, lb1);
        const f32x4 n0 = *(const f32x4*)(F.in[IN_NORMW] + h * 128 + 8 * (F.tid & 15)), n1 = *(const f32x4*)(F.in[IN_NORMW] + h * 128 + 8 * (F.tid & 15) + 4);
        f32x4 S[8];
        hgrn_state_load(F, samp ? F.in[IN_ST] + (size_t)su * 16384 : U + (size_t)unit * 16384, S);
        for (int blk = 0; blk < nblk; ++blk) { const size_t ro = ro0 + (size_t)(blk * 32) * DM;
            hgrn_prep<true>(F, R, lb0, lb1, bt0, bt1);
            const u32x4 hgc = R.hg;
            if (blk + 1 < nblk) hgrn_load<true>(F, ro + (size_t)32 * DM, R);
            else if (unit + F.G < NU) hgrn_load<true>(F, hgrn_b_rowoff(unit + F.G), R);
            hgrn_mma<true>(F, S); __syncthreads(); hgrn_norm(F, ro, hgc, n0, n1); }
        if (samp) hgrn_state_store(F, F.out + OFF_NSS + (size_t)su * 16384, S);
        __syncthreads();
    }
}
#ifndef DUPMASK
#define DUPMASK 0
#endif
#define DUP(k) ((DUPMASK >> (k)) & 1)
struct Args { const float* in[22]; float* out; unsigned char* ws; int ph_lo, ph_hi; };
__global__ void __launch_bounds__(NWAVES * 64, 2) fwd(Args args) {
    extern __shared__ __attribute__((aligned(16))) unsigned char lds[];
    Frame F;
    F.lds = (LAS unsigned char*)lds;
    F.tid = threadIdx.x; F.lane = F.tid & 63; F.wave = __builtin_amdgcn_readfirstlane(F.tid >> 6);
    F.G = gridDim.x; { const int bx = blockIdx.x; F.vcu = (F.G % 8 == 0) ? (bx % 8) * (F.G / 8) + bx / 8 : bx; }
#pragma unroll
    for (int i = 0; i < 22; ++i) F.in[i] = args.in[i];
    F.out = args.out; F.ws = args.ws;
    cooperative_groups::grid_group grid = cooperative_groups::this_grid();
    const int lo = args.ph_lo, hi = args.ph_hi;
    for (int u = F.tid; u < (LDS_BYTES - LDSCTL_OFF) / 4; u += NWAVES * 64) ((LAS unsigned*)(F.lds + LDSCTL_OFF))[u] = 0u;
    __syncthreads();
    XcdBarrier bar; bar.bar = (unsigned*)(args.ws + WS_CTL) + CW_BAR; bar.x = 0; bar.st = nullptr;
#if MK_N_LAUNCHES == 1
    bar = xcd_barrier_post((unsigned*)(args.ws + WS_CTL) + CW_BAR, (volatile LAS unsigned*)(F.lds + MISC_OFF) + 8);
#endif
#define IN(k) (lo <= (k) && (k) < hi)
#define SEAM(k) do { if (IN(k) && IN((k) + 1)) { xcd_barrier(bar); } } while (0)
    if (args.ph_lo == 0x7fffff01) grid.sync();
    unsigned char* ws = args.ws;
    bf16_t* H = (bf16_t*)(ws + WS_H);

    if (IN(0)) { p0_prologue(F, true); if (DUP(14)) { __syncthreads(); p0_prologue(F, false); } }
    SEAM(0);
    if (IN(1)) { p1_ln_mod(F); if (DUP(1)) p1_ln_mod(F); }
    SEAM(1);
#define PH2_BODY \
        pg8::Gemm g{H, (const bf16_t*)(ws + WS_WIN), M, INW, DM}; pg8::StaticOrder S; S.init(M, INW, F.G, (int)blockIdx.x); \
        pg8::EpiProj E{(bf16_t*)(ws + WS_QB), (bf16_t*)(ws + WS_KB), (bf16_t*)(ws + WS_VB), (bf16_t*)(ws + WS_HQ), (bf16_t*)(ws + WS_HZ), (bf16_t*)(ws + WS_HV), (bf16_t*)(ws + WS_HG), (bf16_t*)F.out, F.out}; \
        pg8::gemm_phase<pg8::EpiProj, pg8::StaticOrder, true, true>(F.lds, g, S, E); \

    if (IN(2)) { { PH2_BODY } if (DUP(2)) { __syncthreads(); PH2_BODY } }
    SEAM(2);
    if (IN(3)) {
#if ATTN_IMPL
        attn_fast(F, true); if (DUP(13)) attn_fast(F, args.ph_lo == 77);
#else
        attn_simple(F);
#endif
#if HGRN_IMPL
        hgrn_pass_a(F); if (DUP(3)) hgrn_pass_a(F);
#else
        hgrn_simple(F);
#endif
    }
    SEAM(3);
#if HGRN_IMPL
    if (IN(4)) { hgrn_scan(F); if (DUP(12)) { for (int xb = 0; xb < 8; ++xb) xcd_barrier(bar); } }
    SEAM(4);
    if (IN(5)) { hgrn_pass_b(F); if (DUP(5)) hgrn_pass_b(F); }
    SEAM(5);
#endif
#define PH6_BODY \
        { pg8::Gemm g{(const bf16_t*)(ws + WS_QB), (const bf16_t*)(ws + WS_WBA), M, DM, 512}; pg8::StaticOrder S; S.init(M, DM, F.G, (int)blockIdx.x); \
          pg8::EpiMerge<true> E{(const bf16_t*)F.out, nullptr, (bf16_t*)(ws + WS_T1)}; \
          pg8::gemm_phase<pg8::EpiMerge<true>, pg8::StaticOrder, true, true>(F.lds, g, S, E); } \
        __syncthreads(); \
        { pg8::Gemm g{(const bf16_t*)(ws + WS_YH), (const bf16_t*)(ws + WS_WBH), M, DM, DM}; pg8::StaticOrder S; S.init(M, DM, F.G, (int)blockIdx.x); \
          pg8::EpiMerge<false> E{(const bf16_t*)F.out, (const bf16_t*)(ws + WS_T1), (bf16_t*)(ws + WS_MERGED)}; \
          pg8::gemm_phase<pg8::EpiMerge<false>, pg8::StaticOrder, true, true>(F.lds, g, S, E); } \

    if (IN(6)) { { PH6_BODY } if (DUP(6)) { __syncthreads(); PH6_BODY } }
    SEAM(6);
#define PH7_BODY \
        pg8::Gemm g{(const bf16_t*)(ws + WS_MERGED), (const bf16_t*)(ws + WS_WOUT), M, DM, DM}; pg8::StaticOrder S; S.init(M, DM, F.G, (int)blockIdx.x); \
        pg8::EpiResid E{F.in[IN_XP], F.in[IN_XS], (const float*)(ws + WS_MOD) + 2048, (float*)(ws + WS_Z1), ALPHA}; \
        pg8::gemm_phase<pg8::EpiResid, pg8::StaticOrder, true, true>(F.lds, g, S, E); \

    if (IN(7)) { { PH7_BODY } if (DUP(7)) { __syncthreads(); PH7_BODY } }
    SEAM(7);
    if (IN(8)) { p8_ln_mix(F); if (DUP(8)) p8_ln_mix(F); }
    SEAM(8);
#define PH9_BODY \
        pg8::Gemm g{H, (const bf16_t*)(ws + WS_WUP), M, 2 * DFF, DM}; pg8::StaticOrder S; S.init(M, 2 * DFF, F.G, (int)blockIdx.x); \
        pg8::EpiSwiGLU E{(bf16_t*)(ws + WS_ACT)}; \
        pg8::gemm_phase<pg8::EpiSwiGLU, pg8::StaticOrder, true, true>(F.lds, g, S, E); \

    if (IN(9)) { { PH9_BODY } if (DUP(9)) { __syncthreads(); PH9_BODY } }
    SEAM(9);
#define PH10_BODY \
        pg8::Gemm g{(const bf16_t*)(ws + WS_ACT), (const bf16_t*)(ws + WS_WDN), M, DM, DFF}; pg8::StaticOrder S; S.init(M, DM, F.G, (int)blockIdx.x); \
        const float* X1 = (const float*)(ws + WS_X1); \
        pg8::EpiResid E{X1, X1 + (size_t)MP * DM, (const float*)(ws + WS_MOD) + 5120, F.out, ALPHA}; \
        pg8::gemm_phase<pg8::EpiResid, pg8::StaticOrder, true, true>(F.lds, g, S, E); \

    if (IN(10)) { { PH10_BODY } if (DUP(10)) { __syncthreads(); PH10_BODY } }
    SEAM(10);
    if (IN(11)) { p11_ln_out(F); }
#undef IN
#undef SEAM
}

extern "C" void kernel_launch(void* const* d_in, const int* in_sizes, int n_in, void* d_out, int out_size, void* d_ws, size_t ws_size, hipStream_t stream) {
    static int grid = 0;
    if (grid == 0) {
        if (n_in != 22 || out_size != 41549824 || ws_size < WS_END) { fprintf(stderr, "kernel_launch: unexpected problem (n_in %d, out %d, ws %zu)\n", n_in, out_size, ws_size); grid = -1; return; }
        int dev = 0, cus = 0, per_cu = 0;
        if (hipGetDevice(&dev) != hipSuccess || hipDeviceGetAttribute(&cus, hipDeviceAttributeMultiprocessorCount, dev) != hipSuccess) { grid = -1; return; }
        if (hipFuncSetAttribute((const void*)fwd, hipFuncAttributeMaxDynamicSharedMemorySize, LDS_BYTES) != hipSuccess) { fprintf(stderr, "kernel_launch: hipFuncSetAttribute failed\n"); grid = -1; return; }
        if (hipOccupancyMaxActiveBlocksPerMultiprocessor(&per_cu, (const void*)fwd, NWAVES * 64, LDS_BYTES) != hipSuccess || per_cu < 1) { fprintf(stderr, "kernel_launch: occupancy query says %d\n", per_cu); (void)hipGetLastError(); grid = -1; return; }
        grid = cus;
    }
    if (grid < 0) return;
    (void)hipMemsetAsync((char*)d_ws + WS_CTL, 0, CTL_ZERO_BYTES, stream);
    Args a{};
    for (int i = 0; i < 22; ++i) a.in[i] = (const float*)d_in[i];
    a.out = (float*)d_out; a.ws = (unsigned char*)d_ws;
#if MK_N_LAUNCHES == 1
    a.ph_lo = 0; a.ph_hi = N_PHASES;
    void* kargs[] = {&a};
    hipError_t e = hipLaunchCooperativeKernel((const void*)fwd, dim3(grid), dim3(NWAVES * 64), kargs, LDS_BYTES, stream);
    if (e != hipSuccess) fprintf(stderr, "kernel_launch: cooperative launch failed: %s\n", hipGetErrorString(e));
#else
    for (int p = 0; p < N_PHASES; ++p) {
        if (p == 4 || p == 5) { if (!HGRN_IMPL) continue; }
        a.ph_lo = p; a.ph_hi = p + 1;
        hipLaunchKernelGGL(fwd, dim3(grid), dim3(NWAVES * 64), LDS_BYTES, stream, a);
    }
#endif
}
```
